# Optimizing an MI355X kernel written in HIP

```python
import math
import jax, jax.numpy as jnp
from jax import lax
import numpy as np

D_MODEL = 1024
BATCH = 2
SEQ = 8192
DEPTH = 1

MLA_HEADS = 4
MLA_Q_RANK = 256
MLA_KV_RANK = 128
MLA_NOPE = 128
MLA_ROPE = 64
MLA_VDIM = 128
ROPE_THETA = 10000.0
Q_BLOCK = 128
GDN_HEADS = 4
GDN_DK = 128
GDN_DV = 128
CONV_K = 5
CHUNK = 64
MLA_WIDTH = MLA_HEADS * MLA_VDIM
GDN_WIDTH = GDN_HEADS * GDN_DV
MIX_WIDTH = MLA_WIDTH + GDN_WIDTH
MLA_IN = MLA_Q_RANK + MLA_KV_RANK + MLA_ROPE
GDN_QKV = GDN_HEADS * (2 * GDN_DK + GDN_DV)
GDN_IN = GDN_QKV + GDN_WIDTH + 4 * GDN_HEADS
IN_WIDTH = MLA_IN + GDN_IN
PEER_HEADS = 8
PEER_NKEYS = 128
PEER_EXPERTS = PEER_NKEYS * PEER_NKEYS
PEER_TOPK = 16
PEER_QDIM = 256
PEER_HALF = PEER_QDIM // 2
TOKEN_BLOCK = 128
EPS = 1e-6

kernel_name = "hybrid_mla_gdn_peer_encoder"

F32 = jnp.float32


def rmsnorm(t, w):
    tf = t.astype(F32)
    y = tf * lax.rsqrt(jnp.mean(tf * tf, axis=-1, keepdims=True) + EPS)
    return (y * w.astype(F32)).astype(t.dtype)


def l2norm(t):
    tf = t.astype(F32)
    return (tf * lax.rsqrt(jnp.sum(tf * tf, axis=-1, keepdims=True) + EPS)).astype(t.dtype)


def rope_tables(positions):
    inv = ROPE_THETA ** (-jnp.arange(0, MLA_ROPE, 2, dtype=F32) / MLA_ROPE)
    ang = positions.astype(F32)[..., None] * inv
    return jnp.cos(ang)[:, :, None, :], jnp.sin(ang)[:, :, None, :]


def apply_rope(t, cos, sin):
    half = t.shape[-1] // 2
    t1, t2 = t[..., :half], t[..., half:]
    return jnp.concatenate([t1 * cos - t2 * sin, t2 * cos + t1 * sin], axis=-1).astype(t.dtype)


def block_dense_attention(q, k, v):
    B, S, H, D = q.shape
    scale = D ** -0.5
    kf = k.astype(F32)
    vf = v.astype(F32)
    qb = jnp.moveaxis(q.reshape(B, S // Q_BLOCK, Q_BLOCK, H, D), 1, 0)

    def attend(q_blk):
        s = jnp.einsum('bqhd,bkhd->bhqk', q_blk.astype(F32), kf) * scale
        p = jax.nn.softmax(s, axis=-1)
        return jnp.einsum('bhqk,bkhd->bqhd', p, vf)

    o = lax.map(attend, qb)
    return jnp.moveaxis(o, 0, 1).reshape(B, S, H, v.shape[-1]).astype(q.dtype)


def mla_group(mla_in, cos, sin, q_a_norm_w, w_q_up, kv_a_norm_w, w_kv_up):
    B, S, _ = mla_in.shape
    c_q = rmsnorm(mla_in[..., :MLA_Q_RANK], q_a_norm_w)
    c_kv = rmsnorm(mla_in[..., MLA_Q_RANK:MLA_Q_RANK + MLA_KV_RANK], kv_a_norm_w)
    k_pe = mla_in[..., MLA_Q_RANK + MLA_KV_RANK:]
    q = (c_q @ w_q_up).reshape(B, S, MLA_HEADS, MLA_NOPE + MLA_ROPE)
    q = jnp.concatenate([q[..., :MLA_NOPE], apply_rope(q[..., MLA_NOPE:], cos, sin)], axis=-1)
    kv = (c_kv @ w_kv_up).reshape(B, S, MLA_HEADS, MLA_NOPE + MLA_VDIM)
    k_pe = apply_rope(k_pe[:, :, None, :], cos, sin)
    k = jnp.concatenate([kv[..., :MLA_NOPE], jnp.broadcast_to(k_pe, (B, S, MLA_HEADS, MLA_ROPE))], axis=-1)
    v = kv[..., MLA_NOPE:]
    o = block_dense_attention(q, k, v)
    return o.reshape(B, S, MLA_WIDTH)


def centred_depthwise_conv(t, w):
    C = t.shape[-1]
    pad = CONV_K // 2
    return lax.conv_general_dilated(
        t, w.astype(t.dtype)[:, None, :], window_strides=(1,), padding=[(pad, pad)],
        dimension_numbers=('NWC', 'WIO', 'NWC'), feature_group_count=C)


def gated_delta_chunked(q, k, v, g, beta):
    dtype = v.dtype
    q, k, v, g, beta = (t.astype(F32) for t in (q, k, v, g, beta))
    B, H, S, DK = k.shape
    DV = v.shape[-1]
    NC = S // CHUNK
    q = q * (DK ** -0.5)

    def chunks(t):
        return t.reshape(B, H, NC, CHUNK, *t.shape[3:])

    q, k, v, g, beta = (chunks(t) for t in (q, k, v, g, beta))
    g = jnp.cumsum(g, axis=-1)
    idx = jnp.arange(CHUNK)
    incl = idx[:, None] >= idx[None, :]
    strict = idx[:, None] > idx[None, :]
    diff = g[..., :, None] - g[..., None, :]
    decay = jnp.where(incl, jnp.exp(jnp.where(incl, diff, 0.0)), 0.0)
    k_beta = k * beta[..., None]
    v_beta = v * beta[..., None]
    lower = jnp.where(strict, jnp.einsum('bhnid,bhnjd->bhnij', k_beta, k) * decay, 0.0)
    a_mat = lower + jnp.eye(CHUNK, dtype=F32)
    rhs = jnp.concatenate([v_beta, k_beta * jnp.exp(g)[..., None]], axis=-1)
    sol = lax.linalg.triangular_solve(a_mat, rhs, left_side=True, lower=True, unit_diagonal=True)
    u, w = sol[..., :DV], sol[..., DV:]
    attn = jnp.where(incl, jnp.einsum('bhnid,bhnjd->bhnij', q, k) * decay, 0.0)
    g_last = g[..., -1]
    q_dec = q * jnp.exp(g)[..., None]
    k_dec = k * jnp.exp(g_last[..., None] - g)[..., None]
    xs = tuple(jnp.moveaxis(t, 2, 0) for t in (q_dec, k_dec, u, w, attn, g_last))

    def step(state, inp):
        qd, kd, uc, wc, ac, gl = inp
        v_new = uc - jnp.einsum('bhck,bhkv->bhcv', wc, state)
        o = jnp.einsum('bhck,bhkv->bhcv', qd, state) + jnp.einsum('bhij,bhjv->bhiv', ac, v_new)
        state = state * jnp.exp(gl)[..., None, None] + jnp.einsum('bhck,bhcv->bhkv', kd, v_new)
        return state, o

    state0 = jnp.zeros((B, H, DK, DV), F32)
    _, o = lax.scan(step, state0, xs)
    o = jnp.moveaxis(o, 0, 2).reshape(B, H, S, DV)
    return o.astype(dtype)


def gdn_group(gdn_in, conv_w, a_log_f, dt_bias_f, a_log_b, dt_bias_b, norm_w):
    B, S, _ = gdn_in.shape
    qkv = gdn_in[..., :GDN_QKV]
    z = gdn_in[..., GDN_QKV:GDN_QKV + GDN_WIDTH].reshape(B, S, GDN_HEADS, GDN_DV)
    gates = gdn_in[..., GDN_QKV + GDN_WIDTH:].reshape(B, S, 4, GDN_HEADS)
    a_f, b_f, a_b, b_b = gates[:, :, 0], gates[:, :, 1], gates[:, :, 2], gates[:, :, 3]
    qkv = jax.nn.silu(centred_depthwise_conv(qkv, conv_w))
    nq = GDN_HEADS * GDN_DK
    q = l2norm(qkv[..., :nq].reshape(B, S, GDN_HEADS, GDN_DK))
    k = l2norm(qkv[..., nq:2 * nq].reshape(B, S, GDN_HEADS, GDN_DK))
    v = qkv[..., 2 * nq:].reshape(B, S, GDN_HEADS, GDN_DV)
    af = a_f.astype(F32)
    ab = a_b.astype(F32)
    g_f = -jnp.exp(a_log_f.astype(F32)) * jax.nn.softplus(af + dt_bias_f.astype(F32))
    g_b = -jnp.exp(a_log_b.astype(F32)) * jax.nn.softplus(ab + dt_bias_b.astype(F32))
    beta_f = jax.nn.sigmoid(b_f.astype(F32))
    beta_b = jax.nn.sigmoid(b_b.astype(F32))
    qt, kt, vt = (jnp.moveaxis(t, 2, 1) for t in (q, k, v))
    g_ft, g_bt, be_ft, be_bt = (jnp.moveaxis(t, 2, 1) for t in (g_f, g_b, beta_f, beta_b))
    o_f = gated_delta_chunked(qt, kt, vt, g_ft, be_ft)
    flip = lambda t: jnp.flip(t, axis=2)
    o_b = flip(gated_delta_chunked(flip(qt), flip(kt), flip(vt), flip(g_bt), flip(be_bt)))
    o = jnp.moveaxis(o_f + o_b, 1, 2)
    o = rmsnorm(o, norm_w) * jax.nn.silu(z)
    return o.reshape(B, S, GDN_WIDTH)


def peer_ffn(xn, w_q, sub_keys, u_tab, v_tab):
    B, S, D = xn.shape
    T = B * S
    xt = xn.reshape(T, D)
    q = (xt @ w_q).reshape(T, PEER_HEADS, 2, PEER_HALF)
    scores = jnp.einsum('thpd,hpnd->thpn', q, sub_keys).astype(F32)
    s_top, i_top = lax.top_k(scores, PEER_TOPK)
    cand = s_top[:, :, 0, :, None] + s_top[:, :, 1, None, :]
    cand_idx = i_top[:, :, 0, :, None] * PEER_NKEYS + i_top[:, :, 1, None, :]
    f_s, f_i = lax.top_k(cand.reshape(T, PEER_HEADS, PEER_TOPK * PEER_TOPK), PEER_TOPK)
    experts = jnp.take_along_axis(cand_idx.reshape(T, PEER_HEADS, PEER_TOPK * PEER_TOPK), f_i, axis=-1)
    gates = jax.nn.softmax(f_s, axis=-1)
    nb = T // TOKEN_BLOCK
    xb = xt.reshape(nb, TOKEN_BLOCK, D)
    eb = experts.reshape(nb, TOKEN_BLOCK, PEER_HEADS * PEER_TOPK)
    gb = gates.reshape(nb, TOKEN_BLOCK, PEER_HEADS * PEER_TOPK)

    def blk(args):
        xc, ec, gc = args
        uc = u_tab[ec]
        hid = jax.nn.gelu(jnp.einsum('td,ted->te', xc, uc).astype(F32), approximate=False)
        vc = v_tab[ec]
        return jnp.einsum('te,ted->td', (gc * hid).astype(vc.dtype), vc)

    out = lax.map(blk, (xb, eb, gb))
    return out.reshape(B, S, D).astype(xn.dtype)


def setup_inputs(seed: int = 0) -> dict:
    key = jax.random.key(seed)
    ks = jax.random.split(key, 24)
    L = DEPTH

    def nrm(k, shape, scale):
        return jax.random.normal(k, shape, F32) * scale

    def gain(k, shape):
        return 1.0 + 0.01 * jax.random.normal(k, shape, F32)

    def dt_bias(k):
        dt = jnp.exp(jax.random.uniform(k, (L, GDN_HEADS), F32, math.log(1e-3), math.log(1e-1)))
        return dt + jnp.log(-jnp.expm1(-dt))

    x = nrm(ks[0], (BATCH, SEQ, D_MODEL), 1.0)
    positions = jnp.arange(SEQ, dtype=jnp.int32)[None, :] + jax.random.randint(ks[1], (BATCH, 1), 0, 1024, dtype=jnp.int32)
    return {
        'x': x,
        'positions': positions,
        'ln1_w': gain(ks[2], (L, D_MODEL)),
        'w_in': nrm(ks[3], (L, D_MODEL, IN_WIDTH), D_MODEL ** -0.5),
        'q_a_norm_w': gain(ks[4], (L, MLA_Q_RANK)),
        'w_q_up': nrm(ks[5], (L, MLA_Q_RANK, MLA_HEADS * (MLA_NOPE + MLA_ROPE)), MLA_Q_RANK ** -0.5),
        'kv_a_norm_w': gain(ks[6], (L, MLA_KV_RANK)),
        'w_kv_up': nrm(ks[7], (L, MLA_KV_RANK, MLA_HEADS * (MLA_NOPE + MLA_VDIM)), MLA_KV_RANK ** -0.5),
        'conv_w': nrm(ks[8], (L, CONV_K, GDN_QKV), CONV_K ** -0.5),
        'a_log_f': jnp.log(jax.random.uniform(ks[9], (L, GDN_HEADS), F32, 1.0, 16.0)),
        'dt_bias_f': dt_bias(ks[10]),
        'a_log_b': jnp.log(jax.random.uniform(ks[11], (L, GDN_HEADS), F32, 1.0, 16.0)),
        'dt_bias_b': dt_bias(ks[12]),
        'gdn_norm_w': gain(ks[13], (L, GDN_DV)),
        'w_out': nrm(ks[14], (L, MIX_WIDTH, D_MODEL), MIX_WIDTH ** -0.5),
        'ln2_w': gain(ks[15], (L, D_MODEL)),
        'peer_wq': nrm(ks[16], (L, D_MODEL, PEER_HEADS * PEER_QDIM), D_MODEL ** -0.5),
        'peer_sub_keys': nrm(ks[17], (L, PEER_HEADS, 2, PEER_NKEYS, PEER_HALF), PEER_HALF ** -0.5),
        'peer_u': nrm(ks[18], (L, PEER_EXPERTS, D_MODEL), D_MODEL ** -0.5),
        'peer_v': nrm(ks[19], (L, PEER_EXPERTS, D_MODEL), PEER_HEADS ** -0.5),
        'final_norm_w': gain(ks[20], (D_MODEL,)),
    }


def reference(x, positions, ln1_w, w_in, q_a_norm_w, w_q_up, kv_a_norm_w, w_kv_up, conv_w,
              a_log_f, dt_bias_f, a_log_b, dt_bias_b, gdn_norm_w, w_out, ln2_w,
              peer_wq, peer_sub_keys, peer_u, peer_v, final_norm_w):
    cos, sin = rope_tables(positions)
    h = x
    for i in range(DEPTH):
        n1 = rmsnorm(h, ln1_w[i])
        proj = n1 @ w_in[i]
        o_mla = mla_group(proj[..., :MLA_IN], cos, sin, q_a_norm_w[i], w_q_up[i], kv_a_norm_w[i], w_kv_up[i])
        o_gdn = gdn_group(proj[..., MLA_IN:], conv_w[i], a_log_f[i], dt_bias_f[i], a_log_b[i], dt_bias_b[i], gdn_norm_w[i])
        h = h + jnp.concatenate([o_mla, o_gdn], axis=-1) @ w_out[i]
        n2 = rmsnorm(h, ln2_w[i])
        h = h + peer_ffn(n2, peer_wq[i], peer_sub_keys[i], peer_u[i], peer_v[i])
    return rmsnorm(h, final_norm_w)
```

```cpp
#include <hip/hip_runtime.h>
#include <hip/hip_cooperative_groups.h>
#include <cstdio>
#include <cstdint>
namespace cg = cooperative_groups;

#ifndef PROBE_PH
#define PROBE_PH -1
#endif
constexpr int D_MODEL = 1024, BATCH = 2, SEQ = 8192, T = BATCH * SEQ;
constexpr int MLA_H = 4, QRANK = 256, KVRANK = 128, NOPE = 128, ROPE = 64, VDIM = 128, QKD = 192;
constexpr int GH = 4, DK = 128, DV = 128, CHUNK = 64, NCH = SEQ / CHUNK;
constexpr int GDN_QKV = 1536, IN_W = 2512, IN_WP = 2560;
constexpr int C_QKV = 448, C_Z = 1984, C_GATE = 2496;
constexpr int PH = 8, NKEYS = 128, TOPK = 16, NEXP = 16384;
constexpr float EPS = 1e-6f;
constexpr int NT = 512;

typedef unsigned short bf16_t;
typedef float f32x4 __attribute__((ext_vector_type(4)));
typedef unsigned u32x4 __attribute__((ext_vector_type(4)));
typedef unsigned u32x2 __attribute__((ext_vector_type(2)));

__device__ __forceinline__ int opaque_tid() { int t; asm volatile("v_mov_b32 %0, %1" : "=v"(t) : "v"((int)threadIdx.x)); return t; }
__device__ __forceinline__ float bf2f(bf16_t v) { return __uint_as_float((unsigned)v << 16); }
__device__ __forceinline__ bf16_t f2bf(float f) { unsigned u = __float_as_uint(f); u += 0x7fffu + ((u >> 16) & 1u); return (bf16_t)(u >> 16); }
__device__ __forceinline__ float bflo(unsigned w) { return __uint_as_float(w << 16); }
__device__ __forceinline__ float bfhi(unsigned w) { return __uint_as_float(w & 0xffff0000u); }
__device__ __forceinline__ unsigned pk2(float lo, float hi) { return (unsigned)f2bf(lo) | ((unsigned)f2bf(hi) << 16); }
__device__ __forceinline__ float wave_sum(float v) {
#pragma unroll
    for (int o = 1; o < 64; o <<= 1) v += __shfl_xor(v, o);
    return v;
}
__device__ __forceinline__ float sigmoidf_(float x) { return 1.f / (1.f + __expf(-x)); }
__device__ __forceinline__ float siluf_(float x) { return x * sigmoidf_(x); }
__device__ __forceinline__ float softplusf_(float x) { return x > 20.f ? x : log1pf(expf(x)); }
__device__ __forceinline__ float gelu_erf(float x) { return 0.5f * x * (1.f + erff(x * 0.70710678118654752f)); }

namespace pg8 {
#define PG8_LAS __attribute__((address_space(3)))
typedef unsigned short bf16_t;
typedef short bf16x8 __attribute__((ext_vector_type(8)));
typedef float f32x4 __attribute__((ext_vector_type(4)));
typedef unsigned u32x4 __attribute__((ext_vector_type(4)));
constexpr int BM = 256, BK = 64, HALF = 128, HTB = HALF * BK * 2  , STAGE_BYTES = 8 * HTB, NXCD = 8, WGM = 8;

__host__ __device__ __forceinline__ int lds_byte(int r, int c) { const int st = (r >> 4) * 2 + (c >> 5), rr = r & 15, cc = c & 31, ob = rr * 64 + cc * 2; return st * 1024 + (ob ^ (((ob >> 9) & 1) << 5)); }
__host__ __device__ __forceinline__ void stage_rc(int b, int& R, int& C) { const int st = b / 1024, sb = b % 1024, swz = sb ^ (((sb >> 9) & 1) << 5); R = (st >> 1) * 16 + swz / 64; C = (st & 1) * 32 + (swz % 64) / 2; }
__host__ __device__ __forceinline__ int perm32(int rho) { const int n = rho >> 4, i = rho & 15; return 8 * (i >> 2) + 4 * n + (i & 3); }

struct Unit { int pm, pn; };
struct Gemm { const bf16_t* A; const bf16_t* Bt; int M, N, K, lda, ldb; };

struct StaticOrder {
    int nM, nN, nwg, G, c;
    __host__ __device__ void init(int M, int N, int G_, int c_) { nM = M / BM; nN = N / BM; nwg = nM * nN; G = G_; c = c_; }
    __host__ __device__ bool next(int i, Unit& u) const {
        const long L = (long)i * G + c; if (L >= nwg) return false;
        int wgid = (int)L; { const int q = nwg / NXCD, r = nwg % NXCD, xcd = wgid % NXCD, off = wgid / NXCD; wgid = (xcd < r ? xcd * (q + 1) : r * (q + 1) + (xcd - r) * q) + off; }
        const int nig = WGM * nN, gid = wgid / nig, fm = gid * WGM, gsz = (nM - fm) < WGM ? (nM - fm) : WGM;
        u.pm = fm + ((wgid % nig) % gsz); u.pn = (wgid % nig) / gsz; return true;
    }
    __device__ __forceinline__ void a_ready(const Unit&) const {}
    __device__ __forceinline__ void done(const Unit&) const {}
};
__device__ __forceinline__ unsigned cvt_pk_bf16(float lo, float hi) { unsigned r; asm volatile("v_cvt_pk_bf16_f32 %0, %1, %2" : "=v"(r) : "v"(lo), "v"(hi)); return r; }
typedef float f32x2 __attribute__((ext_vector_type(2)));
template <class Epi, class Sched, bool ALIGN_EPI = false, bool SP2 = false>
__device__ __forceinline__ void gemm_phase(PG8_LAS unsigned char* lds, const Gemm g, const Sched& S, const Epi& E) {
    const int tid = opaque_tid(), wid = __builtin_amdgcn_readfirstlane(tid >> 6), lane = tid & 63, wr = wid >> 2, wc = wid & 3, fr = lane & 15, fq = lane >> 4;
    const int K = g.K, nt = K / BK;
    unsigned voffA[2], voffB[2];
#pragma unroll
    for (int i = 0; i < 2; ++i) { int R, C; stage_rc(tid * 16 + i * 8192, R, C); const int Rb = Epi::PERM ? ((R & ~31) + perm32(R & 31)) : R;
        voffA[i] = (unsigned)(R * g.lda + C) * 2u; voffB[i] = (unsigned)(Rb * g.ldb + C) * 2u; }
    const size_t kstep = (size_t)(BK * 2);
    const size_t hstepA = (size_t)HALF * g.lda * 2, hstepB = (size_t)HALF * g.ldb * 2;
    const size_t tstepA = 2 * hstepA, tstepB = 2 * hstepB;
    const unsigned ldsw = (unsigned)wid * 1024u;
    const int aoff = lds_byte(wr * 64 + fr, fq * 8), boff = lds_byte(wc * 32 + fr, fq * 8);
#define PG8_SA(b, h) (((b) * 2 + (h)) * HTB)
#define PG8_SB(b, h) ((4 + (b) * 2 + (h)) * HTB)
#define PG8_STAGE(bufoff, gbase, voff) do { _Pragma("unroll") for (int _i = 0; _i < 2; ++_i) \
        __builtin_amdgcn_global_load_lds((const unsigned*)((const char*)(gbase) + (voff)[_i]), (PG8_LAS unsigned*)(lds + (bufoff) + ldsw + _i * 8192), 16, 0, 0); } while (0)
#define PG8_LDA(dst, b, h) do { _Pragma("unroll") for (int m = 0; m < 4; ++m) _Pragma("unroll") for (int k = 0; k < 2; ++k) dst[m][k] = *(const PG8_LAS bf16x8*)(lds + PG8_SA(b, h) + aoff + m * 2048 + k * 1024); } while (0)
#define PG8_LDB(dst, b, h) do { _Pragma("unroll") for (int n = 0; n < 2; ++n) _Pragma("unroll") for (int k = 0; k < 2; ++k) dst[n][k] = *(const PG8_LAS bf16x8*)(lds + PG8_SB(b, h) + boff + n * 2048 + k * 1024); } while (0)
#define PG8_MMA(ai, bj, At, Bt) do { __builtin_amdgcn_s_setprio(1); _Pragma("unroll") for (int m = 0; m < 4; ++m) _Pragma("unroll") for (int n = 0; n < 2; ++n) _Pragma("unroll") for (int k = 0; k < 2; ++k) \
        acc[ai][bj][m][n] = __builtin_amdgcn_mfma_f32_16x16x32_bf16(Bt[n][k], At[m][k], acc[ai][bj][m][n], 0, 0, 0); __builtin_amdgcn_s_setprio(0); } while (0)
#define PG8_WAIT_V(n) asm volatile("s_waitcnt vmcnt(" #n ")" ::: "memory")
#define PG8_WAIT_L(n) asm volatile("s_waitcnt lgkmcnt(" #n ")" ::: "memory")
#define PG8_BAR __builtin_amdgcn_s_barrier()
#define PG8_SCHED __builtin_amdgcn_sched_barrier(0)
    Unit cur, nxt; int ui = 0;
    if (!S.next(0, cur)) return;
    f32x4 acc[2][2][4][2];
#pragma unroll
    for (int a = 0; a < 2; ++a)
#pragma unroll
        for (int b = 0; b < 2; ++b)
#pragma unroll
            for (int m = 0; m < 4; ++m)
#pragma unroll
                for (int n = 0; n < 2; ++n) acc[a][b][m][n] = (f32x4){0.f, 0.f, 0.f, 0.f};
    bf16x8 At[4][2], B0[2][2], B1[2][2];
    const char* cA = (const char*)g.A + (size_t)cur.pm * tstepA; const char* cB = (const char*)g.Bt + (size_t)cur.pn * tstepB;
    S.a_ready(cur);
    if constexpr (SP2) {
        PG8_STAGE(PG8_SB(0, 0), cB, voffB); PG8_STAGE(PG8_SB(0, 1), cB + hstepB, voffB); PG8_STAGE(PG8_SA(0, 0), cA, voffA); PG8_STAGE(PG8_SA(0, 1), cA + hstepA, voffA);
        if (wr == 1) PG8_BAR;
        PG8_WAIT_V(2); PG8_BAR;
        PG8_STAGE(PG8_SB(1, 0), cB + kstep, voffB); PG8_STAGE(PG8_SA(1, 0), cA + kstep, voffA); PG8_STAGE(PG8_SB(1, 1), cB + hstepB + kstep, voffB);
        PG8_WAIT_V(6); PG8_BAR;
    } else {
        PG8_STAGE(PG8_SB(0, 0), cB, voffB); PG8_STAGE(PG8_SA(0, 0), cA, voffA); PG8_STAGE(PG8_SB(0, 1), cB + hstepB, voffB); PG8_STAGE(PG8_SA(0, 1), cA + hstepA, voffA);
        if (wr == 1) PG8_BAR;
        PG8_WAIT_V(4); PG8_BAR;
        PG8_STAGE(PG8_SB(1, 0), cB + kstep, voffB); PG8_STAGE(PG8_SA(1, 0), cA + kstep, voffA); PG8_STAGE(PG8_SB(1, 1), cB + hstepB + kstep, voffB);
        PG8_WAIT_V(6); PG8_BAR;
    }
    for (;;) {
        const bool has_next = S.next(ui + 1, nxt);
        const char* nA = has_next ? (const char*)g.A + (size_t)nxt.pm * tstepA : cA; const char* nB = has_next ? (const char*)g.Bt + (size_t)nxt.pn * tstepB : cB;
        for (int t = 0; t < nt; t += 2) {
            const bool last = (t == nt - 2);
            const char* a1 = cA + (size_t)(t + 1) * kstep;
            const char* a2 = last ? nA : cA + (size_t)(t + 2) * kstep; const char* b2 = last ? nB : cB + (size_t)(t + 2) * kstep;
            const char* a3 = a2 + kstep; const char* b3 = b2 + kstep;
            if (last && has_next) S.a_ready(nxt);
            if constexpr (SP2) {
            PG8_LDB(B0, 0, 0); PG8_LDB(B1, 0, 1); PG8_SCHED; PG8_LDA(At, 0, 0); PG8_STAGE(PG8_SA(1, 1), a1 + hstepA, voffA);
            PG8_WAIT_V(8); PG8_WAIT_L(0); PG8_BAR; PG8_MMA(0, 0, At, B0); PG8_MMA(0, 1, At, B1); PG8_BAR; PG8_SCHED;
            PG8_LDA(At, 0, 1); PG8_STAGE(PG8_SB(0, 0), b2, voffB); PG8_STAGE(PG8_SB(0, 1), b2 + hstepB, voffB); PG8_STAGE(PG8_SA(0, 0), a2, voffA);
            PG8_WAIT_V(8); PG8_WAIT_L(0); PG8_BAR; PG8_MMA(1, 0, At, B0); PG8_MMA(1, 1, At, B1); PG8_BAR; PG8_SCHED;
            PG8_LDB(B0, 1, 0); PG8_LDB(B1, 1, 1); PG8_SCHED; PG8_LDA(At, 1, 0); PG8_STAGE(PG8_SA(0, 1), a2 + hstepA, voffA);
            PG8_WAIT_V(8); PG8_WAIT_L(0); PG8_BAR; PG8_MMA(0, 0, At, B0); PG8_MMA(0, 1, At, B1); PG8_BAR; PG8_SCHED;
            PG8_LDA(At, 1, 1); PG8_STAGE(PG8_SB(1, 0), b3, voffB); PG8_STAGE(PG8_SB(1, 1), b3 + hstepB, voffB); PG8_STAGE(PG8_SA(1, 0), a3, voffA);
            PG8_WAIT_V(8); PG8_WAIT_L(0); PG8_BAR; PG8_MMA(1, 0, At, B0); PG8_MMA(1, 1, At, B1); PG8_BAR; PG8_SCHED;
            } else {
            PG8_LDB(B0, 0, 0); PG8_SCHED; PG8_LDA(At, 0, 0); PG8_STAGE(PG8_SA(1, 1), a1 + hstepA, voffA);
            PG8_WAIT_L(8); PG8_BAR; PG8_WAIT_L(0); PG8_MMA(0, 0, At, B0); PG8_BAR; PG8_SCHED;
            PG8_LDB(B1, 0, 1); PG8_STAGE(PG8_SB(0, 0), b2, voffB);
            PG8_BAR; PG8_WAIT_L(0); PG8_MMA(0, 1, At, B1); PG8_BAR;
            PG8_LDA(At, 0, 1); PG8_STAGE(PG8_SA(0, 0), a2, voffA);
            PG8_BAR; PG8_WAIT_L(0); PG8_MMA(1, 0, At, B0); PG8_BAR; PG8_SCHED;
            PG8_STAGE(PG8_SB(0, 1), b2 + hstepB, voffB);
            PG8_WAIT_V(6); PG8_BAR; PG8_MMA(1, 1, At, B1); PG8_BAR;
            PG8_LDB(B0, 1, 0); PG8_SCHED; PG8_LDA(At, 1, 0); PG8_STAGE(PG8_SA(0, 1), a2 + hstepA, voffA);
            PG8_WAIT_L(8); PG8_BAR; PG8_WAIT_L(0); PG8_MMA(0, 0, At, B0); PG8_BAR; PG8_SCHED;
            PG8_LDB(B1, 1, 1); PG8_STAGE(PG8_SB(1, 0), b3, voffB);
            PG8_BAR; PG8_WAIT_L(0); PG8_MMA(0, 1, At, B1); PG8_BAR;
            PG8_LDA(At, 1, 1); PG8_STAGE(PG8_SA(1, 0), a3, voffA);
            PG8_BAR; PG8_WAIT_L(0); PG8_MMA(1, 0, At, B0); PG8_BAR; PG8_SCHED;
            PG8_STAGE(PG8_SB(1, 1), b3 + hstepB, voffB);
            PG8_WAIT_V(6); PG8_BAR; PG8_MMA(1, 1, At, B1); PG8_BAR;
            }
        }
        if constexpr (ALIGN_EPI) { if (wr == 0) PG8_BAR; }
        if constexpr (!Epi::AFTER_DRAIN) { E(acc, cur, wr, wc, fr, fq); S.done(cur); }
        if (!has_next) break;
#pragma unroll
        for (int a = 0; a < 2; ++a)
#pragma unroll
            for (int b = 0; b < 2; ++b)
#pragma unroll
                for (int m = 0; m < 4; ++m)
#pragma unroll
                    for (int n = 0; n < 2; ++n) acc[a][b][m][n] = (f32x4){0.f, 0.f, 0.f, 0.f};
        cur = nxt; cA = nA; cB = nB; ++ui;
        if constexpr (ALIGN_EPI) { if (wr == 1) PG8_BAR; }
    }
    PG8_WAIT_V(0);
    if constexpr (!ALIGN_EPI) { if (wr == 0) PG8_BAR; }
    PG8_BAR;
    if constexpr (Epi::AFTER_DRAIN) { E.fused(acc, cur, wr, wc, fr, fq, lds, wid, lane); S.done(cur); }
#undef PG8_SA
#undef PG8_SB
#undef PG8_STAGE
#undef PG8_LDA
#undef PG8_LDB
#undef PG8_MMA
#undef PG8_WAIT_V
#undef PG8_WAIT_L
#undef PG8_BAR
#undef PG8_SCHED
}

struct EpiScaleBf16 {
    static constexpr bool PERM = true, AFTER_DRAIN = false;
    bf16_t* O; int ldc; const float* rs;
    __device__ __forceinline__ void operator()(const f32x4 (&acc)[2][2][4][2], const Unit& u, int wr, int wc, int fr, int fq) const {
        const int row0 = u.pm * BM + wr * 64 + fr, col0 = u.pn * BM + wc * 32 + 8 * fq;
#pragma unroll
        for (int ai = 0; ai < 2; ++ai)
#pragma unroll
            for (int m = 0; m < 4; ++m) { const int r = row0 + ai * HALF + m * 16; const float sc = rs ? rs[r] : 1.f; bf16_t* rowp = O + (size_t)r * ldc + col0;
#pragma unroll
                for (int bj = 0; bj < 2; ++bj) { const f32x4 v0 = acc[ai][bj][m][0] * sc, v1 = acc[ai][bj][m][1] * sc;
                    u32x4 w; w.x = cvt_pk_bf16(v0[0], v0[1]); w.y = cvt_pk_bf16(v0[2], v0[3]); w.z = cvt_pk_bf16(v1[0], v1[1]); w.w = cvt_pk_bf16(v1[2], v1[3]);
                    *(u32x4*)(rowp + bj * HALF) = w; } }
    }
};
struct EpiResF32 {
    static constexpr bool PERM = false, AFTER_DRAIN = false;
    const float* base; float* out; int ldc;
    __device__ __forceinline__ void operator()(const f32x4 (&acc)[2][2][4][2], const Unit& u, int wr, int wc, int fr, int fq) const {
        const int row0 = u.pm * BM + wr * 64 + fr, col0 = u.pn * BM + wc * 32 + 4 * fq;
#pragma unroll
        for (int ai = 0; ai < 2; ++ai)
#pragma unroll
            for (int m = 0; m < 4; ++m) { const size_t off = (size_t)(row0 + ai * HALF + m * 16) * ldc + col0;
#pragma unroll
                for (int bj = 0; bj < 2; ++bj)
#pragma unroll
                    for (int n = 0; n < 2; ++n) { const f32x4 b = *(const f32x4*)(base + off + bj * HALF + n * 16); *(f32x4*)(out + off + bj * HALF + n * 16) = b + acc[ai][bj][m][n]; } }
    }
};
struct EpiResF32Hb {
    static constexpr bool PERM = false, AFTER_DRAIN = false;
    const float* base; float* out; bf16_t* hb; float* sumsq; int ldc;
    __device__ __forceinline__ void operator()(const f32x4 (&acc)[2][2][4][2], const Unit& u, int wr, int wc, int fr, int fq) const {
        const int row0 = u.pm * BM + wr * 64 + fr, col0 = u.pn * BM + wc * 32 + 4 * fq;
#pragma unroll
        for (int ai = 0; ai < 2; ++ai)
#pragma unroll
            for (int m = 0; m < 4; ++m) { const int r = row0 + ai * HALF + m * 16; const size_t off = (size_t)r * ldc + col0; float ss = 0.f;
#pragma unroll
                for (int bj = 0; bj < 2; ++bj)
#pragma unroll
                    for (int n = 0; n < 2; ++n) { const f32x4 o = *(const f32x4*)(base + off + bj * HALF + n * 16) + acc[ai][bj][m][n];
                        *(f32x4*)(out + off + bj * HALF + n * 16) = o; ss += o[0] * o[0] + o[1] * o[1] + o[2] * o[2] + o[3] * o[3];
                        typedef unsigned u32x2v __attribute__((ext_vector_type(2))); u32x2v w; w.x = cvt_pk_bf16(o[0], o[1]); w.y = cvt_pk_bf16(o[2], o[3]);
                        *(u32x2v*)(hb + off + bj * HALF + n * 16) = w; }
                ss += __shfl_xor(ss, 16); ss += __shfl_xor(ss, 32);
                if (fq == 0) unsafeAtomicAdd(sumsq + r, ss); }
    }
};
}

#define XB_TMO      128
#define XB_XCNT(j)  (256  + 64 * (j))
#define XB_XSUB(j)  (1280 + 64 * (j))
#define XB_XGEN(j)  (2304 + 64 * (j))
#define XB_TOP      3328
#define XB_TOPGEN   3392
#define XCD_BAR_WORDS 3456
#define XB_SPIN_CAP (1u << 18)
#define LAS __attribute__((address_space(3)))

__device__ __forceinline__ unsigned xb_ld(unsigned* p)              { return __hip_atomic_load(p, __ATOMIC_RELAXED, __HIP_MEMORY_SCOPE_AGENT); }
__device__ __forceinline__ unsigned xb_add(unsigned* p, unsigned v) { return __hip_atomic_fetch_add(p, v, __ATOMIC_RELAXED, __HIP_MEMORY_SCOPE_AGENT); }
__device__ __forceinline__ unsigned xb_xcc_id() { return (unsigned)__builtin_amdgcn_s_getreg((3 << 11) | 20) & 0xFu; }
#define XB_SPIN(cond, bar) do { unsigned _sp = 0; while (cond) { __builtin_amdgcn_s_sleep(1); \
    if ((++_sp & 255u) == 0u) { if (xb_ld(&(bar)[XB_TMO])) break; if (_sp > XB_SPIN_CAP) { atomicAdd(&(bar)[XB_TMO], 1u); break; } } } } while (0)

struct XcdBarrier {
    unsigned* bar; unsigned x;
    volatile LAS unsigned* st;
};

__device__ __forceinline__ XcdBarrier xcd_barrier_post(unsigned* bar, volatile LAS unsigned* st) {
    XcdBarrier b; b.bar = bar; b.x = xb_xcc_id(); b.st = st;
    if (threadIdx.x == 0) (void)xb_add(&bar[XB_XCNT(b.x)], 1u);
    return b;
}
__device__ __forceinline__ void xcd_barrier_complete(unsigned* bar, unsigned x, unsigned& nloc, unsigned& nx) {
    const unsigned G = gridDim.x * gridDim.y * gridDim.z;
    unsigned sum, cnt, mine, sp = 0u;
    for (;;) {
        sum = 0u; cnt = 0u; mine = 0u;
#pragma unroll
        for (unsigned j = 0; j < 16; ++j) { const unsigned c = xb_ld(&bar[XB_XCNT(j)]); sum += c; cnt += (c > 0u) ? 1u : 0u; mine = (j == x) ? c : mine; }
        if (sum == G) break;
        __builtin_amdgcn_s_sleep(1);
        if ((++sp & 255u) == 0u) { if (xb_ld(&bar[XB_TMO])) break; if (sp > XB_SPIN_CAP) { atomicAdd(&bar[XB_TMO], 1u); break; } }
    }
    nloc = mine > 0u ? mine : 1u; nx = cnt > 0u ? cnt : 1u;
}

__device__ __forceinline__ void xcd_barrier(const XcdBarrier& b) {
    asm volatile("s_waitcnt vmcnt(0)" ::: "memory");
    __syncthreads();
    if (threadIdx.x == 0) {
        unsigned* bar = b.bar;
        __builtin_amdgcn_s_waitcnt(0);
        unsigned nloc = b.st[0], nx = b.st[1];
        if (nloc == 0u) { xcd_barrier_complete(bar, b.x, nloc, nx); b.st[0] = nloc; b.st[1] = nx; }
        const unsigned old = xb_add(&bar[XB_XSUB(b.x)], 1u);
        const unsigned gen = old / nloc;
        if (old + 1u == (gen + 1u) * nloc) {
            __builtin_amdgcn_fence(__ATOMIC_RELEASE, "agent");
            asm volatile("s_waitcnt vmcnt(0)" ::: "memory");
            const unsigned og = xb_add(&bar[XB_TOP], 1u);
            const unsigned tg = og / nx;
            if (og + 1u == (tg + 1u) * nx) xb_add(&bar[XB_TOPGEN], 1u);
            else XB_SPIN(xb_ld(&bar[XB_TOPGEN]) == tg, bar);
            __builtin_amdgcn_fence(__ATOMIC_ACQUIRE, "agent");
            xb_add(&bar[XB_XGEN(b.x)], 1u);
            asm volatile("s_waitcnt vmcnt(0)" ::: "memory");
        } else {
            XB_SPIN(xb_ld(&bar[XB_XGEN(b.x)]) == gen, bar);
            __builtin_amdgcn_fence(__ATOMIC_ACQUIRE, "agent");
            asm volatile("s_waitcnt vmcnt(0)" ::: "memory");
        }
    }
    __syncthreads();
}

constexpr size_t MB = 1u << 20;
constexpr size_t OFF_WIN = 0;
constexpr size_t OFF_WQUP = 5 * MB;
constexpr size_t OFF_WKVUP = 5 * MB + 512 * 1024;
constexpr size_t OFF_WOUT = 6 * MB;
constexpr size_t OFF_WPQ = 8 * MB;
constexpr size_t OFF_SUBK = 12 * MB;
constexpr size_t OFF_VEC = 12 * MB + 512 * 1024;
constexpr size_t OFF_SU = OFF_VEC + 4 * (size_t)T * 4, OFF_SV = OFF_SU + (size_t)NEXP * 4, OFF_SH = OFF_SV + (size_t)NEXP * 4;
constexpr size_t OFF_GATE = 13 * MB;
constexpr size_t OFF_BAR = 15 * MB;
constexpr size_t OFF_R1 = 16 * MB;
constexpr size_t OFF_R2 = 96 * MB;
constexpr size_t OFF_R3 = 160 * MB;
constexpr size_t OFF_R4 = 192 * MB;
constexpr size_t OFF_R5 = 208 * MB;
constexpr size_t WS_END = 256 * MB;

struct Params {
    const float* x; const int* pos; const float *ln1_w, *w_in, *q_a_norm_w, *w_q_up, *kv_a_norm_w, *w_kv_up, *conv_w, *a_log_f, *dt_bias_f, *a_log_b,
        *dt_bias_b, *gdn_norm_w, *w_out, *ln2_w, *peer_wq, *sub_keys, *peer_u, *peer_v, *final_w;
    float* out; unsigned char* ws;
};

struct Ctx {
    int tid, lane, wave, bid, nb, gw, ngw;
    float* lds;
};

#define LDS3 ((PG8_LAS unsigned char*)c.lds)
__device__ __forceinline__ void gemm_scale_bf16(const Ctx& c, const bf16_t* A, int lda, const bf16_t* Bt, int ldb, int N, int K, bf16_t* O, int ldc, const float* rs) {
    pg8::Gemm g{A, Bt, T, N, K, lda, ldb}; pg8::StaticOrder S; S.init(T, N, c.nb, c.bid);
    pg8::EpiScaleBf16 E{O, ldc, rs};
    pg8::gemm_phase<pg8::EpiScaleBf16, pg8::StaticOrder, true, true>(LDS3, g, S, E);
}
__device__ __forceinline__ void ph1_mfma(const Ctx& c, const Params& p) {
    gemm_scale_bf16(c, (const bf16_t*)(p.ws + OFF_R2), 1024, (const bf16_t*)(p.ws + OFF_WIN), 1024, IN_WP, 1024, (bf16_t*)(p.ws + OFF_R1), IN_WP, nullptr);
}
__device__ __forceinline__ void ph2a2_v2(const Ctx& c, const Params& p) {
    const bf16_t* proj = (const bf16_t*)(p.ws + OFF_R1);
    gemm_scale_bf16(c, proj, IN_WP, (const bf16_t*)(p.ws + OFF_WQUP), 256, 768, 256, (bf16_t*)(p.ws + OFF_R5), 768, nullptr);
    gemm_scale_bf16(c, proj + 256, IN_WP, (const bf16_t*)(p.ws + OFF_WKVUP), 256, 1024, 256, (bf16_t*)(p.ws + OFF_R3), 1024, nullptr);
}
__device__ __forceinline__ void ph4b_v2(const Ctx& c, const Params& p) {
    pg8::Gemm g{(const bf16_t*)(p.ws + OFF_R1), (const bf16_t*)(p.ws + OFF_WOUT), T, 1024, 1024, 1024, 1024}; pg8::StaticOrder S; S.init(T, 1024, c.nb, c.bid);
    pg8::EpiResF32Hb E{p.x, p.out, (bf16_t*)(p.ws + OFF_R3), (float*)(p.ws + OFF_SH), 1024};
    pg8::gemm_phase<pg8::EpiResF32Hb, pg8::StaticOrder, true, true>(LDS3, g, S, E);
}
__device__ __forceinline__ void ph5_v2(const Ctx& c, const Params& p) {
    gemm_scale_bf16(c, (const bf16_t*)(p.ws + OFF_R3), 1024, (const bf16_t*)(p.ws + OFF_WPQ), 1024, 2048, 1024, (bf16_t*)(p.ws + OFF_R2), 2048, nullptr);
}

namespace attn {
constexpr int SDEPTH = 1;
constexpr int NW = 8, QBLK = 32, KVBLK = 64, LDQ = 192, LDK = 192, LDV = 128, LDO = 512;
constexpr float SCALE = 0.07216878364870322f;
constexpr float THR = 8.f;
constexpr size_t SHM_V = KVBLK * 128 * 2, SHM_K = KVBLK * 192 * 2, SHM_ATTN = 2 * SHM_V + 2 * SHM_K + NW * 64 * 4 + NW * 6144;
constexpr int QREG = 6;
using bf16 = unsigned short;
using bf16x8 = __attribute__((ext_vector_type(8))) short;
using s16x4  = __attribute__((ext_vector_type(4))) short;
using f32x16 = __attribute__((ext_vector_type(16))) float;
using f32x8  = __attribute__((ext_vector_type(8))) float;
using u32x4a = __attribute__((ext_vector_type(4))) unsigned;
#define KSWZ(row, colB) ((row) * 384 + ((colB) ^ ((((row) >> 1) & 7) << 4)))
#define SBAR() __builtin_amdgcn_sched_barrier(0)
__device__ __forceinline__ int crow(int r, int hi) { return (r & 3) + 8 * (r >> 2) + 4 * hi; }
__device__ __forceinline__ unsigned cvtpk(float lo, float hi) {
  unsigned r; asm volatile("v_cvt_pk_bf16_f32 %0, %1, %2" : "=v"(r) : "v"(lo), "v"(hi)); return r;
}
__device__ __forceinline__ void partialSM(f32x16& p0, f32x16& p1, float& m_reg, float& mn, float& alpha) {
  constexpr float C = SCALE * 1.4426950408889634f;
  float pmax = p0[0]; for (int r = 1; r < 16; ++r) pmax = fmaxf(pmax, p0[r]); for (int r = 0; r < 16; ++r) pmax = fmaxf(pmax, p1[r]);
  { auto rr = __builtin_amdgcn_permlane32_swap(__float_as_uint(pmax), __float_as_uint(pmax), false, false);
    pmax = fmaxf(__uint_as_float(rr[0]), __uint_as_float(rr[1])); }
  if (__builtin_expect(__all(pmax - m_reg <= THR / SCALE), 1)) { mn = m_reg; alpha = 1.f; }
  else { mn = fmaxf(m_reg, pmax); alpha = __builtin_amdgcn_exp2f((m_reg - mn) * C); m_reg = mn; }
  float mnC = -mn * C;
  for (int r = 0; r < 16; ++r) p0[r] = fmaf(p0[r], C, mnC); for (int r = 0; r < 16; ++r) p1[r] = fmaf(p1[r], C, mnC);
  for (int r = 0; r < 16; ++r) p0[r] = __builtin_amdgcn_exp2f(p0[r]);
}
__device__ __forceinline__ void finishSM(f32x16& p0, f32x16& p1, float alpha, float& l_reg, bf16x8& pa0, bf16x8& pa1, bf16x8& pa2, bf16x8& pa3) {
  for (int r = 0; r < 16; ++r) p1[r] = __builtin_amdgcn_exp2f(p1[r]);
  float ps = 0; for (int r = 0; r < 16; ++r) ps += p0[r]; for (int r = 0; r < 16; ++r) ps += p1[r];
  { auto rr = __builtin_amdgcn_permlane32_swap(__float_as_uint(ps), __float_as_uint(ps), false, false);
    ps = __uint_as_float(rr[0]) + __uint_as_float(rr[1]); }
  l_reg = l_reg * alpha + ps;
#define PK4(P, BASE, OUT) do { unsigned a0 = cvtpk(P[BASE + 0], P[BASE + 1]), a1 = cvtpk(P[BASE + 2], P[BASE + 3]);   \
    unsigned b0 = cvtpk(P[BASE + 4], P[BASE + 5]), b1 = cvtpk(P[BASE + 6], P[BASE + 7]);                              \
    auto r0 = __builtin_amdgcn_permlane32_swap(a0, b0, false, false); auto r1 = __builtin_amdgcn_permlane32_swap(a1, b1, false, false); \
    u32x4a w = {r0[0], r1[0], r0[1], r1[1]}; OUT = *reinterpret_cast<bf16x8*>(&w); } while (0)
  PK4(p0, 0, pa0); PK4(p0, 8, pa1); PK4(p1, 0, pa2); PK4(p1, 8, pa3);
#undef PK4
}
__device__ __forceinline__ void qkt(f32x16& p0, f32x16& p1, const bf16* Ks, const bf16x8* qr, const bf16x8* qro, int r32, int hi) {
  p0 = f32x16{}; p1 = f32x16{};
  for (int d0 = 0; d0 < 12; ++d0) { int cb = (d0 * 16 + hi * 8) * 2;
    bf16x8 b0 = *reinterpret_cast<const bf16x8*>((const char*)Ks + KSWZ(r32, cb));
    bf16x8 b1 = *reinterpret_cast<const bf16x8*>((const char*)Ks + KSWZ(32 + r32, cb));
    const bf16x8 qf = d0 < QREG ? qr[d0 < QREG ? d0 : 0] : qro[(d0 - QREG) * 64];
    p0 = __builtin_amdgcn_mfma_f32_32x32x16_bf16(b0, qf, p0, 0, 0, 0);
    p1 = __builtin_amdgcn_mfma_f32_32x32x16_bf16(b1, qf, p1, 0, 0, 0); }
}
__device__ __forceinline__ int v_st(int k, int c) { const int kk = (k & ~0xC) | ((k & 4) << 1) | ((k & 8) >> 1); return ((kk >> 3) * 4 + (c >> 5)) * 512 + ((kk & 7) * 32 + (c & 31)) * 2; }
__device__ __forceinline__ int v_rd_base(int lane) { return ((lane & 3) << 3) | (((lane >> 2) & 3) << 6) | (((lane >> 4) & 1) << 5) | (((lane >> 5) & 1) << 8); }
constexpr int v_rd_off(int d0, int ks, int half) { return d0 * 512 + ks * 4096 + half * 2048; }
template <int OFF> __device__ __forceinline__ s16x4 tr_read(int vb) {
  s16x4 r; asm volatile("ds_read_b64_tr_b16 %0, %1 offset:%2" : "=&v"(r) : "v"(vb), "i"(OFF) : "memory"); return r;
}
template <int D0> __device__ __forceinline__ void pv_one(f32x16& od, int vb, bf16x8 pa0, bf16x8 pa1, bf16x8 pa2, bf16x8 pa3) {
  const s16x4 l0 = tr_read<v_rd_off(D0, 0, 0)>(vb), h0 = tr_read<v_rd_off(D0, 0, 1)>(vb), l1 = tr_read<v_rd_off(D0, 1, 0)>(vb), h1 = tr_read<v_rd_off(D0, 1, 1)>(vb);
  const s16x4 l2 = tr_read<v_rd_off(D0, 2, 0)>(vb), h2 = tr_read<v_rd_off(D0, 2, 1)>(vb), l3 = tr_read<v_rd_off(D0, 3, 0)>(vb), h3 = tr_read<v_rd_off(D0, 3, 1)>(vb);
  asm volatile("s_waitcnt lgkmcnt(0)" ::: "memory"); SBAR();
#define PK(L, H) (bf16x8){L[0], L[1], L[2], L[3], H[0], H[1], H[2], H[3]}
  od = __builtin_amdgcn_mfma_f32_32x32x16_bf16(pa0, PK(l0, h0), od, 0, 0, 0);
  od = __builtin_amdgcn_mfma_f32_32x32x16_bf16(pa1, PK(l1, h1), od, 0, 0, 0);
  od = __builtin_amdgcn_mfma_f32_32x32x16_bf16(pa2, PK(l2, h2), od, 0, 0, 0);
  od = __builtin_amdgcn_mfma_f32_32x32x16_bf16(pa3, PK(l3, h3), od, 0, 0, 0);
#undef PK
}
__device__ __forceinline__ void pv_d0(f32x16* o, int vb, bf16x8 pa0, bf16x8 pa1, bf16x8 pa2, bf16x8 pa3) {
  pv_one<0>(o[0], vb, pa0, pa1, pa2, pa3); pv_one<1>(o[1], vb, pa0, pa1, pa2, pa3); pv_one<2>(o[2], vb, pa0, pa1, pa2, pa3); pv_one<3>(o[3], vb, pa0, pa1, pa2, pa3);
}


template <bool PARTIAL>
__device__ __forceinline__ void attn_dense_body(const bf16* __restrict__ Qb, const bf16* __restrict__ Kh, const bf16* __restrict__ Vh,
                                                bf16* __restrict__ Ob, int seq, char* lds, float* __restrict__ ML = nullptr) {
  const int tid = opaque_tid(), wid = __builtin_amdgcn_readfirstlane(tid >> 6), lane = tid & 63, r32 = lane & 31, hi = lane >> 5;
  bf16* V_lds = (bf16*)lds; bf16* K_lds = (bf16*)(lds + 2 * SHM_V);
  float* ws = (float*)(lds + 2 * SHM_V + 2 * SHM_K) + wid * 64; float* li_l = ws; float* al_l = ws + 32;
  float m_reg = -1e30f, l_reg = 0; f32x16 o[4] = {}; bf16x8 qr[QREG];
  const bf16* Qw = Qb + (long)(wid * QBLK + r32) * LDQ + hi * 8;
#pragma unroll
  for (int d0 = 0; d0 < QREG; ++d0) qr[d0] = *reinterpret_cast<const bf16x8*>(Qw + d0 * 16);
  bf16x8* qro = (bf16x8*)(lds + 2 * SHM_V + 2 * SHM_K + NW * 64 * 4) + wid * 384 + lane;
#pragma unroll
  for (int d0 = QREG; d0 < 12; ++d0) qro[(d0 - QREG) * 64] = *reinterpret_cast<const bf16x8*>(Qw + d0 * 16);
  const int sr = tid >> 4, sc = (tid & 15) * 8, vst0 = v_st(sr, sc), vst1 = v_st(32 + sr, sc);
  const int vb0 = (int)(uintptr_t)V_lds + v_rd_base(lane);
  const int kr0 = tid / 24, kc0 = (tid % 24) * 16, kr1 = (tid + 512) / 24, kc1 = ((tid + 512) % 24) * 16, kr2 = (tid + 1024) / 24, kc2 = ((tid + 1024) % 24) * 16;
  const int kst0 = KSWZ(kr0, kc0), kst1 = KSWZ(kr1, kc1), kst2 = KSWZ(kr2, kc2);
  struct { bf16x8 vs0, vs1, ks0, ks1, ks2; } sr_[SDEPTH];
#define SLOAD(i, k0) do { sr_[i].vs0 = *(const bf16x8*)(&Vh[(long)((k0) + sr) * LDV + sc]); sr_[i].vs1 = *(const bf16x8*)(&Vh[(long)((k0) + 32 + sr) * LDV + sc]); \
    const bf16* kt_ = Kh + (long)(k0) * LDK + tid * 8; sr_[i].ks0 = *(const bf16x8*)(kt_); sr_[i].ks1 = *(const bf16x8*)(kt_ + 4096); sr_[i].ks2 = *(const bf16x8*)(kt_ + 8192); } while (0)
#define SWRITE(b, i) do { *(bf16x8*)((char*)V_lds + (b) * SHM_V + vst0) = sr_[i].vs0;          \
    *(bf16x8*)((char*)V_lds + (b) * SHM_V + vst1) = sr_[i].vs1;                                 \
    *(bf16x8*)((char*)K_lds + (b) * SHM_K + kst0) = sr_[i].ks0;                                 \
    *(bf16x8*)((char*)K_lds + (b) * SHM_K + kst1) = sr_[i].ks1;                                 \
    *(bf16x8*)((char*)K_lds + (b) * SHM_K + kst2) = sr_[i].ks2; } while (0)
#define SWAIT() do { if constexpr (SDEPTH == 2) asm volatile("s_waitcnt vmcnt(5)" ::: "memory"); else asm volatile("s_waitcnt vmcnt(0)" ::: "memory"); } while (0)
#define RESC(a) do { if (__any((a) < 1.f)) { if (hi == 0) al_l[r32] = (a); asm volatile("s_waitcnt lgkmcnt(0)" ::: "memory"); \
    for (int d = 0; d < 4; ++d) for (int r = 0; r < 16; ++r) o[d][r] *= al_l[crow(r, hi)]; } } while (0)
  f32x16 pA0, pA1, pB0, pB1; float mnA, mnB, alA, alB; bf16x8 pa0, pa1, pa2, pa3; const int NT = seq / KVBLK;
  constexpr int SE = 0, SO = SDEPTH - 1;
  SLOAD(SE, 0); asm volatile("s_waitcnt vmcnt(0)" ::: "memory"); SWRITE(0, SE); __syncthreads();
  qkt(pA0, pA1, K_lds, qr, qro, r32, hi); partialSM(pA0, pA1, m_reg, mnA, alA);
  SLOAD(SO, KVBLK); if constexpr (SDEPTH == 2) { if (2 < NT) SLOAD(SE, 2 * KVBLK); }
  SWAIT(); SWRITE(1, SO); __syncthreads();
  for (int j = 1; j + 1 < NT; j += 2) {
    SBAR(); qkt(pB0, pB1, (bf16*)((char*)K_lds + SHM_K), qr, qro, r32, hi);
    finishSM(pA0, pA1, alA, l_reg, pa0, pa1, pa2, pa3); SBAR();
    SLOAD(SO, (j + SDEPTH) * KVBLK); SBAR();
    pv_d0(o, vb0, pa0, pa1, pa2, pa3); partialSM(pB0, pB1, m_reg, mnB, alB);
    __syncthreads(); SWAIT(); SWRITE(0, SE);
    RESC(alB); __syncthreads();
    SBAR(); qkt(pA0, pA1, K_lds, qr, qro, r32, hi);
    finishSM(pB0, pB1, alB, l_reg, pa0, pa1, pa2, pa3); SBAR();
    if (SDEPTH == 1 || j + 3 < NT) SLOAD(SE, (j + 1 + SDEPTH) * KVBLK); SBAR();
    pv_d0(o, vb0 + (int)SHM_V, pa0, pa1, pa2, pa3); partialSM(pA0, pA1, m_reg, mnA, alA);
    __syncthreads(); SWAIT(); SWRITE(1, SO);
    RESC(alA); __syncthreads();
  }
  SBAR(); qkt(pB0, pB1, (bf16*)((char*)K_lds + SHM_K), qr, qro, r32, hi);
  finishSM(pA0, pA1, alA, l_reg, pa0, pa1, pa2, pa3); SBAR();
  pv_d0(o, vb0, pa0, pa1, pa2, pa3); partialSM(pB0, pB1, m_reg, mnB, alB);
  __syncthreads(); RESC(alB);
  finishSM(pB0, pB1, alB, l_reg, pa0, pa1, pa2, pa3); SBAR();
  pv_d0(o, vb0 + (int)SHM_V, pa0, pa1, pa2, pa3);
  if constexpr (PARTIAL) {
    if (hi == 0) { ML[(wid * QBLK + r32) * 2] = m_reg; ML[(wid * QBLK + r32) * 2 + 1] = l_reg; }
    bf16* Ow = Ob + (long)(wid * QBLK) * 128;
#pragma unroll
    for (int r = 0; r < 16; ++r) { int orow = crow(r, hi);
      for (int d0 = 0; d0 < 4; ++d0) Ow[(long)orow * 128 + d0 * 32 + r32] = (bf16)(cvtpk(o[d0][r], 0.f) & 0xffffu); }
  } else {
  if (hi == 0) li_l[r32] = l_reg; asm volatile("s_waitcnt lgkmcnt(0)" ::: "memory");
  float rli[16];
#pragma unroll
  for (int r = 0; r < 16; ++r) rli[r] = __builtin_amdgcn_rcpf(li_l[crow(r, hi)]);
  bf16* Ow = Ob + (long)(wid * QBLK) * LDO;
#pragma unroll
  for (int r = 0; r < 16; ++r) { int orow = crow(r, hi);
    for (int d0 = 0; d0 < 4; ++d0) Ow[(long)orow * LDO + d0 * 32 + r32] = (bf16)(cvtpk(o[d0][r] * rli[r], 0.f) & 0xffffu); }
  }
  __syncthreads();
#undef SLOAD
#undef SWRITE
#undef SWAIT
#undef RESC
}

}

__device__ __forceinline__ void ph3a_mfma(const Ctx& c, const Params& p) {
    const bf16_t* Q = (const bf16_t*)p.out; const bf16_t* Kk = Q + (size_t)T * MLA_H * QKD; const bf16_t* V = Kk + (size_t)T * MLA_H * QKD;
    bf16_t* omla = (bf16_t*)(p.ws + OFF_R4);
    for (int unit = c.bid; unit < BATCH * MLA_H * (SEQ / 256); unit += c.nb) {
        const int bh = unit & 7, qb = unit >> 3, b = bh >> 2, h = bh & 3;
        const size_t base = (size_t)bh * SEQ;
        attn::attn_dense_body<false>(Q + (base + qb * 256) * QKD, Kk + base * QKD, V + base * VDIM, omla + (size_t)(b * SEQ + qb * 256) * 512 + h * 128, SEQ, (char*)c.lds);
    }
}
constexpr size_t OFF_PART = 240 * MB, OFF_PARTML = 255 * MB;
__device__ __forceinline__ void ph3a_split(const Ctx& c, const Params& p) {
    const bf16_t* Q = (const bf16_t*)p.out; const bf16_t* Kk = Q + (size_t)T * MLA_H * QKD; const bf16_t* V = Kk + (size_t)T * MLA_H * QKD;
    bf16_t* omla = (bf16_t*)(p.ws + OFF_R4);
    const int j = c.bid - 32, bh = j & 7, b = bh >> 2, h = bh & 3; const size_t base = (size_t)bh * SEQ;
    { const int qb = j >> 3;
      attn::attn_dense_body<false>(Q + (base + qb * 256) * QKD, Kk + base * QKD, V + base * VDIM, omla + (size_t)(b * SEQ + qb * 256) * 512 + h * 128, SEQ, (char*)c.lds); }
    { const int r = j >> 3, qb = 28 + r / 7, part = r % 7, k0 = part * 18 * 64, nk = (part == 6 ? 20 : 18) * 64, lu = (qb - 28) * 8 + bh;
      attn::attn_dense_body<true>(Q + (base + qb * 256) * QKD, Kk + (base + k0) * QKD, V + (base + k0) * VDIM, (bf16_t*)(p.ws + OFF_PART) + ((size_t)(lu * 7 + part) * 256) * 128, nk,
                                  (char*)c.lds, (float*)(p.ws + OFF_PARTML) + (size_t)(lu * 7 + part) * 512); }
}


namespace pk {
typedef float f32x16 __attribute__((ext_vector_type(16)));
typedef short bf16x8 __attribute__((ext_vector_type(8)));
__device__ __forceinline__ int f2ord(float f) { const int b = __float_as_int(f); return b ^ ((b >> 31) & 0x7fffffff); }
__device__ __forceinline__ float ord2f(int k) { return __int_as_float(k ^ ((k >> 31) & 0x7fffffff)); }
__device__ __forceinline__ void ce(int& a, int& b) { const int mx = max(a, b), mn = min(a, b); a = mx; b = mn; }
__device__ __forceinline__ void sort16(int (&v)[16]) {
#pragma unroll
    for (int k = 2; k <= 16; k <<= 1)
#pragma unroll
        for (int j = k >> 1; j > 0; j >>= 1)
#pragma unroll
            for (int i = 0; i < 16; ++i) { const int l = i ^ j; if (l > i) { if ((i & k) == 0) ce(v[i], v[l]); else ce(v[l], v[i]); } }
}
__device__ __forceinline__ void merge16(int (&v)[16]) {
#pragma unroll
    for (int j = 8; j > 0; j >>= 1)
#pragma unroll
        for (int i = 0; i < 16; ++i) { const int l = i ^ j; if (l > i) ce(v[i], v[l]); }
}
__device__ __forceinline__ void top_merge(int (&best)[16], int (&g)[16]) {
#pragma unroll
    for (int i = 0; i < 16; ++i) best[i] = max(best[i], g[15 - i]);
    merge16(best);
}
__device__ __forceinline__ int lookup16(unsigned long long lo, unsigned long long hi8, int i) {
    const unsigned long long s = (i & 8) ? hi8 : lo;
    return (int)((s >> ((i & 7) * 8)) & 0xffull);
}
}
__device__ __forceinline__ void ph6_fast(const Ctx& c, const Params& p) {
    using namespace pk;
    const int tid = opaque_tid(), wid = __builtin_amdgcn_readfirstlane(tid >> 6), lane = tid & 63, r32 = lane & 31, hi = lane >> 5;
    const bf16_t* qp = (const bf16_t*)(p.ws + OFF_R2); const bf16_t* subk = (const bf16_t*)(p.ws + OFF_SUBK);
    int* experts = (int*)(p.ws + OFF_R4); float* gates = (float*)(p.ws + OFF_R4 + 8 * MB);
    char* lds = (char*)c.lds;
    constexpr int NU = PH * (T / 256);
    const int per = (NU + c.nb - 1) / c.nb;
    int cur_h = -1;
    for (int ui = 0; ui < per; ++ui) {
        const int u = c.bid * per + ui; if (u >= NU) break;
        const int h = u / (T / 256), t0 = (u % (T / 256)) * 256;
        if (h != cur_h) {
            __syncthreads();
            for (int ch = tid; ch < 4096; ch += NT) { const int row = ch >> 4, cb = (ch & 15) * 16;
                const u32x4 v = *(const u32x4*)(subk + (size_t)h * 32768 + (size_t)row * 128 + (cb >> 1));
                *(u32x4*)(lds + row * 256 + (cb ^ ((row & 7) << 4))) = v; }
            __syncthreads(); cur_h = h;
        }
        const int t = t0 + wid * 32 + r32;
        int A[2][16];
#pragma unroll
        for (int pp = 0; pp < 2; ++pp) {
            bf16x8 bq[8];
#pragma unroll
            for (int ks = 0; ks < 8; ++ks) bq[ks] = *(const bf16x8*)(qp + (size_t)t * 2048 + h * 256 + pp * 128 + ks * 16 + hi * 8);
            f32x16 acc[4];
#pragma unroll
            for (int kt = 0; kt < 4; ++kt) acc[kt] = f32x16{};
#pragma unroll
            for (int ks = 0; ks < 8; ++ks)
#pragma unroll
                for (int kt = 0; kt < 4; ++kt) { const int row = pp * 128 + kt * 32 + r32, cb = (ks * 16 + hi * 8) * 2;
                    const bf16x8 a = *(const bf16x8*)(lds + row * 256 + (cb ^ ((row & 7) << 4)));
                    acc[kt] = __builtin_amdgcn_mfma_f32_32x32x16_bf16(a, bq[ks], acc[kt], 0, 0, 0); }
            int best[16], g[16];
#pragma unroll
            for (int kt = 0; kt < 4; ++kt) {
#pragma unroll
                for (int r = 0; r < 16; ++r) { const int idx = kt * 32 + (r & 3) + 8 * (r >> 2) + 4 * hi; const int k = (f2ord(acc[kt][r]) & ~127) | idx; if (kt == 0) best[r] = k; else g[r] = k; }
                if (kt == 0) sort16(best); else { sort16(g); top_merge(best, g); }
            }
#pragma unroll
            for (int i = 0; i < 16; ++i) g[i] = __shfl_xor(best[i], 32);
            top_merge(best, g);
#pragma unroll
            for (int i = 0; i < 16; ++i) A[pp][i] = best[i];
        }
        constexpr int CI[50] = {0,0,0,0,0,0,0,0,0,0,0,0,0,0,0,0,1,1,1,1,1,1,1,1,2,2,2,2,2,3,3,3,3,4,4,4,5,5,6,6,7,7,8,9,10,11,12,13,14,15};
        constexpr int CJ[50] = {0,1,2,3,4,5,6,7,8,9,10,11,12,13,14,15,0,1,2,3,4,5,6,7,0,1,2,3,4,0,1,2,3,0,1,2,0,1,0,1,0,1,0,0,0,0,0,0,0,0};
        float fa[16], fb[16]; unsigned long long wa0 = 0, wa1 = 0, wb0 = 0, wb1 = 0;
#pragma unroll
        for (int i = 0; i < 16; ++i) { fa[i] = ord2f(A[0][i] & ~127); fb[i] = ord2f(A[1][i] & ~127);
            if (i < 8) { wa0 |= (unsigned long long)(A[0][i] & 127) << (i * 8); wb0 |= (unsigned long long)(A[1][i] & 127) << (i * 8); }
            else { wa1 |= (unsigned long long)(A[0][i] & 127) << ((i - 8) * 8); wb1 |= (unsigned long long)(A[1][i] & 127) << ((i - 8) * 8); } }
        int best[16], g[16];
#pragma unroll
        for (int gi = 0; gi < 4; ++gi) {
#pragma unroll
            for (int r = 0; r < 16; ++r) { const int n = gi * 16 + r; int k = (int)0x80000000;
                if (n < 50) k = (f2ord(fa[CI[n < 50 ? n : 0]] + fb[CJ[n < 50 ? n : 0]]) & ~255) | (CI[n < 50 ? n : 0] << 4) | CJ[n < 50 ? n : 0];
                if (gi == 0) best[r] = k; else g[r] = k; }
            if (gi == 0) sort16(best); else { sort16(g); top_merge(best, g); }
        }
        float fs[16]; int fe[16]; float sum = 0.f; const float s0 = ord2f(best[0] & ~255);
        const float rs2 = rsqrtf(((const float*)(p.ws + OFF_SH))[t] * (1.f / 1024.f) + EPS);
#pragma unroll
        for (int k = 0; k < 16; ++k) { const int code = best[k] & 255; fe[k] = lookup16(wa0, wa1, code >> 4) * NKEYS + lookup16(wb0, wb1, code & 15);
            fs[k] = __expf((ord2f(best[k] & ~255) - s0) * rs2); sum += fs[k]; }
        const float inv = 1.f / sum;
        if (hi == 0) { int* eo = experts + (size_t)t * 128 + h * 16;
#pragma unroll
            for (int k = 0; k < 16; k += 4) *(u32x4*)(eo + k) = u32x4{(unsigned)fe[k], (unsigned)fe[k + 1], (unsigned)fe[k + 2], (unsigned)fe[k + 3]}; }
        else { float* go = gates + (size_t)t * 128 + h * 16;
#pragma unroll
            for (int k = 0; k < 16; k += 4) *(f32x4*)(go + k) = f32x4{fs[k] * inv, fs[k + 1] * inv, fs[k + 2] * inv, fs[k + 3] * inv}; }
    }
    __syncthreads();
}


__device__ __forceinline__ float wave_max(float v) {
#pragma unroll
    for (int o = 1; o < 64; o <<= 1) v = fmaxf(v, __shfl_xor(v, o));
    return v;
}
__device__ __forceinline__ unsigned q4(float a, float b, float cc, float d, float inv, int off) {
    const int x = (int)rintf(a * inv) + off, y = (int)rintf(b * inv) + off, z = (int)rintf(cc * inv) + off, w = (int)rintf(d * inv) + off;
    return (unsigned)(x & 255) | ((unsigned)(y & 255) << 8) | ((unsigned)(z & 255) << 16) | ((unsigned)(w & 255) << 24);
}
__device__ __forceinline__ void quant_row(const float* row, const float* mul, int lane, unsigned char* dst, float* scale_out, int off) {
    f32x4 v[4]; float mx = 0.f;
#pragma unroll
    for (int j = 0; j < 4; ++j) { v[j] = *(const f32x4*)(row + 16 * lane + 4 * j); if (mul) v[j] = v[j] * *(const f32x4*)(mul + 16 * lane + 4 * j);
        mx = fmaxf(mx, fmaxf(fmaxf(fabsf(v[j].x), fabsf(v[j].y)), fmaxf(fabsf(v[j].z), fabsf(v[j].w)))); }
    mx = fmaxf(wave_max(mx), 1e-30f);
    const float inv = 127.f / mx;
    u32x4 o; o.x = q4(v[0].x, v[0].y, v[0].z, v[0].w, inv, off); o.y = q4(v[1].x, v[1].y, v[1].z, v[1].w, inv, off);
    o.z = q4(v[2].x, v[2].y, v[2].z, v[2].w, inv, off); o.w = q4(v[3].x, v[3].y, v[3].z, v[3].w, inv, off);
    *(u32x4*)(dst + 16 * lane) = o;
    if (lane == 0) *scale_out = mx * (1.f / 127.f);
}
__device__ __forceinline__ void fp8_row(const float* row, int lane, unsigned char* dst) {
    u32x4 o;
#pragma unroll
    for (int j = 0; j < 4; ++j) { const f32x4 v = *(const f32x4*)(row + 16 * lane + 4 * j);
        int w = __builtin_amdgcn_cvt_pk_fp8_f32(v.x, v.y, 0, false); w = __builtin_amdgcn_cvt_pk_fp8_f32(v.z, v.w, w, true); o[j] = (unsigned)w; }
    *(u32x4*)(dst + (size_t)(lane >> 3) * ((size_t)NEXP * 128) + (lane & 7) * 16) = o;
}
__device__ __forceinline__ void ph4a_tables_q8(const Ctx& c, const Params& p, int gw, int ngw, int r_lo, int r_hi) {
    unsigned char* u8 = p.ws + OFF_R5; unsigned char* v8 = u8 + (size_t)NEXP * 1024;
    float* su = (float*)(p.ws + OFF_SU); float* sv = (float*)(p.ws + OFF_SV);
    for (int r = r_lo + gw; r < r_hi; r += ngw) {
        if (r < NEXP) quant_row(p.peer_u + (size_t)r * 1024, p.ln2_w, c.lane, u8 + (size_t)r * 1024, su + r, 0);
        else { const int e = r - NEXP; fp8_row(p.peer_v + (size_t)e * 1024, c.lane, v8 + (size_t)e * 128); }
    }
}


namespace gdn {
typedef short bf16x8 __attribute__((ext_vector_type(8)));
typedef short s16x4 __attribute__((ext_vector_type(4)));
typedef float f32x4v __attribute__((ext_vector_type(4)));
typedef float f32x2c __attribute__((ext_vector_type(2))); typedef __bf16 bf16x2c __attribute__((ext_vector_type(2)));
__device__ __forceinline__ unsigned cvtpk(float lo, float hi) { const f32x2c v = {lo, hi}; const bf16x2c r = __builtin_convertvector(v, bf16x2c); return *(const unsigned*)&r; }
__device__ __forceinline__ int wperm(int d) { const int x = d & 31; return (d & ~31) | (8 * ((x >> 2) & 3) + 4 * (x >> 4) + (x & 3)); }
}
__device__ __forceinline__ void unpack8(const u32x4 w, float (&f)[8]) {
    f[0] = bflo(w.x); f[1] = bfhi(w.x); f[2] = bflo(w.y); f[3] = bfhi(w.y); f[4] = bflo(w.z); f[5] = bfhi(w.z); f[6] = bflo(w.w); f[7] = bfhi(w.w); }
__device__ __forceinline__ u32x4 pack8(const float (&f)[8]) { u32x4 w; w.x = gdn::cvtpk(f[0], f[1]); w.y = gdn::cvtpk(f[2], f[3]); w.z = gdn::cvtpk(f[4], f[5]); w.w = gdn::cvtpk(f[6], f[7]); return w; }


template <int VAR>
__device__ __forceinline__ void ph2b_v4(const Ctx& c, const Params& p) {
    using namespace gdn;
    const int tid = opaque_tid(), wid = __builtin_amdgcn_readfirstlane(tid >> 6), lane = tid & 63, li = lane & 15, lq = lane >> 4;
    const bf16_t* gq = (const bf16_t*)(p.ws + OFF_R2); const bf16_t* gk = gq + (size_t)T * 512; const bf16_t* gv = gk + (size_t)T * 512;
    const float* Gg = (const float*)(p.ws + OFF_GATE); const float* Gb = Gg + 2 * T * GH; float* Gcs = (float*)(p.ws + OFF_GATE) + 4 * T * GH;
    bf16_t* U = (bf16_t*)(p.ws + OFF_R1); bf16_t* W = U + (size_t)2 * T * 512; bf16_t* AT = W + (size_t)2 * T * 512;
    char* lds = (char*)c.lds;
    char* kL = lds; char* qL = lds + 16384;
    float (*Gm)[68] = (float (*)[68])(lds + 32768); float (*QKm)[68] = Gm + 64;
    float (*Lm)[64][68] = (float (*)[64][68])(lds + 32768 + 2 * 64 * 68 * 4);
    float* gcsL = (float*)(lds + 32768 + 4 * 64 * 68 * 4); float* betaL = gcsL + 128; float* gL = betaL + 128;
    for (int unit = c.bid; unit < BATCH * GH * NCH; unit += c.nb) {
        const int nt = unit % NCH, h = (unit / NCH) % GH, b = unit / (NCH * GH);
        const int p0 = nt * CHUNK; const size_t bh = (size_t)(b * GH + h) * SEQ;
        __syncthreads();
#pragma unroll
        for (int i = 0; i < 2; ++i) { const int ch = tid + i * NT, row = ch >> 4, a = ch & 15; const int off = row * 256 + ((a * 16) ^ ((row & 15) << 4));
            *(u32x4*)(kL + off) = *(const u32x4*)(gk + (bh + p0 + row) * 128 + a * 8); *(u32x4*)(qL + off) = *(const u32x4*)(gq + (bh + p0 + row) * 128 + a * 8); }
        if (tid < 128) { const int d = tid >> 6, i = tid & 63; gL[tid] = Gg[(size_t)d * T * GH + bh + p0 + i]; betaL[tid] = Gb[(size_t)d * T * GH + bh + p0 + i]; }
        __syncthreads();
        if (wid < 2) { float v = gL[wid * 64 + (wid ? 63 - lane : lane)];
#pragma unroll
            for (int o = 1; o < 64; o <<= 1) { const float t_ = __shfl_up(v, o); if (lane >= o) v += t_; }
            gcsL[wid * 64 + lane] = v; }
        { const int mt = wid & 3; const char* Asrc = wid < 4 ? kL : qL; f32x4v acc[4];
#pragma unroll
          for (int n = 0; n < 4; ++n) acc[n] = f32x4v{0.f, 0.f, 0.f, 0.f};
#pragma unroll
          for (int s = 0; s < 4; ++s) { const int cb = 64 * s + 16 * lq;
              const bf16x8 af = *(const bf16x8*)(Asrc + (16 * mt + li) * 256 + (cb ^ (li << 4)));
#pragma unroll
              for (int n = 0; n < 4; ++n) { const bf16x8 bfr = *(const bf16x8*)(kL + (16 * n + li) * 256 + (cb ^ (li << 4)));
                  acc[n] = __builtin_amdgcn_mfma_f32_16x16x32_bf16(af, bfr, acc[n], 0, 0, 0); } }
          float (*dst)[68] = wid < 4 ? Gm : QKm;
#pragma unroll
          for (int n = 0; n < 4; ++n)
#pragma unroll
              for (int r = 0; r < 4; ++r) dst[16 * mt + 4 * lq + r][16 * n + li] = acc[n][r];
        }
        __syncthreads();
        if (tid < 128) { const int d = tid >> 6, i = tid & 63; const int nv = d ? NCH - 1 - nt : nt; Gcs[(size_t)d * T * GH + bh + nv * CHUNK + i] = gcsL[tid]; }
        const int tid2 = opaque_tid();
#pragma unroll 2
        for (int idx = tid2; idx < (VAR == 2 ? 0 : 2 * 4096); idx += NT) { const int d = idx >> 12, i = (idx >> 6) & 63, j = idx & 63; const int ti = d ? 63 - i : i, tj = d ? 63 - j : j;
            const float dec = __expf(gcsL[d * 64 + i] - gcsL[d * 64 + j]);
            Lm[d][j][i] = i > j ? betaL[d * 64 + ti] * Gm[ti][tj] * dec : 0.f;
            const int nv = d ? NCH - 1 - nt : nt;
            AT[((size_t)(d * BATCH * GH + b * GH + h) * NCH + nv) * 4096 + i * 64 + wperm(j)] = f2bf(i >= j ? QKm[ti][tj] * dec : 0.f); }
        __syncthreads();
        if (VAR == 1) continue;
        char* RL = lds;
        char* Dv = lds + 32768 + 4 * 64 * 68 * 4 + 1536;
        char* Lb = Dv + 4096;
        for (int ch = tid; ch < 4096; ch += NT) { const int d = ch >> 11, j = (ch >> 5) & 63, cc = ch & 31, tj = d ? 63 - j : j, col0 = cc * 8;
            const bf16_t* sp = (col0 < 128 ? gv + (bh + p0 + tj) * 128 + col0 : gk + (bh + p0 + tj) * 128 + (col0 - 128));
            float f[8]; unpack8(*(const u32x4*)sp, f);
            const float sc = betaL[d * 64 + tj] * (col0 < 128 ? 1.f : __expf(gcsL[d * 64 + j]));
#pragma unroll
            for (int e = 0; e < 8; ++e) f[e] *= sc;
            *(u32x4*)(RL + d * 33792 + (j >> 2) * 2112 + (cc >> 1) * 128 + (j & 3) * 32 + (cc & 1) * 16) = pack8(f); }
        if (tid < 128) {
            const int d = tid >> 6, bb = (tid >> 4) & 3, cc = tid & 15; float x[16];
#pragma unroll
            for (int i = 0; i < 16; ++i) x[i] = (i == cc) ? 1.f : 0.f;
#pragma unroll
            for (int j = 0; j < 15; ++j) { const float xj = x[j];
#pragma unroll
                for (int i = j + 1; i < 16; ++i) x[i] -= Lm[d][16 * bb + j][16 * bb + i] * xj; }
#pragma unroll
            for (int i = 0; i < 16; ++i) *(bf16_t*)(Dv + ((d * 4 + bb) * 16 + i) * 32 + cc * 2) = f2bf(x[i]);
        } else {
            for (int e = tid - 128; e < 2 * 6 * 256; e += NT - 128) { const int d = e / 1536, r = e % 1536, pi = r >> 8, i = (r >> 4) & 15, k = r & 15;
                const int bb = pi == 0 ? 1 : (pi < 3 ? 2 : 3), aa = pi - bb * (bb - 1) / 2;
                *(bf16_t*)(Lb + ((d * 6 + pi) * 16 + i) * 32 + k * 2) = f2bf(-Lm[d][16 * aa + k][16 * bb + i]); }
        }
        __syncthreads();
        { typedef short s16x4v __attribute__((ext_vector_type(4)));
          const int d = wid >> 2, nv = d ? NCH - 1 - nt : nt; const size_t rowbase = ((size_t)d * T * GH + bh + nv * CHUNK) * 128;
          const char* RLd = RL + d * 33792; const char* Dvd = Dv + d * 2048; const char* Lbd = Lb + d * 3072;
#pragma unroll
          for (int tp = 0; tp < 2; ++tp) {
              f32x4v acc[2][4]; s16x4v xb[2][4];
#pragma unroll
              for (int u = 0; u < 2; ++u) { const int ntile = 4 * (wid & 3) + 2 * tp + u;
#pragma unroll
                  for (int bb = 0; bb < 4; ++bb)
#pragma unroll
                      for (int r = 0; r < 4; ++r) acc[u][bb][r] = bf2f(*(const bf16_t*)(RLd + (4 * bb + lq) * 2112 + ntile * 128 + r * 32 + li * 2)); }
#pragma unroll
              for (int bb = 0; bb < 4; ++bb) {
#pragma unroll
                  for (int aa = 0; aa < bb; ++aa) { const s16x4v lf = *(const s16x4v*)(Lbd + ((bb * (bb - 1) / 2 + aa) * 16 + li) * 32 + lq * 8);
#pragma unroll
                      for (int u = 0; u < 2; ++u) acc[u][bb] = __builtin_amdgcn_mfma_f32_16x16x16bf16_1k(lf, xb[u][aa], acc[u][bb], 0, 0, 0); }
                  const s16x4v df = *(const s16x4v*)(Dvd + (bb * 16 + li) * 32 + lq * 8);
#pragma unroll
                  for (int u = 0; u < 2; ++u) { u32x2 w; w.x = cvtpk(acc[u][bb][0], acc[u][bb][1]); w.y = cvtpk(acc[u][bb][2], acc[u][bb][3]);
                      const s16x4v rb = *(s16x4v*)&w; acc[u][bb] = __builtin_amdgcn_mfma_f32_16x16x16bf16_1k(df, rb, f32x4v{0.f, 0.f, 0.f, 0.f}, 0, 0, 0);
                      u32x2 w2; w2.x = cvtpk(acc[u][bb][0], acc[u][bb][1]); w2.y = cvtpk(acc[u][bb][2], acc[u][bb][3]); xb[u][bb] = *(s16x4v*)&w2; }
              }
#pragma unroll
              for (int u = 0; u < 2; ++u) { const int col = 16 * (4 * (wid & 3) + 2 * tp + u) + li; bf16_t* dst = (col < 128 ? U + rowbase + col : W + rowbase + wperm(col - 128));
#pragma unroll
                  for (int bb = 0; bb < 4; ++bb)
#pragma unroll
                      for (int r = 0; r < 4; ++r) dst[(size_t)(16 * bb + 4 * lq + r) * 128] = (bf16_t)((unsigned short)xb[u][bb][r]); }
          }
        }
    }
    __syncthreads();
}

template <int VAR>
__device__ __forceinline__ void ph3b_mfma(const Ctx& c, const Params& p) {
    using namespace gdn;
    constexpr int W_OFF = 0, QD_OFF = 16384, KD_OFF = 32768, AT_OFF = 51200, U_OFF = 59392, MISC_OFF = 68608, BUF = 69632;
    const int tid = opaque_tid(), wid = __builtin_amdgcn_readfirstlane(tid >> 6), lane = tid & 63, li = lane & 15, lq = lane >> 4;
    const bf16_t* gq = (const bf16_t*)(p.ws + OFF_R2); const bf16_t* gk = gq + (size_t)T * 512;
    const float* Gcs = (const float*)(p.ws + OFF_GATE) + 4 * T * GH;
    const bf16_t* Ug = (const bf16_t*)(p.ws + OFF_R1); const bf16_t* Wg = Ug + (size_t)2 * T * 512; const bf16_t* ATg = Wg + (size_t)2 * T * 512;
    bf16_t* Od = (bf16_t*)(p.ws + OFF_R3);
    char* lds = (char*)c.lds;
    for (int unit = c.bid; unit < 2 * BATCH * GH * 2; unit += c.nb) {
        const int chain = (unit & 7) | ((unit >> 4) << 3), vh = (unit >> 3) & 1, h = chain & 3, b = (chain >> 2) & 1, dir = chain >> 3;
        const size_t bh = (size_t)(b * GH + h) * SEQ; const size_t dbh = (size_t)dir * T * GH + bh; const int c0 = vh * 64;
        __syncthreads();
        if (wid >= 4) {
            const int lt = tid - 256;
            struct LSet { u32x4 rw[4], rq[4], rk[4], ra[2], ru[2]; float gc[4], gl; };
            LSet sA, sB;
            const int r0 = lt >> 4, a0 = lt & 15;
            const unsigned offW = (unsigned)(r0 * 256 + a0 * 16);
            const unsigned offQ = (unsigned)((dir ? 63 - r0 : r0) * 256 + a0 * 16);
            const int r1 = lt >> 3, a1 = lt & 7;
            const unsigned offA = (unsigned)(r1 * 128 + a1 * 16), offU = (unsigned)(r1 * 256 + a1 * 16), offG = (unsigned)(r0 * 4);
            const int qstep = dir ? -4096 : 4096;
            const unsigned swW = (unsigned)((r0 & 15) << 4);
            const unsigned ldsW = (unsigned)(r0 * 256) + (((unsigned)a0 * 16u) ^ swW);
            const int s_ = a0 >> 2, a2 = a0 & 3; const int pos0 = ((2 * a2) & 3) * 2 + (a2 >> 1), pos1 = ((2 * a2 + 1) & 3) * 2 + (a2 >> 1);
            const unsigned ldsQ0 = (unsigned)(r0 * 256) + (((unsigned)(64 * s_ + 8 * pos0)) ^ swW), ldsQ1 = (unsigned)(r0 * 256) + (((unsigned)(64 * s_ + 8 * pos1)) ^ swW);
            const unsigned ldsK = (unsigned)((r0 >> 2) * 1152 + (a0 >> 1) * 128 + (r0 & 3) * 32 + (a0 & 1) * 16);
            const unsigned ldsA = (unsigned)(r1 * 128) + (((unsigned)a1 * 16u) ^ (unsigned)(((r1 >> 1) & 7) << 4)), ldsU = (unsigned)(r1 * 144 + a1 * 16);
            const char* Wb = (const char*)(Wg + dbh * 128); const char* Ub = (const char*)(Ug + dbh * 128 + c0);
            const char* Qb = (const char*)(gq + (bh + (dir ? SEQ - 64 : 0)) * 128); const char* Kb = (const char*)(gk + (bh + (dir ? SEQ - 64 : 0)) * 128);
            const char* Ab = (const char*)(ATg + (size_t)(dir * BATCH * GH + b * GH + h) * NCH * 4096); const char* Gb_ = (const char*)(Gcs + dbh);
#define GDN_LOAD(S_, nreal_) do { const int n_ = VAR == 1 ? 0 : (nreal_); const long cw_ = (long)(n_) * 16384, cq_ = dir ? -(long)(n_) * 16384 : (long)(n_) * 16384; \
    _Pragma("unroll") for (int i = 0; i < 4; ++i) { \
        S_.rw[i] = *(const u32x4*)(Wb + cw_ + i * 4096 + offW); S_.rq[i] = *(const u32x4*)(Qb + cq_ + i * qstep + offQ); S_.rk[i] = *(const u32x4*)(Kb + cq_ + i * qstep + offQ); \
        S_.gc[i] = *(const float*)(Gb_ + (long)(n_) * 256 + i * 64 + offG); } \
    _Pragma("unroll") for (int i = 0; i < 2; ++i) { \
        S_.ra[i] = *(const u32x4*)(Ab + (long)(n_) * 8192 + i * 4096 + offA); S_.ru[i] = *(const u32x4*)(Ub + cw_ + i * 8192 + offU); } \
    S_.gl = *(const float*)(Gb_ + (long)(n_) * 256 + 252); } while (0)
#define GDN_SCALE2(w_, f_) cvtpk(bflo(w_) * (f_), bfhi(w_) * (f_))
#define GDN_WRITE(S_, buf_) do { char* B_ = lds + (buf_) * BUF; \
    _Pragma("unroll") for (int i = 0; i < 4; ++i) { \
        *(u32x4*)(B_ + W_OFF + i * 4096 + ldsW) = S_.rw[i]; \
        const float fq_ = __expf(S_.gc[i]), fk_ = __expf(S_.gl - S_.gc[i]); \
        u32x2 q0, q1; q0.x = GDN_SCALE2(S_.rq[i].x, fq_); q0.y = GDN_SCALE2(S_.rq[i].y, fq_); q1.x = GDN_SCALE2(S_.rq[i].z, fq_); q1.y = GDN_SCALE2(S_.rq[i].w, fq_); \
        *(u32x2*)(B_ + QD_OFF + i * 4096 + ldsQ0) = q0; *(u32x2*)(B_ + QD_OFF + i * 4096 + ldsQ1) = q1; \
        u32x4 k_; k_.x = GDN_SCALE2(S_.rk[i].x, fk_); k_.y = GDN_SCALE2(S_.rk[i].y, fk_); k_.z = GDN_SCALE2(S_.rk[i].z, fk_); k_.w = GDN_SCALE2(S_.rk[i].w, fk_); \
        *(u32x4*)(B_ + KD_OFF + i * 4608 + ldsK) = k_; } \
    _Pragma("unroll") for (int i = 0; i < 2; ++i) { \
        *(u32x4*)(B_ + AT_OFF + i * 4096 + ldsA) = S_.ra[i]; *(u32x4*)(B_ + U_OFF + i * 4608 + ldsU) = S_.ru[i]; } \
    if (lt == 0) *(float*)(B_ + MISC_OFF) = __expf(S_.gl); } while (0)
            GDN_LOAD(sA, 0); GDN_WRITE(sA, 0); GDN_LOAD(sB, 1); GDN_LOAD(sA, 2);
            for (int n = 0; n < NCH; n += 2) {
                __syncthreads();
                GDN_WRITE(sB, 1);
                { const int nn = n + 3 < NCH ? n + 3 : NCH - 1; GDN_LOAD(sB, nn); }
                __syncthreads();
                GDN_WRITE(sA, 0);
                { const int nn = n + 4 < NCH ? n + 4 : NCH - 1; GDN_LOAD(sA, nn); }
            }
#undef GDN_LOAD
#undef GDN_WRITE
#undef GDN_SCALE2
        } else {
            f32x4v S[8];
#pragma unroll
            for (int m = 0; m < 8; ++m) S[m] = f32x4v{0.f, 0.f, 0.f, 0.f};
            const int cw = 16 * wid;
            for (int n = 0; n < NCH; ++n) {
                __syncthreads();
                if (VAR == 2) continue;
                const char* B = lds + (n & 1) * BUF; const int p0 = n * CHUNK;
                const float egl = *(const float*)(B + MISC_OFF);
                bf16x8 Sb[4];
#pragma unroll
                for (int s = 0; s < 4; ++s) { u32x4 w; w.x = cvtpk(S[2 * s][0], S[2 * s][1]); w.y = cvtpk(S[2 * s][2], S[2 * s][3]); w.z = cvtpk(S[2 * s + 1][0], S[2 * s + 1][1]); w.w = cvtpk(S[2 * s + 1][2], S[2 * s + 1][3]); Sb[s] = *(bf16x8*)&w; }
                f32x4v av[4], ao[4];
#pragma unroll
                for (int m = 0; m < 4; ++m) { av[m] = f32x4v{0.f, 0.f, 0.f, 0.f}; ao[m] = f32x4v{0.f, 0.f, 0.f, 0.f}; }
#pragma unroll
                for (int s = 0; s < 4; ++s)
#pragma unroll
                    for (int m = 0; m < 4; ++m) { const int off = (16 * m + li) * 256 + ((64 * s + 16 * lq) ^ (li << 4));
                        av[m] = __builtin_amdgcn_mfma_f32_16x16x32_bf16(*(const bf16x8*)(B + W_OFF + off), Sb[s], av[m], 0, 0, 0);
                        ao[m] = __builtin_amdgcn_mfma_f32_16x16x32_bf16(*(const bf16x8*)(B + QD_OFF + off), Sb[s], ao[m], 0, 0, 0); }
#pragma unroll
                for (int m = 0; m < 4; ++m)
#pragma unroll
                    for (int r = 0; r < 4; ++r) av[m][r] = bf2f(*(const bf16_t*)(B + U_OFF + (16 * m + 4 * lq + r) * 144 + (cw + li) * 2)) - av[m][r];
                bf16x8 Vb[2];
#pragma unroll
                for (int s = 0; s < 2; ++s) { u32x4 w; w.x = cvtpk(av[2 * s][0], av[2 * s][1]); w.y = cvtpk(av[2 * s][2], av[2 * s][3]); w.z = cvtpk(av[2 * s + 1][0], av[2 * s + 1][1]); w.w = cvtpk(av[2 * s + 1][2], av[2 * s + 1][3]); Vb[s] = *(bf16x8*)&w; }
#pragma unroll
                for (int s = 0; s < 2; ++s)
#pragma unroll
                    for (int m = 0; m < 4; ++m) { const int row = 16 * m + li;
                        ao[m] = __builtin_amdgcn_mfma_f32_16x16x32_bf16(*(const bf16x8*)(B + AT_OFF + row * 128 + ((64 * s + 16 * lq) ^ (((row >> 1) & 7) << 4))), Vb[s], ao[m], 0, 0, 0); }
#pragma unroll
                for (int m = 0; m < 8; ++m) S[m] = S[m] * egl;
                { s16x4 tr[8][4]; const int base = (int)(uintptr_t)(B + KD_OFF) + lq * 1152 + 8 * li;
#define GDN_TR(m_) do { asm volatile("ds_read_b64_tr_b16 %0, %1 offset:%2" : "=&v"(tr[m_][0]) : "v"(base), "i"((m_) * 128) : "memory"); \
    asm volatile("ds_read_b64_tr_b16 %0, %1 offset:%2" : "=&v"(tr[m_][1]) : "v"(base), "i"((m_) * 128 + 4608) : "memory"); \
    asm volatile("ds_read_b64_tr_b16 %0, %1 offset:%2" : "=&v"(tr[m_][2]) : "v"(base), "i"((m_) * 128 + 9216) : "memory"); \
    asm volatile("ds_read_b64_tr_b16 %0, %1 offset:%2" : "=&v"(tr[m_][3]) : "v"(base), "i"((m_) * 128 + 13824) : "memory"); } while (0)
#define GDN_SUP(m_) do { const bf16x8 k0 = bf16x8{tr[m_][0][0], tr[m_][0][1], tr[m_][0][2], tr[m_][0][3], tr[m_][1][0], tr[m_][1][1], tr[m_][1][2], tr[m_][1][3]}, \
        k1 = bf16x8{tr[m_][2][0], tr[m_][2][1], tr[m_][2][2], tr[m_][2][3], tr[m_][3][0], tr[m_][3][1], tr[m_][3][2], tr[m_][3][3]}; \
    S[m_] = __builtin_amdgcn_mfma_f32_16x16x32_bf16(k0, Vb[0], S[m_], 0, 0, 0); S[m_] = __builtin_amdgcn_mfma_f32_16x16x32_bf16(k1, Vb[1], S[m_], 0, 0, 0); } while (0)
                  GDN_TR(0); GDN_TR(1); GDN_TR(2); GDN_TR(3);
                  asm volatile("s_waitcnt lgkmcnt(0)" ::: "memory"); __builtin_amdgcn_sched_barrier(0);
                  GDN_TR(4); GDN_TR(5); GDN_TR(6); GDN_TR(7);
                  GDN_SUP(0); GDN_SUP(1); GDN_SUP(2); GDN_SUP(3);
                  asm volatile("s_waitcnt lgkmcnt(0)" ::: "memory"); __builtin_amdgcn_sched_barrier(0);
                  GDN_SUP(4); GDN_SUP(5); GDN_SUP(6); GDN_SUP(7);
#undef GDN_TR
#undef GDN_SUP
                }
#pragma unroll
                for (int m = 0; m < 4; ++m)
#pragma unroll
                    for (int r = 0; r < 4; ++r) { const int pv = p0 + 16 * m + 4 * lq + r; const int tk = dir ? SEQ - 1 - pv : pv;
                        Od[((size_t)dir * T + b * SEQ + tk) * 512 + h * 128 + c0 + cw + li] = f2bf(ao[m][r]); }
            }
        }
    }
    __syncthreads();
}


constexpr size_t OFF_SUMSQ = OFF_SH;
constexpr size_t OFF_KPE = OFF_R4;
__device__ __forceinline__ void cvt_tile(const float* src, int K, int N, const float* scale, bf16_t* dst, int Kpad, int tk, int tn, float* tile, int tid) {
    const int k0 = tk * 64, n0 = tn * 64;
#pragma unroll
    for (int i = 0; i < 2; ++i) { const int r = (tid >> 4) + 32 * i, k = k0 + r, n = n0 + (tid & 15) * 4; f32x4 v = {0.f, 0.f, 0.f, 0.f};
        if (k < K) { const float sc = scale ? scale[k] : 1.f;
            if (n + 3 < N) v = *(const f32x4*)(src + (size_t)k * N + n) * sc;
            else { for (int e = 0; e < 4; ++e) if (n + e < N) v[e] = src[(size_t)k * N + n + e] * sc; } }
#pragma unroll
        for (int e = 0; e < 4; ++e) tile[r * 65 + (tid & 15) * 4 + e] = v[e]; }
    __syncthreads();
    { const int nl = tid >> 3, kc = (tid & 7) * 8; float f[8];
#pragma unroll
      for (int j = 0; j < 8; ++j) f[j] = tile[(kc + j) * 65 + nl];
      *(u32x4*)(dst + (size_t)(n0 + nl) * Kpad + k0 + kc) = pack8(f); }
    __syncthreads();
}
__device__ __forceinline__ void ph0_v2(const Ctx& c, const Params& p) {
    unsigned char* ws = p.ws;
    constexpr int T0 = 16 * 40, T1 = T0 + 4 * 12, T2 = T1 + 4 * 16, T3 = T2 + 16 * 16, T4 = T3 + 16 * 32;
    for (int tile = c.bid; tile < T4; tile += c.nb) {
        if (tile < T0) cvt_tile(p.w_in, 1024, IN_W, p.ln1_w, (bf16_t*)(ws + OFF_WIN), 1024, tile % 16, tile / 16, c.lds, c.tid);
        else if (tile < T1) { const int r = tile - T0; cvt_tile(p.w_q_up, QRANK, 768, p.q_a_norm_w, (bf16_t*)(ws + OFF_WQUP), 256, r % 4, r / 4, c.lds, c.tid); }
        else if (tile < T2) { const int r = tile - T1; cvt_tile(p.w_kv_up, KVRANK, 1024, p.kv_a_norm_w, (bf16_t*)(ws + OFF_WKVUP), 256, r % 4, r / 4, c.lds, c.tid); }
        else if (tile < T3) { const int r = tile - T2; cvt_tile(p.w_out, 1024, 1024, nullptr, (bf16_t*)(ws + OFF_WOUT), 1024, r % 16, r / 16, c.lds, c.tid); }
        else { const int r = tile - T3; cvt_tile(p.peer_wq, 1024, 2048, p.ln2_w, (bf16_t*)(ws + OFF_WPQ), 1024, r % 16, r / 16, c.lds, c.tid); }
    }
    { bf16_t* d = (bf16_t*)(ws + OFF_SUBK); const int total4 = PH * 2 * NKEYS * 128 / 4;
      for (int i = c.bid * NT + c.tid; i < total4; i += c.nb * NT) { const f32x4 v = ((const f32x4*)p.sub_keys)[i]; u32x2 o; o.x = gdn::cvtpk(v.x, v.y); o.y = gdn::cvtpk(v.z, v.w); ((u32x2*)d)[i] = o; } }
    { float* sq = (float*)(ws + OFF_SUMSQ); for (int i = c.bid * NT + c.tid; i < T; i += c.nb * NT) sq[i] = 0.f; }
    bf16_t* xb = (bf16_t*)(ws + OFF_R2); float* rstd1 = (float*)(ws + OFF_VEC);
    for (int m = c.gw; m < T; m += c.ngw) {
        const f32x4* xr = (const f32x4*)(p.x + (size_t)m * D_MODEL) + c.lane;
        f32x4 v[4]; float s = 0.f;
#pragma unroll
        for (int j = 0; j < 4; ++j) { v[j] = xr[64 * j]; s += v[j].x * v[j].x + v[j].y * v[j].y + v[j].z * v[j].z + v[j].w * v[j].w; }
        s = wave_sum(s);
        const float rs = rsqrtf(s * (1.f / D_MODEL) + EPS);
        if (c.lane == 0) rstd1[m] = rs;
        u32x2* o = (u32x2*)(xb + (size_t)m * D_MODEL) + c.lane;
#pragma unroll
        for (int j = 0; j < 4; ++j) { u32x2 w; w.x = gdn::cvtpk(v[j].x * rs, v[j].y * rs); w.y = gdn::cvtpk(v[j].z * rs, v[j].w * rs); o[64 * j] = w; }
    }
}

__device__ __forceinline__ void ph2a1_v2(const Ctx& c, const Params& p) {
    const int lane = opaque_tid() & 63;
    const bf16_t* proj = (const bf16_t*)(p.ws + OFF_R1);
    bf16_t* gq = (bf16_t*)(p.ws + OFF_R2); bf16_t* gk = gq + (size_t)T * 512; bf16_t* gv = gk + (size_t)T * 512; bf16_t* zs = gv + (size_t)T * 512;
    const int part = c.gw & 3;
    float cw[5][8];
#pragma unroll
    for (int j = 0; j < 5; ++j)
#pragma unroll
        for (int e = 0; e < 8; ++e) cw[j][e] = part < 3 ? p.conv_w[j * GDN_QKV + part * 512 + 8 * lane + e] : 0.f;
    for (int run = c.gw >> 2; run < T / 16; run += c.ngw >> 2) {
        const int t0 = run * 16, b = t0 / SEQ, s0 = t0 % SEQ;
        if (part == 3) {
#pragma unroll 4
            for (int i = 0; i < 16; ++i) { float f[8]; unpack8(*(const u32x4*)(proj + (size_t)(t0 + i) * IN_WP + C_Z + 8 * lane), f);
#pragma unroll
                for (int e = 0; e < 8; ++e) f[e] = siluf_(f[e]);
                *(u32x4*)(zs + (size_t)(t0 + i) * 512 + 8 * lane) = pack8(f); }
        } else {
            const bf16_t* base = proj + (size_t)t0 * IN_WP + C_QKV + part * 512 + 8 * lane;
            const u32x4 zero = {0u, 0u, 0u, 0u};
            u32x4 xw[5];
            xw[0] = s0 >= 2 ? *(const u32x4*)(base - 2 * IN_WP) : zero; xw[1] = s0 >= 1 ? *(const u32x4*)(base - IN_WP) : zero;
            xw[2] = *(const u32x4*)(base); xw[3] = *(const u32x4*)(base + IN_WP);
            bf16_t* dst = (part == 0 ? gq : part == 1 ? gk : gv) + ((size_t)(b * GH + (lane >> 4)) * SEQ + s0) * 128 + (lane & 15) * 8;
#pragma unroll
            for (int i = 0; i < 16; ++i) {
                xw[4] = (s0 + i + 2 < SEQ) ? *(const u32x4*)(base + (size_t)(i + 2) * IN_WP) : zero;
                float y[8];
#pragma unroll
                for (int e = 0; e < 8; ++e) y[e] = 0.f;
#pragma unroll
                for (int j = 0; j < 5; ++j) { float f[8]; unpack8(xw[j], f);
#pragma unroll
                    for (int e = 0; e < 8; ++e) y[e] += cw[j][e] * f[e]; }
                float ss = 0.f;
#pragma unroll
                for (int e = 0; e < 8; ++e) { y[e] = siluf_(y[e]); ss += y[e] * y[e]; }
                if (part < 2) { ss += __shfl_xor(ss, 1); ss += __shfl_xor(ss, 2); ss += __shfl_xor(ss, 4); ss += __shfl_xor(ss, 8);
                    const float rs = rsqrtf(ss + EPS) * (part == 0 ? 0.08838834764831845f : 1.f);
#pragma unroll
                    for (int e = 0; e < 8; ++e) y[e] *= rs; }
                *(u32x4*)(dst + (size_t)i * 128) = pack8(y);
                xw[0] = xw[1]; xw[1] = xw[2]; xw[2] = xw[3]; xw[3] = xw[4];
            }
        }
    }
    { float* Gg = (float*)(p.ws + OFF_GATE); float* Gb = Gg + 2 * T * GH;
      for (int t = c.bid * NT + c.tid; t < T; t += c.nb * NT) { const int b = t / SEQ, s = t % SEQ; float f0[8], f1[8];
          unpack8(*(const u32x4*)(proj + (size_t)t * IN_WP + C_GATE), f0); unpack8(*(const u32x4*)(proj + (size_t)t * IN_WP + C_GATE + 8), f1);
#pragma unroll
          for (int h = 0; h < 4; ++h) { const size_t gi = (size_t)(b * GH + h) * SEQ + s;
              Gg[gi] = -expf(p.a_log_f[h]) * softplusf_(f0[h] + p.dt_bias_f[h]); Gb[gi] = sigmoidf_(f0[4 + h]);
              Gg[(size_t)T * GH + gi] = -expf(p.a_log_b[h]) * softplusf_(f1[h] + p.dt_bias_b[h]); Gb[(size_t)T * GH + gi] = sigmoidf_(f1[4 + h]); } } }
    { float* rq = (float*)(p.ws + OFF_VEC) + T; float* rkv = rq + T; bf16_t* kpe = (bf16_t*)(p.ws + OFF_KPE);
      for (int t = c.gw; t < T; t += c.ngw) { u32x4 v = {0u, 0u, 0u, 0u}; if (lane < 56) v = *(const u32x4*)(proj + (size_t)t * IN_WP + 8 * lane);
          float f[8]; unpack8(v, f); float ss = 0.f;
#pragma unroll
          for (int e = 0; e < 8; ++e) ss += f[e] * f[e];
          const float sq = wave_sum(lane < 32 ? ss : 0.f), sk = wave_sum((lane >= 32 && lane < 48) ? ss : 0.f);
          if (lane == 0) { rq[t] = rsqrtf(sq * (1.f / QRANK) + EPS); rkv[t] = rsqrtf(sk * (1.f / KVRANK) + EPS); }
          if (lane >= 48 && lane < 56) *(u32x4*)(kpe + (size_t)t * 64 + (lane - 48) * 8) = v; } }
}

__device__ __forceinline__ void ph2a3_v2(const Ctx& c, const Params& p) {
    const int lane = opaque_tid() & 63;
    const bf16_t* qraw = (const bf16_t*)(p.ws + OFF_R5); const bf16_t* kvraw = (const bf16_t*)(p.ws + OFF_R3); const bf16_t* kpe = (const bf16_t*)(p.ws + OFF_KPE);
    const float* rq = (const float*)(p.ws + OFF_VEC) + T; const float* rkv = rq + T;
    bf16_t* Q = (bf16_t*)p.out; bf16_t* Kk = Q + (size_t)T * MLA_H * QKD; bf16_t* V = Kk + (size_t)T * MLA_H * QKD;
    const int h = lane >> 4, cc = lane & 15, hh = (lane >> 2) & 3, pc = lane & 3;
    const float inv = expf(-(float)(lane & 31) * (9.210340371976184f / 32.f));
    for (int t = c.gw; t < T; t += c.ngw) {
        const int b = t / SEQ, s = t % SEQ; const float rqv = rq[t], rkvv = rkv[t];
        float sn, cs; sincosf((float)p.pos[t] * inv, &sn, &cs);
        const size_t qo = ((size_t)(b * MLA_H + h) * SEQ + s) * QKD, vo = ((size_t)(b * MLA_H + h) * SEQ + s) * VDIM;
        { float f[8]; unpack8(*(const u32x4*)(qraw + (size_t)t * 768 + h * 192 + cc * 8), f);
#pragma unroll
          for (int e = 0; e < 8; ++e) f[e] *= rqv;
          *(u32x4*)(Q + qo + cc * 8) = pack8(f);
          unpack8(*(const u32x4*)(kvraw + (size_t)t * 1024 + h * 256 + cc * 8), f);
#pragma unroll
          for (int e = 0; e < 8; ++e) f[e] *= rkvv;
          *(u32x4*)(Kk + qo + cc * 8) = pack8(f);
          unpack8(*(const u32x4*)(kvraw + (size_t)t * 1024 + h * 256 + 128 + cc * 8), f);
#pragma unroll
          for (int e = 0; e < 8; ++e) f[e] *= rkvv;
          *(u32x4*)(V + vo + cc * 8) = pack8(f); }
        float cs8[8], sn8[8];
#pragma unroll
        for (int e = 0; e < 8; ++e) { cs8[e] = __shfl(cs, pc * 8 + e); sn8[e] = __shfl(sn, pc * 8 + e); }
        if (lane < 16) {
            const size_t ro = ((size_t)(b * MLA_H + hh) * SEQ + s) * QKD;
            float a[8], bq[8], o1[8], o2[8];
            unpack8(*(const u32x4*)(qraw + (size_t)t * 768 + hh * 192 + 128 + pc * 8), a); unpack8(*(const u32x4*)(qraw + (size_t)t * 768 + hh * 192 + 160 + pc * 8), bq);
#pragma unroll
            for (int e = 0; e < 8; ++e) { o1[e] = (a[e] * cs8[e] - bq[e] * sn8[e]) * rqv; o2[e] = (bq[e] * cs8[e] + a[e] * sn8[e]) * rqv; }
            *(u32x4*)(Q + ro + 128 + pc * 8) = pack8(o1); *(u32x4*)(Q + ro + 160 + pc * 8) = pack8(o2);
            unpack8(*(const u32x4*)(kpe + (size_t)t * 64 + pc * 8), a); unpack8(*(const u32x4*)(kpe + (size_t)t * 64 + 32 + pc * 8), bq);
#pragma unroll
            for (int e = 0; e < 8; ++e) { o1[e] = a[e] * cs8[e] - bq[e] * sn8[e]; o2[e] = bq[e] * cs8[e] + a[e] * sn8[e]; }
            *(u32x4*)(Kk + ro + 128 + pc * 8) = pack8(o1); *(u32x4*)(Kk + ro + 160 + pc * 8) = pack8(o2);
        }
    }
}

__device__ __forceinline__ void ph4a_v2(const Ctx& c, const Params& p, bool split) {
    const int lane = opaque_tid() & 63;
    const bf16_t* Od = (const bf16_t*)(p.ws + OFF_R3); const bf16_t* omla = (const bf16_t*)(p.ws + OFF_R4);
    const bf16_t* zs = (const bf16_t*)(p.ws + OFF_R2) + (size_t)3 * T * 512; bf16_t* cat = (bf16_t*)(p.ws + OFF_R1);
    float gw8[8];
#pragma unroll
    for (int e = 0; e < 8; ++e) gw8[e] = p.gdn_norm_w[(lane & 15) * 8 + e];
    for (int t = c.gw; t < T; t += c.ngw) {
        float a[8], bb[8], z[8];
        unpack8(*(const u32x4*)(Od + (size_t)t * 512 + lane * 8), a); unpack8(*(const u32x4*)(Od + ((size_t)T + t) * 512 + lane * 8), bb); unpack8(*(const u32x4*)(zs + (size_t)t * 512 + lane * 8), z);
        float ss = 0.f;
#pragma unroll
        for (int e = 0; e < 8; ++e) { a[e] += bb[e]; ss += a[e] * a[e]; }
        ss += __shfl_xor(ss, 1); ss += __shfl_xor(ss, 2); ss += __shfl_xor(ss, 4); ss += __shfl_xor(ss, 8);
        const float r = rsqrtf(ss * (1.f / 128.f) + EPS);
#pragma unroll
        for (int e = 0; e < 8; ++e) a[e] = a[e] * r * gw8[e] * z[e];
        *(u32x4*)(cat + (size_t)t * 1024 + 512 + lane * 8) = pack8(a);
        const int s_ = t % SEQ;
        if (split && s_ >= 28 * 256) {
            const int lu = ((s_ >> 8) - 28) * 8 + (t / SEQ) * 4 + (lane >> 4), row = s_ & 255;
            const float* ml = (const float*)(p.ws + OFF_PARTML) + ((size_t)lu * 7 * 256 + row) * 2; const bf16_t* po = (const bf16_t*)(p.ws + OFF_PART) + ((size_t)lu * 7 * 256 + row) * 128 + (lane & 15) * 8;
            float mp[7], lp[7], M = -3e38f;
#pragma unroll
            for (int q = 0; q < 7; ++q) { mp[q] = ml[q * 512]; lp[q] = ml[q * 512 + 1]; M = fmaxf(M, mp[q]); }
            float o8[8], L = 0.f;
#pragma unroll
            for (int e = 0; e < 8; ++e) o8[e] = 0.f;
#pragma unroll
            for (int q = 0; q < 7; ++q) { const float w = exp2f((mp[q] - M) * (attn::SCALE * 1.4426950408889634f)); L += w * lp[q]; float f[8]; unpack8(*(const u32x4*)(po + (size_t)q * 256 * 128), f);
#pragma unroll
                for (int e = 0; e < 8; ++e) o8[e] += w * f[e]; }
            const float il = 1.f / L;
#pragma unroll
            for (int e = 0; e < 8; ++e) o8[e] *= il;
            *(u32x4*)(cat + (size_t)t * 1024 + lane * 8) = pack8(o8);
        } else
        *(u32x4*)(cat + (size_t)t * 1024 + lane * 8) = *(const u32x4*)(omla + (size_t)t * 512 + lane * 8);
    }
}


constexpr size_t OFF_HQ = OFF_R1;
constexpr size_t OFF_HSC = OFF_VEC + 3 * (size_t)T * 4;
constexpr size_t OFF_CBUF = OFF_R3;
constexpr size_t OFF_SUMSQ2 = OFF_VEC + (size_t)T * 4;
__device__ __forceinline__ float gelu_as(float v) {
    const float av = fabsf(v), t = __builtin_amdgcn_rcpf(av * 0.2316418882f + 1.0f);
    float q = t * 0.5307027145f + (-0.7265760135f); q = q * t + 0.7107068705f; q = q * t + (-0.142248368f); q = q * t + 0.127414796f; q = q * t;
    const float m = v * (q * __builtin_amdgcn_exp2f((v * v) * (-0.72134752044f)));
    return v < 0.f ? m : v - m;
}
__device__ __forceinline__ void peer_hq(const Ctx& c, const Params& p) {
    const int lane = c.lane; unsigned char* hq = p.ws + OFF_HQ; float* hsc = (float*)(p.ws + OFF_HSC);
    for (int t = c.gw; t < T; t += c.ngw) {
        const float* row = p.out + (size_t)t * 1024 + 16 * lane; f32x4 hr[4]; float ssq = 0.f, mx = 0.f;
#pragma unroll
        for (int j = 0; j < 4; ++j) { hr[j] = *(const f32x4*)(row + 4 * j);
#pragma unroll
            for (int k = 0; k < 4; ++k) { ssq += hr[j][k] * hr[j][k]; mx = fmaxf(mx, fabsf(hr[j][k])); } }
        ssq = wave_sum(ssq); mx = fmaxf(wave_max(mx), 1e-30f);
        const float qinv = 127.f / mx;
        u32x4 hv; hv.x = q4(hr[0].x, hr[0].y, hr[0].z, hr[0].w, qinv, 0); hv.y = q4(hr[1].x, hr[1].y, hr[1].z, hr[1].w, qinv, 0);
        hv.z = q4(hr[2].x, hr[2].y, hr[2].z, hr[2].w, qinv, 0); hv.w = q4(hr[3].x, hr[3].y, hr[3].z, hr[3].w, qinv, 0);
        *(u32x4*)(hq + (size_t)t * 1024 + 16 * lane) = hv;
        if (lane == 0) hsc[t] = rsqrtf(ssq * (1.f / 1024.f) + EPS) * mx * (1.f / 127.f);
    }
}
template <int VAR>
__device__ __forceinline__ void peer_H3(const Ctx& c, const Params& p) {
    const int tid = opaque_tid(), lane = tid & 63, wid = __builtin_amdgcn_readfirstlane(tid >> 6), grp = lane >> 3, sub = lane & 7;
    const unsigned char* hq = p.ws + OFF_HQ; const float* hsc = (const float*)(p.ws + OFF_HSC);
    const unsigned char* u8 = p.ws + OFF_R5; const float* su = (const float*)(p.ws + OFF_SU);
    const int* experts = (const int*)(p.ws + OFF_R4); const float* gates = (const float*)(p.ws + OFF_R4 + 8 * MB);
    float* cbuf = (float*)(p.ws + OFF_CBUF);
    { float* s2 = (float*)(p.ws + OFF_SUMSQ2); for (int i = c.bid * NT + tid; i < T; i += c.nb * NT) s2[i] = 0.f; }
    const int x = c.bid & 7, nslw = ((c.nb - x + 7) >> 3) * (NT / 64), wx = (c.bid >> 3) * (NT / 64) + wid;
    int* cE = (int*)c.lds + wid * 384; float* cG = (float*)(cE + 128); int* cS = cE + 256;
    int e0n = 0, e1n = 0; float g0n = 0.f, g1n = 0.f, hsn = 0.f; u32x4 hvn[8];
#define PH_FETCH(t_) do { e0n = experts[(size_t)(t_) * 128 + lane]; e1n = experts[(size_t)(t_) * 128 + 64 + lane]; g0n = gates[(size_t)(t_) * 128 + lane]; g1n = gates[(size_t)(t_) * 128 + 64 + lane]; hsn = hsc[t_]; \
    _Pragma("unroll") for (int j_ = 0; j_ < 8; ++j_) hvn[j_] = *(const u32x4*)(hq + (size_t)(t_) * 1024 + sub * 16 + j_ * 128); } while (0)
    if (wx < T) PH_FETCH(wx);
    for (int t = wx; t < T; t += nslw) {
        const int e0 = e0n, e1 = e1n; const float g0 = g0n, g1 = g1n, hs = hsn; u32x4 hv[8];
#pragma unroll
        for (int j = 0; j < 8; ++j) hv[j] = hvn[j];
        { const int tn = t + nslw < T ? t + nslw : t; PH_FETCH(tn); }
        const bool in0 = (e0 >> 11) == x, in1 = (e1 >> 11) == x;
        const unsigned long long m0 = __ballot(in0), m1 = __ballot(in1);
        const int n0 = __popcll(m0), cnt = n0 + __popcll(m1);
        const int r0 = __builtin_amdgcn_mbcnt_hi((unsigned)(m0 >> 32), __builtin_amdgcn_mbcnt_lo((unsigned)m0, 0));
        const int r1 = n0 + __builtin_amdgcn_mbcnt_hi((unsigned)(m1 >> 32), __builtin_amdgcn_mbcnt_lo((unsigned)m1, 0));
        if (in0) { cE[r0] = e0; cG[r0] = g0; cS[r0] = lane; }
        if (in1) { cE[r1] = e1; cG[r1] = g1; cS[r1] = 64 + lane; }
        for (int b0 = 0; b0 < (VAR == 1 ? 0 : cnt); b0 += 24) {
            int me[3]; float mg[3], msu[3]; int ms[3]; u32x4 ur[3][8];
            const bool third = cnt - b0 > 16;
#pragma unroll
            for (int q = 0; q < 3; ++q) { const int ent = min(b0 + 8 * q + grp, cnt - 1); me[q] = cE[ent]; mg[q] = cG[ent]; ms[q] = cS[ent]; }
#pragma unroll
            for (int q = 0; q < 3; ++q) if (q < 2 || third) { msu[q] = su[me[q]]; const unsigned char* pr = u8 + (size_t)me[q] * 1024 + sub * 16;
#pragma unroll
                for (int j = 0; j < 8; ++j) { if (VAR == 3) ur[q][j] = hv[j]; else ur[q][j] = *(const u32x4*)(pr + j * 128); } }
            __builtin_amdgcn_sched_barrier(0);
#pragma unroll
            for (int q = 0; q < 3; ++q) if (q < 2 || third) {
                int s0 = 0, s1 = 0, s2_ = 0, s3 = 0;
                if (VAR == 2) { s0 = (int)(ur[q][0].x ^ ur[q][1].x ^ ur[q][2].x ^ ur[q][3].x ^ ur[q][4].x ^ ur[q][5].x ^ ur[q][6].x ^ ur[q][7].x); }
                else
#pragma unroll
                for (int j = 0; j < 8; ++j) { s0 = __builtin_amdgcn_sdot4((int)hv[j].x, (int)ur[q][j].x, s0, false); s1 = __builtin_amdgcn_sdot4((int)hv[j].y, (int)ur[q][j].y, s1, false);
                    s2_ = __builtin_amdgcn_sdot4((int)hv[j].z, (int)ur[q][j].z, s2_, false); s3 = __builtin_amdgcn_sdot4((int)hv[j].w, (int)ur[q][j].w, s3, false); }
                int s = (s0 + s1) + (s2_ + s3);
                s += __builtin_amdgcn_update_dpp(0, s, 0xB1, 0xf, 0xf, true);
                s += __builtin_amdgcn_update_dpp(0, s, 0x4E, 0xf, 0xf, true);
                s += __builtin_amdgcn_update_dpp(0, s, 0x141, 0xf, 0xf, true);
                const float cc = mg[q] * gelu_as(hs * msu[q] * (float)s);
                if (sub == 0 && b0 + 8 * q + grp < cnt) cbuf[(size_t)t * 128 + ms[q]] = cc;
            }
        }
    }
#undef PH_FETCH
}
template <int DRY>
__device__ __forceinline__ void peer_O2(const Ctx& c, const Params& p) {
    typedef float f32x2 __attribute__((ext_vector_type(2)));
    const int tid = opaque_tid(), lane = tid & 63, wid = __builtin_amdgcn_readfirstlane(tid >> 6);
    const unsigned char* v8 = p.ws + OFF_R5 + (size_t)NEXP * 1024;
    const int* experts = (const int*)(p.ws + OFF_R4); const float* cbuf = (const float*)(p.ws + OFF_CBUF); float* s2 = (float*)(p.ws + OFF_SUMSQ2);
    const int x = c.bid & 7, nslw = ((c.nb - x + 7) >> 3) * (NT / 64), wx = (c.bid >> 3) * (NT / 64) + wid;
    const int grp = lane >> 3, sub = lane & 7, col = 128 * x + 16 * sub;
    const unsigned char* v8x = v8 + (size_t)x * ((size_t)NEXP * 128) + 16 * sub;
    u32x4 En[2][4];
#define PO_FETCH(u_, t_) do { _Pragma("unroll") for (int j_ = 0; j_ < 4; ++j_) En[u_][j_] = *(const u32x4*)(experts + (size_t)(t_) * 128 + grp * 16 + 4 * j_); } while (0)
#pragma unroll
    for (int u = 0; u < 2; ++u) { const int tt = wx + u * nslw < T ? wx + u * nslw : 0; PO_FETCH(u, tt); }
    for (int t = wx; t < T; t += 2 * nslw) {
        u32x4 vr[2][16]; f32x4 cv[2][4]; f32x4 hpre[2][4];
#pragma unroll
        for (int u = 0; u < 2; ++u) { const int tt = t + u * nslw < T ? t + u * nslw : 0;
#pragma unroll
            for (int j = 0; j < 4; ++j) hpre[u][j] = *(const f32x4*)(p.out + (size_t)tt * 1024 + col + 4 * j);
#pragma unroll
            for (int j = 0; j < 4; ++j) { cv[u][j] = *(const f32x4*)(cbuf + (size_t)tt * 128 + grp * 16 + 4 * j);
#pragma unroll
                for (int k = 0; k < 4; ++k) { int e = (int)En[u][j][k]; if (DRY == 2) e &= 7; vr[u][4 * j + k] = *(const u32x4*)(v8x + (size_t)e * 128); } } }
#pragma unroll
        for (int u = 0; u < 2; ++u) { const int tn = t + (2 + u) * nslw; const int tt = tn < T ? tn : 0; PO_FETCH(u, tt); }
        __builtin_amdgcn_sched_barrier(0);
#pragma unroll
        for (int u = 0; u < 2; ++u) {
            f32x2 acc[8];
#pragma unroll
            for (int i = 0; i < 8; ++i) acc[i] = f32x2{0.f, 0.f};
#pragma unroll
            for (int it = 0; it < 16; ++it) { const float cs_ = cv[u][it >> 2][it & 3]; const f32x2 cc = {cs_, cs_};
#pragma unroll
                for (int w = 0; w < 4; ++w) { const int q = (int)vr[u][it][w];
                    acc[2 * w] += __builtin_amdgcn_cvt_pk_f32_fp8(q, false) * cc; acc[2 * w + 1] += __builtin_amdgcn_cvt_pk_f32_fp8(q, true) * cc; } }
            float a16[16];
#pragma unroll
            for (int i = 0; i < 8; ++i) { a16[2 * i] = acc[i].x; a16[2 * i + 1] = acc[i].y; }
#pragma unroll
            for (int i = 0; i < 16; ++i) { float v = a16[i];
                v += __builtin_amdgcn_update_dpp(0.f, v, 0x128, 0xf, 0xf, true);
                { auto r = __builtin_amdgcn_permlane16_swap(__float_as_uint(v), __float_as_uint(v), false, false); v = __uint_as_float(r[0]) + __uint_as_float(r[1]); }
                { auto r = __builtin_amdgcn_permlane32_swap(__float_as_uint(v), __float_as_uint(v), false, false); v = __uint_as_float(r[0]) + __uint_as_float(r[1]); }
                a16[i] = v; }
            const int tt = t + u * nslw; float ss = 0.f;
            if (grp == 0 && tt < T) { float* hrow = p.out + (size_t)tt * 1024 + col;
#pragma unroll
                for (int j = 0; j < 4; ++j) { f32x4 hv = hpre[u][j];
                    hv[0] += a16[4 * j]; hv[1] += a16[4 * j + 1]; hv[2] += a16[4 * j + 2]; hv[3] += a16[4 * j + 3];
                    ss += hv[0] * hv[0] + hv[1] * hv[1] + hv[2] * hv[2] + hv[3] * hv[3];
                    if (!DRY) *(f32x4*)(hrow + 4 * j) = hv; } }
            ss += __builtin_amdgcn_update_dpp(0.f, ss, 0xB1, 0xf, 0xf, true); ss += __builtin_amdgcn_update_dpp(0.f, ss, 0x4E, 0xf, 0xf, true); ss += __builtin_amdgcn_update_dpp(0.f, ss, 0x141, 0xf, 0xf, true);
            if (DRY) asm volatile("" :: "v"(ss)); else if (lane == 0 && tt < T) unsafeAtomicAdd(s2 + tt, ss);
        }
    }
#undef PO_FETCH
}
__device__ __forceinline__ void peer_N(const Ctx& c, const Params& p) {
    const int lane = c.lane; const float* s2 = (const float*)(p.ws + OFF_SUMSQ2);
    for (int t = c.gw; t < T; t += c.ngw) {
        float* row = p.out + (size_t)t * 1024 + 4 * lane; const float r = rsqrtf(s2[t] * (1.f / 1024.f) + EPS);
#pragma unroll
        for (int j = 0; j < 4; ++j) *(f32x4*)(row + 256 * j) = *(const f32x4*)(row + 256 * j) * r * *(const f32x4*)(p.final_w + 4 * lane + 256 * j);
    }
}

constexpr int LDS_BYTES = 144 * 1024;
__global__ void __launch_bounds__(NT, 2) fwd_megakernel(Params p) {
    extern __shared__ __attribute__((aligned(16))) unsigned char lds_raw[];
    cg::grid_group grid = cg::this_grid();
#define MKCTX() ({ Ctx c_; c_.tid = opaque_tid(); c_.lane = c_.tid & 63; c_.wave = __builtin_amdgcn_readfirstlane(c_.tid >> 6); c_.bid = blockIdx.x; c_.nb = gridDim.x; \
    c_.gw = c_.bid * (NT / 64) + c_.wave; c_.ngw = c_.nb * (NT / 64); c_.lds = (float*)lds_raw; c_; })
    Ctx c = MKCTX();
    volatile LAS unsigned* xb_st = (volatile LAS unsigned*)(lds_raw + LDS_BYTES - 16);
    if (threadIdx.x < 4) xb_st[threadIdx.x] = 0u;
    __syncthreads();
    const XcdBarrier xbar = xcd_barrier_post((unsigned*)(p.ws + OFF_BAR), xb_st);
#define GSYNC() do { xcd_barrier(xbar); c = MKCTX(); } while (0)
#define RP(k, call) for (int r_ = 0; r_ < ((PROBE_PH == (k)) ? 2 : 1); ++r_) { call; }
    if (PROBE_PH == 30 && c.tid == 0) __hip_atomic_store((unsigned*)(p.ws + OFF_BAR + 16384) + c.bid, xb_xcc_id(), __ATOMIC_RELAXED, __HIP_MEMORY_SCOPE_AGENT);
    RP(0, ph0_v2(c, p));
    if (p.ws == nullptr) grid.sync();
    GSYNC();
    RP(1, ph1_mfma(c, p)); GSYNC();
    RP(2, ph2a1_v2(c, p)); RP(3, ph2a2_v2(c, p)); GSYNC();
    RP(4, ph2a3_v2(c, p)); if (PROBE_PH == 24) ph2b_v4<1>(c, p);
    if (PROBE_PH == 25) ph2b_v4<2>(c, p);
    RP(5, ph2b_v4<0>(c, p)); GSYNC();
    const bool split = c.nb == 256; constexpr int TAB_SPLIT = NEXP / 2;
    if (split) {
        if (c.bid >= 32) { RP(6, ph3a_split(c, p)); }
        else { RP(7, ph3b_mfma<0>(c, p)); RP(9, ph4a_tables_q8(c, p, c.gw, 32 * (NT / 64), 0, TAB_SPLIT)); }
    } else {
        ph3a_mfma(c, p);
        if (c.bid < 32) ph3b_mfma<0>(c, p); else ph4a_tables_q8(c, p, (c.bid - 32) * (NT / 64) + c.wave, (c.nb - 32) * (NT / 64), 0, TAB_SPLIT);
    }
    GSYNC();
    RP(8, ph4a_v2(c, p, split)); RP(11, ph4a_tables_q8(c, p, c.gw, c.ngw, TAB_SPLIT, 2 * NEXP)); GSYNC();
    RP(10, ph4b_v2(c, p)); GSYNC();
    RP(12, ph5_v2(c, p)); GSYNC();
    RP(13, ph6_fast(c, p));
    if (PROBE_PH == 30 && c.bid == 0 && c.tid == 0) {
        const unsigned* ids = (const unsigned*)(p.ws + OFF_BAR + 16384); bool ok = true;
        for (int b_ = 0; b_ < c.nb; ++b_) ok = ok && (__hip_atomic_load(ids + b_, __ATOMIC_RELAXED, __HIP_MEMORY_SCOPE_AGENT) == __hip_atomic_load(ids + (b_ & 7), __ATOMIC_RELAXED, __HIP_MEMORY_SCOPE_AGENT));
        for (int b_ = 0; b_ < 8; ++b_) for (int c_ = 0; c_ < b_; ++c_) ok = ok && (__hip_atomic_load(ids + b_, __ATOMIC_RELAXED, __HIP_MEMORY_SCOPE_AGENT) != __hip_atomic_load(ids + c_, __ATOMIC_RELAXED, __HIP_MEMORY_SCOPE_AGENT));
        if (!ok) for (int i_ = 0; i_ < 1024 * 64; ++i_) ((float*)p.out)[i_ * 16] = 1e30f; }
    RP(17, peer_hq(c, p)); GSYNC();
    if (PROBE_PH == 26) peer_H3<1>(c, p);
    if (PROBE_PH == 27) peer_H3<2>(c, p);
    if (PROBE_PH == 28) peer_H3<3>(c, p);
    RP(18, peer_H3<0>(c, p)); GSYNC();
    if (PROBE_PH == 19) peer_O2<1>(c, p);
    if (PROBE_PH == 22) peer_O2<2>(c, p);
    peer_O2<0>(c, p); GSYNC();
    peer_N(c, p);
    if (PROBE_PH == 15) { for (int r_ = 0; r_ < 10; ++r_) GSYNC(); }
}

extern "C" void kernel_launch(void* const* d_in, const int* in_sizes, int n_in, void* d_out, int out_size, void* d_ws, size_t ws_size, hipStream_t stream) {
    static int grid_blocks = 0;
    if (grid_blocks == 0) {
        if (n_in != 21 || out_size != T * D_MODEL || ws_size < WS_END) { fprintf(stderr, "kernel_launch: unexpected shapes n_in %d out %d ws %zu\n", n_in, out_size, ws_size); grid_blocks = -1; return; }
        int dev = 0, cus = 0, per_cu = 0;
        hipGetDevice(&dev); hipDeviceGetAttribute(&cus, hipDeviceAttributeMultiprocessorCount, dev);
        if (hipFuncSetAttribute((const void*)fwd_megakernel, hipFuncAttributeMaxDynamicSharedMemorySize, LDS_BYTES) != hipSuccess) { fprintf(stderr, "kernel_launch: hipFuncSetAttribute failed\n"); grid_blocks = -1; return; }
        if (hipOccupancyMaxActiveBlocksPerMultiprocessor(&per_cu, (const void*)fwd_megakernel, NT, LDS_BYTES) != hipSuccess || per_cu < 1) { fprintf(stderr, "kernel_launch: occupancy query failed (%d)\n", per_cu); grid_blocks = -1; return; }
        grid_blocks = cus * per_cu;
    }
    if (grid_blocks < 0) return;
    Params p{};
    p.x = (const float*)d_in[0]; p.pos = (const int*)d_in[1]; p.ln1_w = (const float*)d_in[2]; p.w_in = (const float*)d_in[3]; p.q_a_norm_w = (const float*)d_in[4];
    p.w_q_up = (const float*)d_in[5]; p.kv_a_norm_w = (const float*)d_in[6]; p.w_kv_up = (const float*)d_in[7]; p.conv_w = (const float*)d_in[8];
    p.a_log_f = (const float*)d_in[9]; p.dt_bias_f = (const float*)d_in[10]; p.a_log_b = (const float*)d_in[11]; p.dt_bias_b = (const float*)d_in[12];
    p.gdn_norm_w = (const float*)d_in[13]; p.w_out = (const float*)d_in[14]; p.ln2_w = (const float*)d_in[15]; p.peer_wq = (const float*)d_in[16];
    p.sub_keys = (const float*)d_in[17]; p.peer_u = (const float*)d_in[18]; p.peer_v = (const float*)d_in[19]; p.final_w = (const float*)d_in[20];
    p.out = (float*)d_out; p.ws = (unsigned char*)d_ws;
    if (hipMemsetAsync((char*)d_ws + OFF_BAR, 0, 16384, stream) != hipSuccess) { fprintf(stderr, "kernel_launch: memset of barrier words failed\n"); return; }
    void* args[] = {&p};
    hipError_t e = hipLaunchCooperativeKernel((const void*)fwd_megakernel, dim3(grid_blocks), dim3(NT), args, LDS_BYTES, stream);
    if (e != hipSuccess) fprintf(stderr, "cooperative launch failed: %s (grid %d)\n", hipGetErrorString(e), grid_blocks);
}
```

```cpp
#include <hip/hip_runtime.h>
#include <hip/hip_cooperative_groups.h>
#include <cstdio>
#include <cstdint>
namespace cg = cooperative_groups;

#ifndef PROBE_PH
#define PROBE_PH -1
#endif
constexpr int D_MODEL = 1024, BATCH = 2, SEQ = 8192, T = BATCH * SEQ;
constexpr int MLA_H = 4, QRANK = 256, KVRANK = 128, NOPE = 128, ROPE = 64, VDIM = 128, QKD = 192;
constexpr int GH = 4, DK = 128, DV = 128, CHUNK = 64, NCH = SEQ / CHUNK;
constexpr int GDN_QKV = 1536, IN_W = 2512, IN_WP = 2560;
constexpr int C_QKV = 448, C_Z = 1984, C_GATE = 2496;
constexpr int PH = 8, NKEYS = 128, TOPK = 16, NEXP = 16384;
constexpr float EPS = 1e-6f;
constexpr int NT = 512;

typedef unsigned short bf16_t;
typedef float f32x4 __attribute__((ext_vector_type(4)));
typedef unsigned u32x4 __attribute__((ext_vector_type(4)));
typedef unsigned u32x2 __attribute__((ext_vector_type(2)));

__device__ __forceinline__ int opaque_tid() { int t; asm volatile("v_mov_b32 %0, %1" : "=v"(t) : "v"((int)threadIdx.x)); return t; }
__device__ __forceinline__ float bf2f(bf16_t v) { return __uint_as_float((unsigned)v << 16); }
__device__ __forceinline__ bf16_t f2bf(float f) { unsigned u = __float_as_uint(f); u += 0x7fffu + ((u >> 16) & 1u); return (bf16_t)(u >> 16); }
__device__ __forceinline__ float bflo(unsigned w) { return __uint_as_float(w << 16); }
__device__ __forceinline__ float bfhi(unsigned w) { return __uint_as_float(w & 0xffff0000u); }
__device__ __forceinline__ unsigned pk2(float lo, float hi) { return (unsigned)f2bf(lo) | ((unsigned)f2bf(hi) << 16); }
__device__ __forceinline__ float wave_sum(float v) {
#pragma unroll
    for (int o = 1; o < 64; o <<= 1) v += __shfl_xor(v, o);
    return v;
}
__device__ __forceinline__ float sigmoidf_(float x) { return 1.f / (1.f + __expf(-x)); }
__device__ __forceinline__ float siluf_(float x) { return x * sigmoidf_(x); }
__device__ __forceinline__ float softplusf_(float x) { return x > 20.f ? x : log1pf(expf(x)); }
__device__ __forceinline__ float gelu_erf(float x) { return 0.5f * x * (1.f + erff(x * 0.70710678118654752f)); }

namespace pg8 {
#define PG8_LAS __attribute__((address_space(3)))
typedef unsigned short bf16_t;
typedef short bf16x8 __attribute__((ext_vector_type(8)));
typedef float f32x4 __attribute__((ext_vector_type(4)));
typedef unsigned u32x4 __attribute__((ext_vector_type(4)));
constexpr int BM = 256, BK = 64, HALF = 128, HTB = HALF * BK * 2  , STAGE_BYTES = 8 * HTB, NXCD = 8, WGM = 8;

__host__ __device__ __forceinline__ int lds_byte(int r, int c) { const int st = (r >> 4) * 2 + (c >> 5), rr = r & 15, cc = c & 31, ob = rr * 64 + cc * 2; return st * 1024 + (ob ^ (((ob >> 9) & 1) << 5)); }
__host__ __device__ __forceinline__ void stage_rc(int b, int& R, int& C) { const int st = b / 1024, sb = b % 1024, swz = sb ^ (((sb >> 9) & 1) << 5); R = (st >> 1) * 16 + swz / 64; C = (st & 1) * 32 + (swz % 64) / 2; }
__host__ __device__ __forceinline__ int perm32(int rho) { const int n = rho >> 4, i = rho & 15; return 8 * (i >> 2) + 4 * n + (i & 3); }

struct Unit { int pm, pn; };
struct Gemm { const bf16_t* A; const bf16_t* Bt; int M, N, K, lda, ldb; };

struct StaticOrder {
    int nM, nN, nwg, G, c;
    __host__ __device__ void init(int M, int N, int G_, int c_) { nM = M / BM; nN = N / BM; nwg = nM * nN; G = G_; c = c_; }
    __host__ __device__ bool next(int i, Unit& u) const {
        const long L = (long)i * G + c; if (L >= nwg) return false;
        int wgid = (int)L; { const int q = nwg / NXCD, r = nwg % NXCD, xcd = wgid % NXCD, off = wgid / NXCD; wgid = (xcd < r ? xcd * (q + 1) : r * (q + 1) + (xcd - r) * q) + off; }
        const int nig = WGM * nN, gid = wgid / nig, fm = gid * WGM, gsz = (nM - fm) < WGM ? (nM - fm) : WGM;
        u.pm = fm + ((wgid % nig) % gsz); u.pn = (wgid % nig) / gsz; return true;
    }
    __device__ __forceinline__ void a_ready(const Unit&) const {}
    __device__ __forceinline__ void done(const Unit&) const {}
};
__device__ __forceinline__ unsigned cvt_pk_bf16(float lo, float hi) { unsigned r; asm volatile("v_cvt_pk_bf16_f32 %0, %1, %2" : "=v"(r) : "v"(lo), "v"(hi)); return r; }
typedef float f32x2 __attribute__((ext_vector_type(2)));
template <class Epi, class Sched, bool ALIGN_EPI = false, bool SP2 = false>
__device__ __forceinline__ void gemm_phase(PG8_LAS unsigned char* lds, const Gemm g, const Sched& S, const Epi& E) {
    const int tid = opaque_tid(), wid = __builtin_amdgcn_readfirstlane(tid >> 6), lane = tid & 63, wr = wid >> 2, wc = wid & 3, fr = lane & 15, fq = lane >> 4;
    const int K = g.K, nt = K / BK;
    unsigned voffA[2], voffB[2];
#pragma unroll
    for (int i = 0; i < 2; ++i) { int R, C; stage_rc(tid * 16 + i * 8192, R, C); const int Rb = Epi::PERM ? ((R & ~31) + perm32(R & 31)) : R;
        voffA[i] = (unsigned)(R * g.lda + C) * 2u; voffB[i] = (unsigned)(Rb * g.ldb + C) * 2u; }
    const size_t kstep = (size_t)(BK * 2);
    const size_t hstepA = (size_t)HALF * g.lda * 2, hstepB = (size_t)HALF * g.ldb * 2;
    const size_t tstepA = 2 * hstepA, tstepB = 2 * hstepB;
    const unsigned ldsw = (unsigned)wid * 1024u;
    const int aoff = lds_byte(wr * 64 + fr, fq * 8), boff = lds_byte(wc * 32 + fr, fq * 8);
#define PG8_SA(b, h) (((b) * 2 + (h)) * HTB)
#define PG8_SB(b, h) ((4 + (b) * 2 + (h)) * HTB)
#define PG8_STAGE(bufoff, gbase, voff) do { _Pragma("unroll") for (int _i = 0; _i < 2; ++_i) \
        __builtin_amdgcn_global_load_lds((const unsigned*)((const char*)(gbase) + (voff)[_i]), (PG8_LAS unsigned*)(lds + (bufoff) + ldsw + _i * 8192), 16, 0, 0); } while (0)
#define PG8_LDA(dst, b, h) do { _Pragma("unroll") for (int m = 0; m < 4; ++m) _Pragma("unroll") for (int k = 0; k < 2; ++k) dst[m][k] = *(const PG8_LAS bf16x8*)(lds + PG8_SA(b, h) + aoff + m * 2048 + k * 1024); } while (0)
#define PG8_LDB(dst, b, h) do { _Pragma("unroll") for (int n = 0; n < 2; ++n) _Pragma("unroll") for (int k = 0; k < 2; ++k) dst[n][k] = *(const PG8_LAS bf16x8*)(lds + PG8_SB(b, h) + boff + n * 2048 + k * 1024); } while (0)
#define PG8_MMA(ai, bj, At, Bt) do { __builtin_amdgcn_s_setprio(1); _Pragma("unroll") for (int m = 0; m < 4; ++m) _Pragma("unroll") for (int n = 0; n < 2; ++n) _Pragma("unroll") for (int k = 0; k < 2; ++k) \
        acc[ai][bj][m][n] = __builtin_amdgcn_mfma_f32_16x16x32_bf16(Bt[n][k], At[m][k], acc[ai][bj][m][n], 0, 0, 0); __builtin_amdgcn_s_setprio(0); } while (0)
#define PG8_WAIT_V(n) asm volatile("s_waitcnt vmcnt(" #n ")" ::: "memory")
#define PG8_WAIT_L(n) asm volatile("s_waitcnt lgkmcnt(" #n ")" ::: "memory")
#define PG8_BAR __builtin_amdgcn_s_barrier()
#define PG8_SCHED __builtin_amdgcn_sched_barrier(0)
    Unit cur, nxt; int ui = 0;
    if (!S.next(0, cur)) return;
    f32x4 acc[2][2][4][2];
#pragma unroll
    for (int a = 0; a < 2; ++a)
#pragma unroll
        for (int b = 0; b < 2; ++b)
#pragma unroll
            for (int m = 0; m < 4; ++m)
#pragma unroll
                for (int n = 0; n < 2; ++n) acc[a][b][m][n] = (f32x4){0.f, 0.f, 0.f, 0.f};
    bf16x8 At[4][2], B0[2][2], B1[2][2];
    const char* cA = (const char*)g.A + (size_t)cur.pm * tstepA; const char* cB = (const char*)g.Bt + (size_t)cur.pn * tstepB;
    S.a_ready(cur);
    if constexpr (SP2) {
        PG8_STAGE(PG8_SB(0, 0), cB, voffB); PG8_STAGE(PG8_SB(0, 1), cB + hstepB, voffB); PG8_STAGE(PG8_SA(0, 0), cA, voffA); PG8_STAGE(PG8_SA(0, 1), cA + hstepA, voffA);
        if (wr == 1) PG8_BAR;
        PG8_WAIT_V(2); PG8_BAR;
        PG8_STAGE(PG8_SB(1, 0), cB + kstep, voffB); PG8_STAGE(PG8_SA(1, 0), cA + kstep, voffA); PG8_STAGE(PG8_SB(1, 1), cB + hstepB + kstep, voffB);
        PG8_WAIT_V(6); PG8_BAR;
    } else {
        PG8_STAGE(PG8_SB(0, 0), cB, voffB); PG8_STAGE(PG8_SA(0, 0), cA, voffA); PG8_STAGE(PG8_SB(0, 1), cB + hstepB, voffB); PG8_STAGE(PG8_SA(0, 1), cA + hstepA, voffA);
        if (wr == 1) PG8_BAR;
        PG8_WAIT_V(4); PG8_BAR;
        PG8_STAGE(PG8_SB(1, 0), cB + kstep, voffB); PG8_STAGE(PG8_SA(1, 0), cA + kstep, voffA); PG8_STAGE(PG8_SB(1, 1), cB + hstepB + kstep, voffB);
        PG8_WAIT_V(6); PG8_BAR;
    }
    for (;;) {
        const bool has_next = S.next(ui + 1, nxt);
        const char* nA = has_next ? (const char*)g.A + (size_t)nxt.pm * tstepA : cA; const char* nB = has_next ? (const char*)g.Bt + (size_t)nxt.pn * tstepB : cB;
        for (int t = 0; t < nt; t += 2) {
            const bool last = (t == nt - 2);
            const char* a1 = cA + (size_t)(t + 1) * kstep;
            const char* a2 = last ? nA : cA + (size_t)(t + 2) * kstep; const char* b2 = last ? nB : cB + (size_t)(t + 2) * kstep;
            const char* a3 = a2 + kstep; const char* b3 = b2 + kstep;
            if (last && has_next) S.a_ready(nxt);
            if constexpr (SP2) {
            PG8_LDB(B0, 0, 0); PG8_LDB(B1, 0, 1); PG8_SCHED; PG8_LDA(At, 0, 0); PG8_STAGE(PG8_SA(1, 1), a1 + hstepA, voffA);
            PG8_WAIT_V(8); PG8_WAIT_L(0); PG8_BAR; PG8_MMA(0, 0, At, B0); PG8_MMA(0, 1, At, B1); PG8_BAR; PG8_SCHED;
            PG8_LDA(At, 0, 1); PG8_STAGE(PG8_SB(0, 0), b2, voffB); PG8_STAGE(PG8_SB(0, 1), b2 + hstepB, voffB); PG8_STAGE(PG8_SA(0, 0), a2, voffA);
            PG8_WAIT_V(8); PG8_WAIT_L(0); PG8_BAR; PG8_MMA(1, 0, At, B0); PG8_MMA(1, 1, At, B1); PG8_BAR; PG8_SCHED;
            PG8_LDB(B0, 1, 0); PG8_LDB(B1, 1, 1); PG8_SCHED; PG8_LDA(At, 1, 0); PG8_STAGE(PG8_SA(0, 1), a2 + hstepA, voffA);
            PG8_WAIT_V(8); PG8_WAIT_L(0); PG8_BAR; PG8_MMA(0, 0, At, B0); PG8_MMA(0, 1, At, B1); PG8_BAR; PG8_SCHED;
            PG8_LDA(At, 1, 1); PG8_STAGE(PG8_SB(1, 0), b3, voffB); PG8_STAGE(PG8_SB(1, 1), b3 + hstepB, voffB); PG8_STAGE(PG8_SA(1, 0), a3, voffA);
            PG8_WAIT_V(8); PG8_WAIT_L(0); PG8_BAR; PG8_MMA(1, 0, At, B0); PG8_MMA(1, 1, At, B1); PG8_BAR; PG8_SCHED;
            } else {
            PG8_LDB(B0, 0, 0); PG8_SCHED; PG8_LDA(At, 0, 0); PG8_STAGE(PG8_SA(1, 1), a1 + hstepA, voffA);
            PG8_WAIT_L(8); PG8_BAR; PG8_WAIT_L(0); PG8_MMA(0, 0, At, B0); PG8_BAR; PG8_SCHED;
            PG8_LDB(B1, 0, 1); PG8_STAGE(PG8_SB(0, 0), b2, voffB);
            PG8_BAR; PG8_WAIT_L(0); PG8_MMA(0, 1, At, B1); PG8_BAR;
            PG8_LDA(At, 0, 1); PG8_STAGE(PG8_SA(0, 0), a2, voffA);
            PG8_BAR; PG8_WAIT_L(0); PG8_MMA(1, 0, At, B0); PG8_BAR; PG8_SCHED;
            PG8_STAGE(PG8_SB(0, 1), b2 + hstepB, voffB);
            PG8_WAIT_V(6); PG8_BAR; PG8_MMA(1, 1, At, B1); PG8_BAR;
            PG8_LDB(B0, 1, 0); PG8_SCHED; PG8_LDA(At, 1, 0); PG8_STAGE(PG8_SA(0, 1), a2 + hstepA, voffA);
            PG8_WAIT_L(8); PG8_BAR; PG8_WAIT_L(0); PG8_MMA(0, 0, At, B0); PG8_BAR; PG8_SCHED;
            PG8_LDB(B1, 1, 1); PG8_STAGE(PG8_SB(1, 0), b3, voffB);
            PG8_BAR; PG8_WAIT_L(0); PG8_MMA(0, 1, At, B1); PG8_BAR;
            PG8_LDA(At, 1, 1); PG8_STAGE(PG8_SA(1, 0), a3, voffA);
            PG8_BAR; PG8_WAIT_L(0); PG8_MMA(1, 0, At, B0); PG8_BAR; PG8_SCHED;
            PG8_STAGE(PG8_SB(1, 1), b3 + hstepB, voffB);
            PG8_WAIT_V(6); PG8_BAR; PG8_MMA(1, 1, At, B1); PG8_BAR;
            }
        }
        if constexpr (ALIGN_EPI) { if (wr == 0) PG8_BAR; }
        if constexpr (!Epi::AFTER_DRAIN) { E(acc, cur, wr, wc, fr, fq); S.done(cur); }
        if (!has_next) break;
#pragma unroll
        for (int a = 0; a < 2; ++a)
#pragma unroll
            for (int b = 0; b < 2; ++b)
#pragma unroll
                for (int m = 0; m < 4; ++m)
#pragma unroll
                    for (int n = 0; n < 2; ++n) acc[a][b][m][n] = (f32x4){0.f, 0.f, 0.f, 0.f};
        cur = nxt; cA = nA; cB = nB; ++ui;
        if constexpr (ALIGN_EPI) { if (wr == 1) PG8_BAR; }
    }
    PG8_WAIT_V(0);
    if constexpr (!ALIGN_EPI) { if (wr == 0) PG8_BAR; }
    PG8_BAR;
    if constexpr (Epi::AFTER_DRAIN) { E.fused(acc, cur, wr, wc, fr, fq, lds, wid, lane); S.done(cur); }
#undef PG8_SA
#undef PG8_SB
#undef PG8_STAGE
#undef PG8_LDA
#undef PG8_LDB
#undef PG8_MMA
#undef PG8_WAIT_V
#undef PG8_WAIT_L
#undef PG8_BAR
#undef PG8_SCHED
}

struct EpiScaleBf16 {
    static constexpr bool PERM = true, AFTER_DRAIN = false;
    bf16_t* O; int ldc; const float* rs;
    __device__ __forceinline__ void operator()(const f32x4 (&acc)[2][2][4][2], const Unit& u, int wr, int wc, int fr, int fq) const {
        const int row0 = u.pm * BM + wr * 64 + fr, col0 = u.pn * BM + wc * 32 + 8 * fq;
#pragma unroll
        for (int ai = 0; ai < 2; ++ai)
#pragma unroll
            for (int m = 0; m < 4; ++m) { const int r = row0 + ai * HALF + m * 16; const float sc = rs ? rs[r] : 1.f; bf16_t* rowp = O + (size_t)r * ldc + col0;
#pragma unroll
                for (int bj = 0; bj < 2; ++bj) { const f32x4 v0 = acc[ai][bj][m][0] * sc, v1 = acc[ai][bj][m][1] * sc;
                    u32x4 w; w.x = cvt_pk_bf16(v0[0], v0[1]); w.y = cvt_pk_bf16(v0[2], v0[3]); w.z = cvt_pk_bf16(v1[0], v1[1]); w.w = cvt_pk_bf16(v1[2], v1[3]);
                    *(u32x4*)(rowp + bj * HALF) = w; } }
    }
};
struct EpiResF32 {
    static constexpr bool PERM = false, AFTER_DRAIN = false;
    const float* base; float* out; int ldc;
    __device__ __forceinline__ void operator()(const f32x4 (&acc)[2][2][4][2], const Unit& u, int wr, int wc, int fr, int fq) const {
        const int row0 = u.pm * BM + wr * 64 + fr, col0 = u.pn * BM + wc * 32 + 4 * fq;
#pragma unroll
        for (int ai = 0; ai < 2; ++ai)
#pragma unroll
            for (int m = 0; m < 4; ++m) { const size_t off = (size_t)(row0 + ai * HALF + m * 16) * ldc + col0;
#pragma unroll
                for (int bj = 0; bj < 2; ++bj)
#pragma unroll
                    for (int n = 0; n < 2; ++n) { const f32x4 b = *(const f32x4*)(base + off + bj * HALF + n * 16); *(f32x4*)(out + off + bj * HALF + n * 16) = b + acc[ai][bj][m][n]; } }
    }
};
struct EpiResF32Hb {
    static constexpr bool PERM = false, AFTER_DRAIN = false;
    const float* base; float* out; bf16_t* hb; float* sumsq; int ldc;
    __device__ __forceinline__ void operator()(const f32x4 (&acc)[2][2][4][2], const Unit& u, int wr, int wc, int fr, int fq) const {
        const int row0 = u.pm * BM + wr * 64 + fr, col0 = u.pn * BM + wc * 32 + 4 * fq;
#pragma unroll
        for (int ai = 0; ai < 2; ++ai)
#pragma unroll
            for (int m = 0; m < 4; ++m) { const int r = row0 + ai * HALF + m * 16; const size_t off = (size_t)r * ldc + col0; float ss = 0.f;
#pragma unroll
                for (int bj = 0; bj < 2; ++bj)
#pragma unroll
                    for (int n = 0; n < 2; ++n) { const f32x4 o = *(const f32x4*)(base + off + bj * HALF + n * 16) + acc[ai][bj][m][n];
                        *(f32x4*)(out + off + bj * HALF + n * 16) = o; ss += o[0] * o[0] + o[1] * o[1] + o[2] * o[2] + o[3] * o[3];
                        typedef unsigned u32x2v __attribute__((ext_vector_type(2))); u32x2v w; w.x = cvt_pk_bf16(o[0], o[1]); w.y = cvt_pk_bf16(o[2], o[3]);
                        *(u32x2v*)(hb + off + bj * HALF + n * 16) = w; }
                ss += __shfl_xor(ss, 16); ss += __shfl_xor(ss, 32);
                if (fq == 0) unsafeAtomicAdd(sumsq + r, ss); }
    }
};
}

#define XB_TMO      128
#define XB_XCNT(j)  (256  + 64 * (j))
#define XB_XSUB(j)  (1280 + 64 * (j))
#define XB_XGEN(j)  (2304 + 64 * (j))
#define XB_TOP      3328
#define XB_TOPGEN   3392
#define XCD_BAR_WORDS 3456
#define XB_SPIN_CAP (1u << 18)
#define LAS __attribute__((address_space(3)))

__device__ __forceinline__ unsigned xb_ld(unsigned* p)              { return __hip_atomic_load(p, __ATOMIC_RELAXED, __HIP_MEMORY_SCOPE_AGENT); }
__device__ __forceinline__ unsigned xb_add(unsigned* p, unsigned v) { return __hip_atomic_fetch_add(p, v, __ATOMIC_RELAXED, __HIP_MEMORY_SCOPE_AGENT); }
__device__ __forceinline__ unsigned xb_xcc_id() { return (unsigned)__builtin_amdgcn_s_getreg((3 << 11) | 20) & 0xFu; }
#define XB_SPIN(cond, bar) do { unsigned _sp = 0; while (cond) { __builtin_amdgcn_s_sleep(1); \
    if ((++_sp & 255u) == 0u) { if (xb_ld(&(bar)[XB_TMO])) break; if (_sp > XB_SPIN_CAP) { atomicAdd(&(bar)[XB_TMO], 1u); break; } } } } while (0)

struct XcdBarrier {
    unsigned* bar; unsigned x;
    volatile LAS unsigned* st;
};

__device__ __forceinline__ XcdBarrier xcd_barrier_post(unsigned* bar, volatile LAS unsigned* st) {
    XcdBarrier b; b.bar = bar; b.x = xb_xcc_id(); b.st = st;
    if (threadIdx.x == 0) (void)xb_add(&bar[XB_XCNT(b.x)], 1u);
    return b;
}
__device__ __forceinline__ void xcd_barrier_complete(unsigned* bar, unsigned x, unsigned& nloc, unsigned& nx) {
    const unsigned G = gridDim.x * gridDim.y * gridDim.z;
    unsigned sum, cnt, mine, sp = 0u;
    for (;;) {
        sum = 0u; cnt = 0u; mine = 0u;
#pragma unroll
        for (unsigned j = 0; j < 16; ++j) { const unsigned c = xb_ld(&bar[XB_XCNT(j)]); sum += c; cnt += (c > 0u) ? 1u : 0u; mine = (j == x) ? c : mine; }
        if (sum == G) break;
        __builtin_amdgcn_s_sleep(1);
        if ((++sp & 255u) == 0u) { if (xb_ld(&bar[XB_TMO])) break; if (sp > XB_SPIN_CAP) { atomicAdd(&bar[XB_TMO], 1u); break; } }
    }
    nloc = mine > 0u ? mine : 1u; nx = cnt > 0u ? cnt : 1u;
}

__device__ __forceinline__ void xcd_barrier(const XcdBarrier& b) {
    asm volatile("s_waitcnt vmcnt(0)" ::: "memory");
    __syncthreads();
    if (threadIdx.x == 0) {
        unsigned* bar = b.bar;
        __builtin_amdgcn_s_waitcnt(0);
        unsigned nloc = b.st[0], nx = b.st[1];
        if (nloc == 0u) { xcd_barrier_complete(bar, b.x, nloc, nx); b.st[0] = nloc; b.st[1] = nx; }
        const unsigned old = xb_add(&bar[XB_XSUB(b.x)], 1u);
        const unsigned gen = old / nloc;
        if (old + 1u == (gen + 1u) * nloc) {
            __builtin_amdgcn_fence(__ATOMIC_RELEASE, "agent");
            asm volatile("s_waitcnt vmcnt(0)" ::: "memory");
            const unsigned og = xb_add(&bar[XB_TOP], 1u);
            const unsigned tg = og / nx;
            if (og + 1u == (tg + 1u) * nx) xb_add(&bar[XB_TOPGEN], 1u);
            else XB_SPIN(xb_ld(&bar[XB_TOPGEN]) == tg, bar);
            __builtin_amdgcn_fence(__ATOMIC_ACQUIRE, "agent");
            xb_add(&bar[XB_XGEN(b.x)], 1u);
            asm volatile("s_waitcnt vmcnt(0)" ::: "memory");
        } else {
            XB_SPIN(xb_ld(&bar[XB_XGEN(b.x)]) == gen, bar);
            __builtin_amdgcn_fence(__ATOMIC_ACQUIRE, "agent");
            asm volatile("s_waitcnt vmcnt(0)" ::: "memory");
        }
    }
    __syncthreads();
}

constexpr size_t MB = 1u << 20;
constexpr size_t OFF_WIN = 0;
constexpr size_t OFF_WQUP = 5 * MB;
constexpr size_t OFF_WKVUP = 5 * MB + 512 * 1024;
constexpr size_t OFF_WOUT = 6 * MB;
constexpr size_t OFF_WPQ = 8 * MB;
constexpr size_t OFF_SUBK = 12 * MB;
constexpr size_t OFF_VEC = 12 * MB + 512 * 1024;
constexpr size_t OFF_SU = OFF_VEC + 4 * (size_t)T * 4, OFF_SV = OFF_SU + (size_t)NEXP * 4, OFF_SH = OFF_SV + (size_t)NEXP * 4;
constexpr size_t OFF_GATE = 13 * MB;
constexpr size_t OFF_BAR = 15 * MB;
constexpr size_t OFF_R1 = 16 * MB;
constexpr size_t OFF_R2 = 96 * MB;
constexpr size_t OFF_R3 = 160 * MB;
constexpr size_t OFF_R4 = 192 * MB;
constexpr size_t OFF_R5 = 208 * MB;
constexpr size_t WS_END = 256 * MB;

struct Params {
    const float* x; const int* pos; const float *ln1_w, *w_in, *q_a_norm_w, *w_q_up, *kv_a_norm_w, *w_kv_up, *conv_w, *a_log_f, *dt_bias_f, *a_log_b,
        *dt_bias_b, *gdn_norm_w, *w_out, *ln2_w, *peer_wq, *sub_keys, *peer_u, *peer_v, *final_w;
    float* out; unsigned char* ws;
};

struct Ctx {
    int tid, lane, wave, bid, nb, gw, ngw;
    float* lds;
};

#define LDS3 ((PG8_LAS unsigned char*)c.lds)
__device__ __forceinline__ void gemm_scale_bf16(const Ctx& c, const bf16_t* A, int lda, const bf16_t* Bt, int ldb, int N, int K, bf16_t* O, int ldc, const float* rs) {
    pg8::Gemm g{A, Bt, T, N, K, lda, ldb}; pg8::StaticOrder S; S.init(T, N, c.nb, c.bid);
    pg8::EpiScaleBf16 E{O, ldc, rs};
    pg8::gemm_phase<pg8::EpiScaleBf16, pg8::StaticOrder, true, true>(LDS3, g, S, E);
}
__device__ __forceinline__ void ph1_mfma(const Ctx& c, const Params& p) {
    gemm_scale_bf16(c, (const bf16_t*)(p.ws + OFF_R2), 1024, (const bf16_t*)(p.ws + OFF_WIN), 1024, IN_WP, 1024, (bf16_t*)(p.ws + OFF_R1), IN_WP, nullptr);
}
__device__ __forceinline__ void ph2a2_v2(const Ctx& c, const Params& p) {
    const bf16_t* proj = (const bf16_t*)(p.ws + OFF_R1);
    gemm_scale_bf16(c, proj, IN_WP, (const bf16_t*)(p.ws + OFF_WQUP), 256, 768, 256, (bf16_t*)(p.ws + OFF_R5), 768, nullptr);
    gemm_scale_bf16(c, proj + 256, IN_WP, (const bf16_t*)(p.ws + OFF_WKVUP), 256, 1024, 256, (bf16_t*)(p.ws + OFF_R3), 1024, nullptr);
}
__device__ __forceinline__ void ph4b_v2(const Ctx& c, const Params& p) {
    pg8::Gemm g{(const bf16_t*)(p.ws + OFF_R1), (const bf16_t*)(p.ws + OFF_WOUT), T, 1024, 1024, 1024, 1024}; pg8::StaticOrder S; S.init(T, 1024, c.nb, c.bid);
    pg8::EpiResF32Hb E{p.x, p.out, (bf16_t*)(p.ws + OFF_R3), (float*)(p.ws + OFF_SH), 1024};
    pg8::gemm_phase<pg8::EpiResF32Hb, pg8::StaticOrder, true, true>(LDS3, g, S, E);
}
__device__ __forceinline__ void ph5_v2(const Ctx& c, const Params& p) {
    gemm_scale_bf16(c, (const bf16_t*)(p.ws + OFF_R3), 1024, (const bf16_t*)(p.ws + OFF_WPQ), 1024, 2048, 1024, (bf16_t*)(p.ws + OFF_R2), 2048, nullptr);
}

namespace attn {
constexpr int SDEPTH = 1;
constexpr int NW = 8, QBLK = 32, KVBLK = 64, LDQ = 192, LDK = 192, LDV = 128, LDO = 512;
constexpr float SCALE = 0.07216878364870322f;
constexpr float THR = 8.f;
constexpr size_t SHM_V = KVBLK * 128 * 2, SHM_K = KVBLK * 192 * 2, SHM_ATTN = 2 * SHM_V + 2 * SHM_K + NW * 64 * 4 + NW * 6144;
constexpr int QREG = 6;
using bf16 = unsigned short;
using bf16x8 = __attribute__((ext_vector_type(8))) short;
using s16x4  = __attribute__((ext_vector_type(4))) short;
using f32x16 = __attribute__((ext_vector_type(16))) float;
using f32x8  = __attribute__((ext_vector_type(8))) float;
using u32x4a = __attribute__((ext_vector_type(4))) unsigned;
#define KSWZ(row, colB) ((row) * 384 + ((colB) ^ ((((row) >> 1) & 7) << 4)))
#define SBAR() __builtin_amdgcn_sched_barrier(0)
__device__ __forceinline__ int crow(int r, int hi) { return (r & 3) + 8 * (r >> 2) + 4 * hi; }
__device__ __forceinline__ unsigned cvtpk(float lo, float hi) {
  unsigned r; asm volatile("v_cvt_pk_bf16_f32 %0, %1, %2" : "=v"(r) : "v"(lo), "v"(hi)); return r;
}
__device__ __forceinline__ void partialSM(f32x16& p0, f32x16& p1, float& m_reg, float& mn, float& alpha) {
  constexpr float C = SCALE * 1.4426950408889634f;
  float pmax = p0[0]; for (int r = 1; r < 16; ++r) pmax = fmaxf(pmax, p0[r]); for (int r = 0; r < 16; ++r) pmax = fmaxf(pmax, p1[r]);
  { auto rr = __builtin_amdgcn_permlane32_swap(__float_as_uint(pmax), __float_as_uint(pmax), false, false);
    pmax = fmaxf(__uint_as_float(rr[0]), __uint_as_float(rr[1])); }
  if (__builtin_expect(__all(pmax - m_reg <= THR / SCALE), 1)) { mn = m_reg; alpha = 1.f; }
  else { mn = fmaxf(m_reg, pmax); alpha = __builtin_amdgcn_exp2f((m_reg - mn) * C); m_reg = mn; }
  float mnC = -mn * C;
  for (int r = 0; r < 16; ++r) p0[r] = fmaf(p0[r], C, mnC); for (int r = 0; r < 16; ++r) p1[r] = fmaf(p1[r], C, mnC);
  for (int r = 0; r < 16; ++r) p0[r] = __builtin_amdgcn_exp2f(p0[r]);
}
__device__ __forceinline__ void finishSM(f32x16& p0, f32x16& p1, float alpha, float& l_reg, bf16x8& pa0, bf16x8& pa1, bf16x8& pa2, bf16x8& pa3) {
  for (int r = 0; r < 16; ++r) p1[r] = __builtin_amdgcn_exp2f(p1[r]);
  float ps = 0; for (int r = 0; r < 16; ++r) ps += p0[r]; for (int r = 0; r < 16; ++r) ps += p1[r];
  { auto rr = __builtin_amdgcn_permlane32_swap(__float_as_uint(ps), __float_as_uint(ps), false, false);
    ps = __uint_as_float(rr[0]) + __uint_as_float(rr[1]); }
  l_reg = l_reg * alpha + ps;
#define PK4(P, BASE, OUT) do { unsigned a0 = cvtpk(P[BASE + 0], P[BASE + 1]), a1 = cvtpk(P[BASE + 2], P[BASE + 3]);   \
    unsigned b0 = cvtpk(P[BASE + 4], P[BASE + 5]), b1 = cvtpk(P[BASE + 6], P[BASE + 7]);                              \
    auto r0 = __builtin_amdgcn_permlane32_swap(a0, b0, false, false); auto r1 = __builtin_amdgcn_permlane32_swap(a1, b1, false, false); \
    u32x4a w = {r0[0], r1[0], r0[1], r1[1]}; OUT = *reinterpret_cast<bf16x8*>(&w); } while (0)
  PK4(p0, 0, pa0); PK4(p0, 8, pa1); PK4(p1, 0, pa2); PK4(p1, 8, pa3);
#undef PK4
}
__device__ __forceinline__ void qkt(f32x16& p0, f32x16& p1, const bf16* Ks, const bf16x8* qr, const bf16x8* qro, int r32, int hi) {
  p0 = f32x16{}; p1 = f32x16{};
  for (int d0 = 0; d0 < 12; ++d0) { int cb = (d0 * 16 + hi * 8) * 2;
    bf16x8 b0 = *reinterpret_cast<const bf16x8*>((const char*)Ks + KSWZ(r32, cb));
    bf16x8 b1 = *reinterpret_cast<const bf16x8*>((const char*)Ks + KSWZ(32 + r32, cb));
    const bf16x8 qf = d0 < QREG ? qr[d0 < QREG ? d0 : 0] : qro[(d0 - QREG) * 64];
    p0 = __builtin_amdgcn_mfma_f32_32x32x16_bf16(b0, qf, p0, 0, 0, 0);
    p1 = __builtin_amdgcn_mfma_f32_32x32x16_bf16(b1, qf, p1, 0, 0, 0); }
}
__device__ __forceinline__ int v_st(int k, int c) { const int kk = (k & ~0xC) | ((k & 4) << 1) | ((k & 8) >> 1); return ((kk >> 3) * 4 + (c >> 5)) * 512 + ((kk & 7) * 32 + (c & 31)) * 2; }
__device__ __forceinline__ int v_rd_base(int lane) { return ((lane & 3) << 3) | (((lane >> 2) & 3) << 6) | (((lane >> 4) & 1) << 5) | (((lane >> 5) & 1) << 8); }
constexpr int v_rd_off(int d0, int ks, int half) { return d0 * 512 + ks * 4096 + half * 2048; }
template <int OFF> __device__ __forceinline__ s16x4 tr_read(int vb) {
  s16x4 r; asm volatile("ds_read_b64_tr_b16 %0, %1 offset:%2" : "=&v"(r) : "v"(vb), "i"(OFF) : "memory"); return r;
}
template <int D0> __device__ __forceinline__ void pv_one(f32x16& od, int vb, bf16x8 pa0, bf16x8 pa1, bf16x8 pa2, bf16x8 pa3) {
  const s16x4 l0 = tr_read<v_rd_off(D0, 0, 0)>(vb), h0 = tr_read<v_rd_off(D0, 0, 1)>(vb), l1 = tr_read<v_rd_off(D0, 1, 0)>(vb), h1 = tr_read<v_rd_off(D0, 1, 1)>(vb);
  const s16x4 l2 = tr_read<v_rd_off(D0, 2, 0)>(vb), h2 = tr_read<v_rd_off(D0, 2, 1)>(vb), l3 = tr_read<v_rd_off(D0, 3, 0)>(vb), h3 = tr_read<v_rd_off(D0, 3, 1)>(vb);
  asm volatile("s_waitcnt lgkmcnt(0)" ::: "memory"); SBAR();
#define PK(L, H) (bf16x8){L[0], L[1], L[2], L[3], H[0], H[1], H[2], H[3]}
  od = __builtin_amdgcn_mfma_f32_32x32x16_bf16(pa0, PK(l0, h0), od, 0, 0, 0);
  od = __builtin_amdgcn_mfma_f32_32x32x16_bf16(pa1, PK(l1, h1), od, 0, 0, 0);
  od = __builtin_amdgcn_mfma_f32_32x32x16_bf16(pa2, PK(l2, h2), od, 0, 0, 0);
  od = __builtin_amdgcn_mfma_f32_32x32x16_bf16(pa3, PK(l3, h3), od, 0, 0, 0);
#undef PK
}
__device__ __forceinline__ void pv_d0(f32x16* o, int vb, bf16x8 pa0, bf16x8 pa1, bf16x8 pa2, bf16x8 pa3) {
  pv_one<0>(o[0], vb, pa0, pa1, pa2, pa3); pv_one<1>(o[1], vb, pa0, pa1, pa2, pa3); pv_one<2>(o[2], vb, pa0, pa1, pa2, pa3); pv_one<3>(o[3], vb, pa0, pa1, pa2, pa3);
}


template <bool PARTIAL>
__device__ __forceinline__ void attn_dense_body(const bf16* __restrict__ Qb, const bf16* __restrict__ Kh, const bf16* __restrict__ Vh,
                                                bf16* __restrict__ Ob, int seq, char* lds, float* __restrict__ ML = nullptr) {
  const int tid = opaque_tid(), wid = __builtin_amdgcn_readfirstlane(tid >> 6), lane = tid & 63, r32 = lane & 31, hi = lane >> 5;
  bf16* V_lds = (bf16*)lds; bf16* K_lds = (bf16*)(lds + 2 * SHM_V);
  float* ws = (float*)(lds + 2 * SHM_V + 2 * SHM_K) + wid * 64; float* li_l = ws; float* al_l = ws + 32;
  float m_reg = -1e30f, l_reg = 0; f32x16 o[4] = {}; bf16x8 qr[QREG];
  const bf16* Qw = Qb + (long)(wid * QBLK + r32) * LDQ + hi * 8;
#pragma unroll
  for (int d0 = 0; d0 < QREG; ++d0) qr[d0] = *reinterpret_cast<const bf16x8*>(Qw + d0 * 16);
  bf16x8* qro = (bf16x8*)(lds + 2 * SHM_V + 2 * SHM_K + NW * 64 * 4) + wid * 384 + lane;
#pragma unroll
  for (int d0 = QREG; d0 < 12; ++d0) qro[(d0 - QREG) * 64] = *reinterpret_cast<const bf16x8*>(Qw + d0 * 16);
  const int sr = tid >> 4, sc = (tid & 15) * 8, vst0 = v_st(sr, sc), vst1 = v_st(32 + sr, sc);
  const int vb0 = (int)(uintptr_t)V_lds + v_rd_base(lane);
  const int kr0 = tid / 24, kc0 = (tid % 24) * 16, kr1 = (tid + 512) / 24, kc1 = ((tid + 512) % 24) * 16, kr2 = (tid + 1024) / 24, kc2 = ((tid + 1024) % 24) * 16;
  const int kst0 = KSWZ(kr0, kc0), kst1 = KSWZ(kr1, kc1), kst2 = KSWZ(kr2, kc2);
  struct { bf16x8 vs0, vs1, ks0, ks1, ks2; } sr_[SDEPTH];
#define SLOAD(i, k0) do { sr_[i].vs0 = *(const bf16x8*)(&Vh[(long)((k0) + sr) * LDV + sc]); sr_[i].vs1 = *(const bf16x8*)(&Vh[(long)((k0) + 32 + sr) * LDV + sc]); \
    const bf16* kt_ = Kh + (long)(k0) * LDK + tid * 8; sr_[i].ks0 = *(const bf16x8*)(kt_); sr_[i].ks1 = *(const bf16x8*)(kt_ + 4096); sr_[i].ks2 = *(const bf16x8*)(kt_ + 8192); } while (0)
#define SWRITE(b, i) do { *(bf16x8*)((char*)V_lds + (b) * SHM_V + vst0) = sr_[i].vs0;          \
    *(bf16x8*)((char*)V_lds + (b) * SHM_V + vst1) = sr_[i].vs1;                                 \
    *(bf16x8*)((char*)K_lds + (b) * SHM_K + kst0) = sr_[i].ks0;                                 \
    *(bf16x8*)((char*)K_lds + (b) * SHM_K + kst1) = sr_[i].ks1;                                 \
    *(bf16x8*)((char*)K_lds + (b) * SHM_K + kst2) = sr_[i].ks2; } while (0)
#define SWAIT() do { if constexpr (SDEPTH == 2) asm volatile("s_waitcnt vmcnt(5)" ::: "memory"); else asm volatile("s_waitcnt vmcnt(0)" ::: "memory"); } while (0)
#define RESC(a) do { if (__any((a) < 1.f)) { if (hi == 0) al_l[r32] = (a); asm volatile("s_waitcnt lgkmcnt(0)" ::: "memory"); \
    for (int d = 0; d < 4; ++d) for (int r = 0; r < 16; ++r) o[d][r] *= al_l[crow(r, hi)]; } } while (0)
  f32x16 pA0, pA1, pB0, pB1; float mnA, mnB, alA, alB; bf16x8 pa0, pa1, pa2, pa3; const int NT = seq / KVBLK;
  constexpr int SE = 0, SO = SDEPTH - 1;
  SLOAD(SE, 0); asm volatile("s_waitcnt vmcnt(0)" ::: "memory"); SWRITE(0, SE); __syncthreads();
  qkt(pA0, pA1, K_lds, qr, qro, r32, hi); partialSM(pA0, pA1, m_reg, mnA, alA);
  SLOAD(SO, KVBLK); if constexpr (SDEPTH == 2) { if (2 < NT) SLOAD(SE, 2 * KVBLK); }
  SWAIT(); SWRITE(1, SO); __syncthreads();
  for (int j = 1; j + 1 < NT; j += 2) {
    SBAR(); qkt(pB0, pB1, (bf16*)((char*)K_lds + SHM_K), qr, qro, r32, hi);
    finishSM(pA0, pA1, alA, l_reg, pa0, pa1, pa2, pa3); SBAR();
    SLOAD(SO, (j + SDEPTH) * KVBLK); SBAR();
    pv_d0(o, vb0, pa0, pa1, pa2, pa3); partialSM(pB0, pB1, m_reg, mnB, alB);
    __syncthreads(); SWAIT(); SWRITE(0, SE);
    RESC(alB); __syncthreads();
    SBAR(); qkt(pA0, pA1, K_lds, qr, qro, r32, hi);
    finishSM(pB0, pB1, alB, l_reg, pa0, pa1, pa2, pa3); SBAR();
    if (SDEPTH == 1 || j + 3 < NT) SLOAD(SE, (j + 1 + SDEPTH) * KVBLK); SBAR();
    pv_d0(o, vb0 + (int)SHM_V, pa0, pa1, pa2, pa3); partialSM(pA0, pA1, m_reg, mnA, alA);
    __syncthreads(); SWAIT(); SWRITE(1, SO);
    RESC(alA); __syncthreads();
  }
  SBAR(); qkt(pB0, pB1, (bf16*)((char*)K_lds + SHM_K), qr, qro, r32, hi);
  finishSM(pA0, pA1, alA, l_reg, pa0, pa1, pa2, pa3); SBAR();
  pv_d0(o, vb0, pa0, pa1, pa2, pa3); partialSM(pB0, pB1, m_reg, mnB, alB);
  __syncthreads(); RESC(alB);
  finishSM(pB0, pB1, alB, l_reg, pa0, pa1, pa2, pa3); SBAR();
  pv_d0(o, vb0 + (int)SHM_V, pa0, pa1, pa2, pa3);
  if constexpr (PARTIAL) {
    if (hi == 0) { ML[(wid * QBLK + r32) * 2] = m_reg; ML[(wid * QBLK + r32) * 2 + 1] = l_reg; }
    bf16* Ow = Ob + (long)(wid * QBLK) * 128;
#pragma unroll
    for (int r = 0; r < 16; ++r) { int orow = crow(r, hi);
      for (int d0 = 0; d0 < 4; ++d0) Ow[(long)orow * 128 + d0 * 32 + r32] = (bf16)(cvtpk(o[d0][r], 0.f) & 0xffffu); }
  } else {
  if (hi == 0) li_l[r32] = l_reg; asm volatile("s_waitcnt lgkmcnt(0)" ::: "memory");
  float rli[16];
#pragma unroll
  for (int r = 0; r < 16; ++r) rli[r] = __builtin_amdgcn_rcpf(li_l[crow(r, hi)]);
  bf16* Ow = Ob + (long)(wid * QBLK) * LDO;
#pragma unroll
  for (int r = 0; r < 16; ++r) { int orow = crow(r, hi);
    for (int d0 = 0; d0 < 4; ++d0) Ow[(long)orow * LDO + d0 * 32 + r32] = (bf16)(cvtpk(o[d0][r] * rli[r], 0.f) & 0xffffu); }
  }
  __syncthreads();
#undef SLOAD
#undef SWRITE
#undef SWAIT
#undef RESC
}

}

__device__ __forceinline__ void ph3a_mfma(const Ctx& c, const Params& p) {
    const bf16_t* Q = (const bf16_t*)p.out; const bf16_t* Kk = Q + (size_t)T * MLA_H * QKD; const bf16_t* V = Kk + (size_t)T * MLA_H * QKD;
    bf16_t* omla = (bf16_t*)(p.ws + OFF_R4);
    for (int unit = c.bid; unit < BATCH * MLA_H * (SEQ / 256); unit += c.nb) {
        const int bh = unit & 7, qb = unit >> 3, b = bh >> 2, h = bh & 3;
        const size_t base = (size_t)bh * SEQ;
        attn::attn_dense_body<false>(Q + (base + qb * 256) * QKD, Kk + base * QKD, V + base * VDIM, omla + (size_t)(b * SEQ + qb * 256) * 512 + h * 128, SEQ, (char*)c.lds);
    }
}
constexpr size_t OFF_PART = 240 * MB, OFF_PARTML = 255 * MB;
__device__ __forceinline__ void ph3a_split(const Ctx& c, const Params& p) {
    const bf16_t* Q = (const bf16_t*)p.out; const bf16_t* Kk = Q + (size_t)T * MLA_H * QKD; const bf16_t* V = Kk + (size_t)T * MLA_H * QKD;
    bf16_t* omla = (bf16_t*)(p.ws + OFF_R4);
    const int j = c.bid - 32, bh = j & 7, b = bh >> 2, h = bh & 3; const size_t base = (size_t)bh * SEQ;
    { const int qb = j >> 3;
      attn::attn_dense_body<false>(Q + (base + qb * 256) * QKD, Kk + base * QKD, V + base * VDIM, omla + (size_t)(b * SEQ + qb * 256) * 512 + h * 128, SEQ, (char*)c.lds); }
    { const int r = j >> 3, qb = 28 + r / 7, part = r % 7, k0 = part * 18 * 64, nk = (part == 6 ? 20 : 18) * 64, lu = (qb - 28) * 8 + bh;
      attn::attn_dense_body<true>(Q + (base + qb * 256) * QKD, Kk + (base + k0) * QKD, V + (base + k0) * VDIM, (bf16_t*)(p.ws + OFF_PART) + ((size_t)(lu * 7 + part) * 256) * 128, nk,
                                  (char*)c.lds, (float*)(p.ws + OFF_PARTML) + (size_t)(lu * 7 + part) * 512); }
}


namespace pk {
typedef float f32x16 __attribute__((ext_vector_type(16)));
typedef short bf16x8 __attribute__((ext_vector_type(8)));
__device__ __forceinline__ int f2ord(float f) { const int b = __float_as_int(f); return b ^ ((b >> 31) & 0x7fffffff); }
__device__ __forceinline__ float ord2f(int k) { return __int_as_float(k ^ ((k >> 31) & 0x7fffffff)); }
__device__ __forceinline__ void ce(int& a, int& b) { const int mx = max(a, b), mn = min(a, b); a = mx; b = mn; }
__device__ __forceinline__ void sort16(int (&v)[16]) {
#pragma unroll
    for (int k = 2; k <= 16; k <<= 1)
#pragma unroll
        for (int j = k >> 1; j > 0; j >>= 1)
#pragma unroll
            for (int i = 0; i < 16; ++i) { const int l = i ^ j; if (l > i) { if ((i & k) == 0) ce(v[i], v[l]); else ce(v[l], v[i]); } }
}
__device__ __forceinline__ void merge16(int (&v)[16]) {
#pragma unroll
    for (int j = 8; j > 0; j >>= 1)
#pragma unroll
        for (int i = 0; i < 16; ++i) { const int l = i ^ j; if (l > i) ce(v[i], v[l]); }
}
__device__ __forceinline__ void top_merge(int (&best)[16], int (&g)[16]) {
#pragma unroll
    for (int i = 0; i < 16; ++i) best[i] = max(best[i], g[15 - i]);
    merge16(best);
}
__device__ __forceinline__ int lookup16(unsigned long long lo, unsigned long long hi8, int i) {
    const unsigned long long s = (i & 8) ? hi8 : lo;
    return (int)((s >> ((i & 7) * 8)) & 0xffull);
}
}
__device__ __forceinline__ void ph6_fast(const Ctx& c, const Params& p) {
    using namespace pk;
    const int tid = opaque_tid(), wid = __builtin_amdgcn_readfirstlane(tid >> 6), lane = tid & 63, r32 = lane & 31, hi = lane >> 5;
    const bf16_t* qp = (const bf16_t*)(p.ws + OFF_R2); const bf16_t* subk = (const bf16_t*)(p.ws + OFF_SUBK);
    int* experts = (int*)(p.ws + OFF_R4); float* gates = (float*)(p.ws + OFF_R4 + 8 * MB);
    char* lds = (char*)c.lds;
    constexpr int NU = PH * (T / 256);
    const int per = (NU + c.nb - 1) / c.nb;
    int cur_h = -1;
    for (int ui = 0; ui < per; ++ui) {
        const int u = c.bid * per + ui; if (u >= NU) break;
        const int h = u / (T / 256), t0 = (u % (T / 256)) * 256;
        if (h != cur_h) {
            __syncthreads();
            for (int ch = tid; ch < 4096; ch += NT) { const int row = ch >> 4, cb = (ch & 15) * 16;
                const u32x4 v = *(const u32x4*)(subk + (size_t)h * 32768 + (size_t)row * 128 + (cb >> 1));
                *(u32x4*)(lds + row * 256 + (cb ^ ((row & 7) << 4))) = v; }
            __syncthreads(); cur_h = h;
        }
        const int t = t0 + wid * 32 + r32;
        int A[2][16];
#pragma unroll
        for (int pp = 0; pp < 2; ++pp) {
            bf16x8 bq[8];
#pragma unroll
            for (int ks = 0; ks < 8; ++ks) bq[ks] = *(const bf16x8*)(qp + (size_t)t * 2048 + h * 256 + pp * 128 + ks * 16 + hi * 8);
            f32x16 acc[4];
#pragma unroll
            for (int kt = 0; kt < 4; ++kt) acc[kt] = f32x16{};
#pragma unroll
            for (int ks = 0; ks < 8; ++ks)
#pragma unroll
                for (int kt = 0; kt < 4; ++kt) { const int row = pp * 128 + kt * 32 + r32, cb = (ks * 16 + hi * 8) * 2;
                    const bf16x8 a = *(const bf16x8*)(lds + row * 256 + (cb ^ ((row & 7) << 4)));
                    acc[kt] = __builtin_amdgcn_mfma_f32_32x32x16_bf16(a, bq[ks], acc[kt], 0, 0, 0); }
            int best[16], g[16];
#pragma unroll
            for (int kt = 0; kt < 4; ++kt) {
#pragma unroll
                for (int r = 0; r < 16; ++r) { const int idx = kt * 32 + (r & 3) + 8 * (r >> 2) + 4 * hi; const int k = (f2ord(acc[kt][r]) & ~127) | idx; if (kt == 0) best[r] = k; else g[r] = k; }
                if (kt == 0) sort16(best); else { sort16(g); top_merge(best, g); }
            }
#pragma unroll
            for (int i = 0; i < 16; ++i) g[i] = __shfl_xor(best[i], 32);
            top_merge(best, g);
#pragma unroll
            for (int i = 0; i < 16; ++i) A[pp][i] = best[i];
        }
        constexpr int CI[50] = {0,0,0,0,0,0,0,0,0,0,0,0,0,0,0,0,1,1,1,1,1,1,1,1,2,2,2,2,2,3,3,3,3,4,4,4,5,5,6,6,7,7,8,9,10,11,12,13,14,15};
        constexpr int CJ[50] = {0,1,2,3,4,5,6,7,8,9,10,11,12,13,14,15,0,1,2,3,4,5,6,7,0,1,2,3,4,0,1,2,3,0,1,2,0,1,0,1,0,1,0,0,0,0,0,0,0,0};
        float fa[16], fb[16]; unsigned long long wa0 = 0, wa1 = 0, wb0 = 0, wb1 = 0;
#pragma unroll
        for (int i = 0; i < 16; ++i) { fa[i] = ord2f(A[0][i] & ~127); fb[i] = ord2f(A[1][i] & ~127);
            if (i < 8) { wa0 |= (unsigned long long)(A[0][i] & 127) << (i * 8); wb0 |= (unsigned long long)(A[1][i] & 127) << (i * 8); }
            else { wa1 |= (unsigned long long)(A[0][i] & 127) << ((i - 8) * 8); wb1 |= (unsigned long long)(A[1][i] & 127) << ((i - 8) * 8); } }
        int best[16], g[16];
#pragma unroll
        for (int gi = 0; gi < 4; ++gi) {
#pragma unroll
            for (int r = 0; r < 16; ++r) { const int n = gi * 16 + r; int k = (int)0x80000000;
                if (n < 50) k = (f2ord(fa[CI[n < 50 ? n : 0]] + fb[CJ[n < 50 ? n : 0]]) & ~255) | (CI[n < 50 ? n : 0] << 4) | CJ[n < 50 ? n : 0];
                if (gi == 0) best[r] = k; else g[r] = k; }
            if (gi == 0) sort16(best); else { sort16(g); top_merge(best, g); }
        }
        float fs[16]; int fe[16]; float sum = 0.f; const float s0 = ord2f(best[0] & ~255);
        const float rs2 = rsqrtf(((const float*)(p.ws + OFF_SH))[t] * (1.f / 1024.f) + EPS);
#pragma unroll
        for (int k = 0; k < 16; ++k) { const int code = best[k] & 255; fe[k] = lookup16(wa0, wa1, code >> 4) * NKEYS + lookup16(wb0, wb1, code & 15);
            fs[k] = __expf((ord2f(best[k] & ~255) - s0) * rs2); sum += fs[k]; }
        const float inv = 1.f / sum;
        if (hi == 0) { int* eo = experts + (size_t)t * 128 + h * 16;
#pragma unroll
            for (int k = 0; k < 16; k += 4) *(u32x4*)(eo + k) = u32x4{(unsigned)fe[k], (unsigned)fe[k + 1], (unsigned)fe[k + 2], (unsigned)fe[k + 3]}; }
        else { float* go = gates + (size_t)t * 128 + h * 16;
#pragma unroll
            for (int k = 0; k < 16; k += 4) *(f32x4*)(go + k) = f32x4{fs[k] * inv, fs[k + 1] * inv, fs[k + 2] * inv, fs[k + 3] * inv}; }
    }
    __syncthreads();
}


__device__ __forceinline__ float wave_max(float v) {
#pragma unroll
    for (int o = 1; o < 64; o <<= 1) v = fmaxf(v, __shfl_xor(v, o));
    return v;
}
__device__ __forceinline__ unsigned q4(float a, float b, float cc, float d, float inv, int off) {
    const int x = (int)rintf(a * inv) + off, y = (int)rintf(b * inv) + off, z = (int)rintf(cc * inv) + off, w = (int)rintf(d * inv) + off;
    return (unsigned)(x & 255) | ((unsigned)(y & 255) << 8) | ((unsigned)(z & 255) << 16) | ((unsigned)(w & 255) << 24);
}
__device__ __forceinline__ void quant_row(const float* row, const float* mul, int lane, unsigned char* dst, float* scale_out, int off) {
    f32x4 v[4]; float mx = 0.f;
#pragma unroll
    for (int j = 0; j < 4; ++j) { v[j] = *(const f32x4*)(row + 16 * lane + 4 * j); if (mul) v[j] = v[j] * *(const f32x4*)(mul + 16 * lane + 4 * j);
        mx = fmaxf(mx, fmaxf(fmaxf(fabsf(v[j].x), fabsf(v[j].y)), fmaxf(fabsf(v[j].z), fabsf(v[j].w)))); }
    mx = fmaxf(wave_max(mx), 1e-30f);
    const float inv = 127.f / mx;
    u32x4 o; o.x = q4(v[0].x, v[0].y, v[0].z, v[0].w, inv, off); o.y = q4(v[1].x, v[1].y, v[1].z, v[1].w, inv, off);
    o.z = q4(v[2].x, v[2].y, v[2].z, v[2].w, inv, off); o.w = q4(v[3].x, v[3].y, v[3].z, v[3].w, inv, off);
    *(u32x4*)(dst + 16 * lane) = o;
    if (lane == 0) *scale_out = mx * (1.f / 127.f);
}
__device__ __forceinline__ void fp8_row(const float* row, int lane, unsigned char* dst) {
    u32x4 o;
#pragma unroll
    for (int j = 0; j < 4; ++j) { const f32x4 v = *(const f32x4*)(row + 16 * lane + 4 * j);
        int w = __builtin_amdgcn_cvt_pk_fp8_f32(v.x, v.y, 0, false); w = __builtin_amdgcn_cvt_pk_fp8_f32(v.z, v.w, w, true); o[j] = (unsigned)w; }
    *(u32x4*)(dst + (size_t)(lane >> 3) * ((size_t)NEXP * 128) + (lane & 7) * 16) = o;
}
__device__ __forceinline__ void ph4a_tables_q8(const Ctx& c, const Params& p, int gw, int ngw, int r_lo, int r_hi) {
    unsigned char* u8 = p.ws + OFF_R5; unsigned char* v8 = u8 + (size_t)NEXP * 1024;
    float* su = (float*)(p.ws + OFF_SU); float* sv = (float*)(p.ws + OFF_SV);
    for (int r = r_lo + gw; r < r_hi; r += ngw) {
        if (r < NEXP) quant_row(p.peer_u + (size_t)r * 1024, p.ln2_w, c.lane, u8 + (size_t)r * 1024, su + r, 0);
        else { const int e = r - NEXP; fp8_row(p.peer_v + (size_t)e * 1024, c.lane, v8 + (size_t)e * 128); }
    }
}


namespace gdn {
typedef short bf16x8 __attribute__((ext_vector_type(8)));
typedef short s16x4 __attribute__((ext_vector_type(4)));
typedef float f32x4v __attribute__((ext_vector_type(4)));
typedef float f32x2c __attribute__((ext_vector_type(2))); typedef __bf16 bf16x2c __attribute__((ext_vector_type(2)));
__device__ __forceinline__ unsigned cvtpk(float lo, float hi) { const f32x2c v = {lo, hi}; const bf16x2c r = __builtin_convertvector(v, bf16x2c); return *(const unsigned*)&r; }
__device__ __forceinline__ int wperm(int d) { const int x = d & 31; return (d & ~31) | (8 * ((x >> 2) & 3) + 4 * (x >> 4) + (x & 3)); }
}
__device__ __forceinline__ void unpack8(const u32x4 w, float (&f)[8]) {
    f[0] = bflo(w.x); f[1] = bfhi(w.x); f[2] = bflo(w.y); f[3] = bfhi(w.y); f[4] = bflo(w.z); f[5] = bfhi(w.z); f[6] = bflo(w.w); f[7] = bfhi(w.w); }
__device__ __forceinline__ u32x4 pack8(const float (&f)[8]) { u32x4 w; w.x = gdn::cvtpk(f[0], f[1]); w.y = gdn::cvtpk(f[2], f[3]); w.z = gdn::cvtpk(f[4], f[5]); w.w = gdn::cvtpk(f[6], f[7]); return w; }


template <int VAR>
__device__ __forceinline__ void ph2b_v4(const Ctx& c, const Params& p) {
    using namespace gdn;
    const int tid = opaque_tid(), wid = __builtin_amdgcn_readfirstlane(tid >> 6), lane = tid & 63, li = lane & 15, lq = lane >> 4;
    const bf16_t* gq = (const bf16_t*)(p.ws + OFF_R2); const bf16_t* gk = gq + (size_t)T * 512; const bf16_t* gv = gk + (size_t)T * 512;
    const float* Gg = (const float*)(p.ws + OFF_GATE); const float* Gb = Gg + 2 * T * GH; float* Gcs = (float*)(p.ws + OFF_GATE) + 4 * T * GH;
    bf16_t* U = (bf16_t*)(p.ws + OFF_R1); bf16_t* W = U + (size_t)2 * T * 512; bf16_t* AT = W + (size_t)2 * T * 512;
    char* lds = (char*)c.lds;
    char* kL = lds; char* qL = lds + 16384;
    float (*Gm)[68] = (float (*)[68])(lds + 32768); float (*QKm)[68] = Gm + 64;
    float (*Lm)[64][68] = (float (*)[64][68])(lds + 32768 + 2 * 64 * 68 * 4);
    float* gcsL = (float*)(lds + 32768 + 4 * 64 * 68 * 4); float* betaL = gcsL + 128; float* gL = betaL + 128;
    for (int unit = c.bid; unit < BATCH * GH * NCH; unit += c.nb) {
        const int nt = unit % NCH, h = (unit / NCH) % GH, b = unit / (NCH * GH);
        const int p0 = nt * CHUNK; const size_t bh = (size_t)(b * GH + h) * SEQ;
        __syncthreads();
#pragma unroll
        for (int i = 0; i < 2; ++i) { const int ch = tid + i * NT, row = ch >> 4, a = ch & 15; const int off = row * 256 + ((a * 16) ^ ((row & 15) << 4));
            *(u32x4*)(kL + off) = *(const u32x4*)(gk + (bh + p0 + row) * 128 + a * 8); *(u32x4*)(qL + off) = *(const u32x4*)(gq + (bh + p0 + row) * 128 + a * 8); }
        if (tid < 128) { const int d = tid >> 6, i = tid & 63; gL[tid] = Gg[(size_t)d * T * GH + bh + p0 + i]; betaL[tid] = Gb[(size_t)d * T * GH + bh + p0 + i]; }
        __syncthreads();
        if (wid < 2) { float v = gL[wid * 64 + (wid ? 63 - lane : lane)];
#pragma unroll
            for (int o = 1; o < 64; o <<= 1) { const float t_ = __shfl_up(v, o); if (lane >= o) v += t_; }
            gcsL[wid * 64 + lane] = v; }
        { const int mt = wid & 3; const char* Asrc = wid < 4 ? kL : qL; f32x4v acc[4];
#pragma unroll
          for (int n = 0; n < 4; ++n) acc[n] = f32x4v{0.f, 0.f, 0.f, 0.f};
#pragma unroll
          for (int s = 0; s < 4; ++s) { const int cb = 64 * s + 16 * lq;
              const bf16x8 af = *(const bf16x8*)(Asrc + (16 * mt + li) * 256 + (cb ^ (li << 4)));
#pragma unroll
              for (int n = 0; n < 4; ++n) { const bf16x8 bfr = *(const bf16x8*)(kL + (16 * n + li) * 256 + (cb ^ (li << 4)));
                  acc[n] = __builtin_amdgcn_mfma_f32_16x16x32_bf16(af, bfr, acc[n], 0, 0, 0); } }
          float (*dst)[68] = wid < 4 ? Gm : QKm;
#pragma unroll
          for (int n = 0; n < 4; ++n)
#pragma unroll
              for (int r = 0; r < 4; ++r) dst[16 * mt + 4 * lq + r][16 * n + li] = acc[n][r];
        }
        __syncthreads();
        if (tid < 128) { const int d = tid >> 6, i = tid & 63; const int nv = d ? NCH - 1 - nt : nt; Gcs[(size_t)d * T * GH + bh + nv * CHUNK + i] = gcsL[tid]; }
        const int tid2 = opaque_tid();
#pragma unroll 2
        for (int idx = tid2; idx < (VAR == 2 ? 0 : 2 * 4096); idx += NT) { const int d = idx >> 12, i = (idx >> 6) & 63, j = idx & 63; const int ti = d ? 63 - i : i, tj = d ? 63 - j : j;
            const float dec = __expf(gcsL[d * 64 + i] - gcsL[d * 64 + j]);
            Lm[d][j][i] = i > j ? betaL[d * 64 + ti] * Gm[ti][tj] * dec : 0.f;
            const int nv = d ? NCH - 1 - nt : nt;
            AT[((size_t)(d * BATCH * GH + b * GH + h) * NCH + nv) * 4096 + i * 64 + wperm(j)] = f2bf(i >= j ? QKm[ti][tj] * dec : 0.f); }
        __syncthreads();
        if (VAR == 1) continue;
        char* RL = lds;
        char* Dv = lds + 32768 + 4 * 64 * 68 * 4 + 1536;
        char* Lb = Dv + 4096;
        for (int ch = tid; ch < 4096; ch += NT) { const int d = ch >> 11, j = (ch >> 5) & 63, cc = ch & 31, tj = d ? 63 - j : j, col0 = cc * 8;
            const bf16_t* sp = (col0 < 128 ? gv + (bh + p0 + tj) * 128 + col0 : gk + (bh + p0 + tj) * 128 + (col0 - 128));
            float f[8]; unpack8(*(const u32x4*)sp, f);
            const float sc = betaL[d * 64 + tj] * (col0 < 128 ? 1.f : __expf(gcsL[d * 64 + j]));
#pragma unroll
            for (int e = 0; e < 8; ++e) f[e] *= sc;
            *(u32x4*)(RL + d * 33792 + (j >> 2) * 2112 + (cc >> 1) * 128 + (j & 3) * 32 + (cc & 1) * 16) = pack8(f); }
        if (tid < 128) {
            const int d = tid >> 6, bb = (tid >> 4) & 3, cc = tid & 15; float x[16];
#pragma unroll
            for (int i = 0; i < 16; ++i) x[i] = (i == cc) ? 1.f : 0.f;
#pragma unroll
            for (int j = 0; j < 15; ++j) { const float xj = x[j];
#pragma unroll
                for (int i = j + 1; i < 16; ++i) x[i] -= Lm[d][16 * bb + j][16 * bb + i] * xj; }
#pragma unroll
            for (int i = 0; i < 16; ++i) *(bf16_t*)(Dv + ((d * 4 + bb) * 16 + i) * 32 + cc * 2) = f2bf(x[i]);
        } else {
            for (int e = tid - 128; e < 2 * 6 * 256; e += NT - 128) { const int d = e / 1536, r = e % 1536, pi = r >> 8, i = (r >> 4) & 15, k = r & 15;
                const int bb = pi == 0 ? 1 : (pi < 3 ? 2 : 3), aa = pi - bb * (bb - 1) / 2;
                *(bf16_t*)(Lb + ((d * 6 + pi) * 16 + i) * 32 + k * 2) = f2bf(-Lm[d][16 * aa + k][16 * bb + i]); }
        }
        __syncthreads();
        { typedef short s16x4v __attribute__((ext_vector_type(4)));
          const int d = wid >> 2, nv = d ? NCH - 1 - nt : nt; const size_t rowbase = ((size_t)d * T * GH + bh + nv * CHUNK) * 128;
          const char* RLd = RL + d * 33792; const char* Dvd = Dv + d * 2048; const char* Lbd = Lb + d * 3072;
#pragma unroll
          for (int tp = 0; tp < 2; ++tp) {
              f32x4v acc[2][4]; s16x4v xb[2][4];
#pragma unroll
              for (int u = 0; u < 2; ++u) { const int ntile = 4 * (wid & 3) + 2 * tp + u;
#pragma unroll
                  for (int bb = 0; bb < 4; ++bb)
#pragma unroll
                      for (int r = 0; r < 4; ++r) acc[u][bb][r] = bf2f(*(const bf16_t*)(RLd + (4 * bb + lq) * 2112 + ntile * 128 + r * 32 + li * 2)); }
#pragma unroll
              for (int bb = 0; bb < 4; ++bb) {
#pragma unroll
                  for (int aa = 0; aa < bb; ++aa) { const s16x4v lf = *(const s16x4v*)(Lbd + ((bb * (bb - 1) / 2 + aa) * 16 + li) * 32 + lq * 8);
#pragma unroll
                      for (int u = 0; u < 2; ++u) acc[u][bb] = __builtin_amdgcn_mfma_f32_16x16x16bf16_1k(lf, xb[u][aa], acc[u][bb], 0, 0, 0); }
                  const s16x4v df = *(const s16x4v*)(Dvd + (bb * 16 + li) * 32 + lq * 8);
#pragma unroll
                  for (int u = 0; u < 2; ++u) { u32x2 w; w.x = cvtpk(acc[u][bb][0], acc[u][bb][1]); w.y = cvtpk(acc[u][bb][2], acc[u][bb][3]);
                      const s16x4v rb = *(s16x4v*)&w; acc[u][bb] = __builtin_amdgcn_mfma_f32_16x16x16bf16_1k(df, rb, f32x4v{0.f, 0.f, 0.f, 0.f}, 0, 0, 0);
                      u32x2 w2; w2.x = cvtpk(acc[u][bb][0], acc[u][bb][1]); w2.y = cvtpk(acc[u][bb][2], acc[u][bb][3]); xb[u][bb] = *(s16x4v*)&w2; }
              }
#pragma unroll
              for (int u = 0; u < 2; ++u) { const int col = 16 * (4 * (wid & 3) + 2 * tp + u) + li; bf16_t* dst = (col < 128 ? U + rowbase + col : W + rowbase + wperm(col - 128));
#pragma unroll
                  for (int bb = 0; bb < 4; ++bb)
#pragma unroll
                      for (int r = 0; r < 4; ++r) dst[(size_t)(16 * bb + 4 * lq + r) * 128] = (bf16_t)((unsigned short)xb[u][bb][r]); }
          }
        }
    }
    __syncthreads();
}

template <int VAR>
__device__ __forceinline__ void ph3b_mfma(const Ctx& c, const Params& p) {
    using namespace gdn;
    constexpr int W_OFF = 0, QD_OFF = 16384, KD_OFF = 32768, AT_OFF = 51200, U_OFF = 59392, MISC_OFF = 68608, BUF = 69632;
    const int tid = opaque_tid(), wid = __builtin_amdgcn_readfirstlane(tid >> 6), lane = tid & 63, li = lane & 15, lq = lane >> 4;
    const bf16_t* gq = (const bf16_t*)(p.ws + OFF_R2); const bf16_t* gk = gq + (size_t)T * 512;
    const float* Gcs = (const float*)(p.ws + OFF_GATE) + 4 * T * GH;
    const bf16_t* Ug = (const bf16_t*)(p.ws + OFF_R1); const bf16_t* Wg = Ug + (size_t)2 * T * 512; const bf16_t* ATg = Wg + (size_t)2 * T * 512;
    bf16_t* Od = (bf16_t*)(p.ws + OFF_R3);
    char* lds = (char*)c.lds;
    for (int unit = c.bid; unit < 2 * BATCH * GH * 2; unit += c.nb) {
        const int chain = (unit & 7) | ((unit >> 4) << 3), vh = (unit >> 3) & 1, h = chain & 3, b = (chain >> 2) & 1, dir = chain >> 3;
        const size_t bh = (size_t)(b * GH + h) * SEQ; const size_t dbh = (size_t)dir * T * GH + bh; const int c0 = vh * 64;
        __syncthreads();
        if (wid >= 4) {
            const int lt = tid - 256;
            struct LSet { u32x4 rw[4], rq[4], rk[4], ra[2], ru[2]; float gc[4], gl; };
            LSet sA, sB;
            const int r0 = lt >> 4, a0 = lt & 15;
            const unsigned offW = (unsigned)(r0 * 256 + a0 * 16);
            const unsigned offQ = (unsigned)((dir ? 63 - r0 : r0) * 256 + a0 * 16);
            const int r1 = lt >> 3, a1 = lt & 7;
            const unsigned offA = (unsigned)(r1 * 128 + a1 * 16), offU = (unsigned)(r1 * 256 + a1 * 16), offG = (unsigned)(r0 * 4);
            const int qstep = dir ? -4096 : 4096;
            const unsigned swW = (unsigned)((r0 & 15) << 4);
            const unsigned ldsW = (unsigned)(r0 * 256) + (((unsigned)a0 * 16u) ^ swW);
            const int s_ = a0 >> 2, a2 = a0 & 3; const int pos0 = ((2 * a2) & 3) * 2 + (a2 >> 1), pos1 = ((2 * a2 + 1) & 3) * 2 + (a2 >> 1);
            const unsigned ldsQ0 = (unsigned)(r0 * 256) + (((unsigned)(64 * s_ + 8 * pos0)) ^ swW), ldsQ1 = (unsigned)(r0 * 256) + (((unsigned)(64 * s_ + 8 * pos1)) ^ swW);
            const unsigned ldsK = (unsigned)((r0 >> 2) * 1152 + (a0 >> 1) * 128 + (r0 & 3) * 32 + (a0 & 1) * 16);
            const unsigned ldsA = (unsigned)(r1 * 128) + (((unsigned)a1 * 16u) ^ (unsigned)(((r1 >> 1) & 7) << 4)), ldsU = (unsigned)(r1 * 144 + a1 * 16);
            const char* Wb = (const char*)(Wg + dbh * 128); const char* Ub = (const char*)(Ug + dbh * 128 + c0);
            const char* Qb = (const char*)(gq + (bh + (dir ? SEQ - 64 : 0)) * 128); const char* Kb = (const char*)(gk + (bh + (dir ? SEQ - 64 : 0)) * 128);
            const char* Ab = (const char*)(ATg + (size_t)(dir * BATCH * GH + b * GH + h) * NCH * 4096); const char* Gb_ = (const char*)(Gcs + dbh);
#define GDN_LOAD(S_, nreal_) do { const int n_ = VAR == 1 ? 0 : (nreal_); const long cw_ = (long)(n_) * 16384, cq_ = dir ? -(long)(n_) * 16384 : (long)(n_) * 16384; \
    _Pragma("unroll") for (int i = 0; i < 4; ++i) { \
        S_.rw[i] = *(const u32x4*)(Wb + cw_ + i * 4096 + offW); S_.rq[i] = *(const u32x4*)(Qb + cq_ + i * qstep + offQ); S_.rk[i] = *(const u32x4*)(Kb + cq_ + i * qstep + offQ); \
        S_.gc[i] = *(const float*)(Gb_ + (long)(n_) * 256 + i * 64 + offG); } \
    _Pragma("unroll") for (int i = 0; i < 2; ++i) { \
        S_.ra[i] = *(const u32x4*)(Ab + (long)(n_) * 8192 + i * 4096 + offA); S_.ru[i] = *(const u32x4*)(Ub + cw_ + i * 8192 + offU); } \
    S_.gl = *(const float*)(Gb_ + (long)(n_) * 256 + 252); } while (0)
#define GDN_SCALE2(w_, f_) cvtpk(bflo(w_) * (f_), bfhi(w_) * (f_))
#define GDN_WRITE(S_, buf_) do { char* B_ = lds + (buf_) * BUF; \
    _Pragma("unroll") for (int i = 0; i < 4; ++i) { \
        *(u32x4*)(B_ + W_OFF + i * 4096 + ldsW) = S_.rw[i]; \
        const float fq_ = __expf(S_.gc[i]), fk_ = __expf(S_.gl - S_.gc[i]); \
        u32x2 q0, q1; q0.x = GDN_SCALE2(S_.rq[i].x, fq_); q0.y = GDN_SCALE2(S_.rq[i].y, fq_); q1.x = GDN_SCALE2(S_.rq[i].z, fq_); q1.y = GDN_SCALE2(S_.rq[i].w, fq_); \
        *(u32x2*)(B_ + QD_OFF + i * 4096 + ldsQ0) = q0; *(u32x2*)(B_ + QD_OFF + i * 4096 + ldsQ1) = q1; \
        u32x4 k_; k_.x = GDN_SCALE2(S_.rk[i].x, fk_); k_.y = GDN_SCALE2(S_.rk[i].y, fk_); k_.z = GDN_SCALE2(S_.rk[i].z, fk_); k_.w = GDN_SCALE2(S_.rk[i].w, fk_); \
        *(u32x4*)(B_ + KD_OFF + i * 4608 + ldsK) = k_; } \
    _Pragma("unroll") for (int i = 0; i < 2; ++i) { \
        *(u32x4*)(B_ + AT_OFF + i * 4096 + ldsA) = S_.ra[i]; *(u32x4*)(B_ + U_OFF + i * 4608 + ldsU) = S_.ru[i]; } \
    if (lt == 0) *(float*)(B_ + MISC_OFF) = __expf(S_.gl); } while (0)
            GDN_LOAD(sA, 0); GDN_WRITE(sA, 0); GDN_LOAD(sB, 1); GDN_LOAD(sA, 2);
            for (int n = 0; n < NCH; n += 2) {
                __syncthreads();
                GDN_WRITE(sB, 1);
                { const int nn = n + 3 < NCH ? n + 3 : NCH - 1; GDN_LOAD(sB, nn); }
                __syncthreads();
                GDN_WRITE(sA, 0);
                { const int nn = n + 4 < NCH ? n + 4 : NCH - 1; GDN_LOAD(sA, nn); }
            }
#undef GDN_LOAD
#undef GDN_WRITE
#undef GDN_SCALE2
        } else {
            f32x4v S[8];
#pragma unroll
            for (int m = 0; m < 8; ++m) S[m] = f32x4v{0.f, 0.f, 0.f, 0.f};
            const int cw = 16 * wid;
            for (int n = 0; n < NCH; ++n) {
                __syncthreads();
                if (VAR == 2) continue;
                const char* B = lds + (n & 1) * BUF; const int p0 = n * CHUNK;
                const float egl = *(const float*)(B + MISC_OFF);
                bf16x8 Sb[4];
#pragma unroll
                for (int s = 0; s < 4; ++s) { u32x4 w; w.x = cvtpk(S[2 * s][0], S[2 * s][1]); w.y = cvtpk(S[2 * s][2], S[2 * s][3]); w.z = cvtpk(S[2 * s + 1][0], S[2 * s + 1][1]); w.w = cvtpk(S[2 * s + 1][2], S[2 * s + 1][3]); Sb[s] = *(bf16x8*)&w; }
                f32x4v av[4], ao[4];
#pragma unroll
                for (int m = 0; m < 4; ++m) { av[m] = f32x4v{0.f, 0.f, 0.f, 0.f}; ao[m] = f32x4v{0.f, 0.f, 0.f, 0.f}; }
#pragma unroll
                for (int s = 0; s < 4; ++s)
#pragma unroll
                    for (int m = 0; m < 4; ++m) { const int off = (16 * m + li) * 256 + ((64 * s + 16 * lq) ^ (li << 4));
                        av[m] = __builtin_amdgcn_mfma_f32_16x16x32_bf16(*(const bf16x8*)(B + W_OFF + off), Sb[s], av[m], 0, 0, 0);
                        ao[m] = __builtin_amdgcn_mfma_f32_16x16x32_bf16(*(const bf16x8*)(B + QD_OFF + off), Sb[s], ao[m], 0, 0, 0); }
#pragma unroll
                for (int m = 0; m < 4; ++m)
#pragma unroll
                    for (int r = 0; r < 4; ++r) av[m][r] = bf2f(*(const bf16_t*)(B + U_OFF + (16 * m + 4 * lq + r) * 144 + (cw + li) * 2)) - av[m][r];
                bf16x8 Vb[2];
#pragma unroll
                for (int s = 0; s < 2; ++s) { u32x4 w; w.x = cvtpk(av[2 * s][0], av[2 * s][1]); w.y = cvtpk(av[2 * s][2], av[2 * s][3]); w.z = cvtpk(av[2 * s + 1][0], av[2 * s + 1][1]); w.w = cvtpk(av[2 * s + 1][2], av[2 * s + 1][3]); Vb[s] = *(bf16x8*)&w; }
#pragma unroll
                for (int s = 0; s < 2; ++s)
#pragma unroll
                    for (int m = 0; m < 4; ++m) { const int row = 16 * m + li;
                        ao[m] = __builtin_amdgcn_mfma_f32_16x16x32_bf16(*(const bf16x8*)(B + AT_OFF + row * 128 + ((64 * s + 16 * lq) ^ (((row >> 1) & 7) << 4))), Vb[s], ao[m], 0, 0, 0); }
#pragma unroll
                for (int m = 0; m < 8; ++m) S[m] = S[m] * egl;
                { s16x4 tr[8][4]; const int base = (int)(uintptr_t)(B + KD_OFF) + lq * 1152 + 8 * li;
#define GDN_TR(m_) do { asm volatile("ds_read_b64_tr_b16 %0, %1 offset:%2" : "=&v"(tr[m_][0]) : "v"(base), "i"((m_) * 128) : "memory"); \
    asm volatile("ds_read_b64_tr_b16 %0, %1 offset:%2" : "=&v"(tr[m_][1]) : "v"(base), "i"((m_) * 128 + 4608) : "memory"); \
    asm volatile("ds_read_b64_tr_b16 %0, %1 offset:%2" : "=&v"(tr[m_][2]) : "v"(base), "i"((m_) * 128 + 9216) : "memory"); \
    asm volatile("ds_read_b64_tr_b16 %0, %1 offset:%2" : "=&v"(tr[m_][3]) : "v"(base), "i"((m_) * 128 + 13824) : "memory"); } while (0)
#define GDN_SUP(m_) do { const bf16x8 k0 = bf16x8{tr[m_][0][0], tr[m_][0][1], tr[m_][0][2], tr[m_][0][3], tr[m_][1][0], tr[m_][1][1], tr[m_][1][2], tr[m_][1][3]}, \
        k1 = bf16x8{tr[m_][2][0], tr[m_][2][1], tr[m_][2][2], tr[m_][2][3], tr[m_][3][0], tr[m_][3][1], tr[m_][3][2], tr[m_][3][3]}; \
    S[m_] = __builtin_amdgcn_mfma_f32_16x16x32_bf16(k0, Vb[0], S[m_], 0, 0, 0); S[m_] = __builtin_amdgcn_mfma_f32_16x16x32_bf16(k1, Vb[1], S[m_], 0, 0, 0); } while (0)
                  GDN_TR(0); GDN_TR(1); GDN_TR(2); GDN_TR(3);
                  asm volatile("s_waitcnt lgkmcnt(0)" ::: "memory"); __builtin_amdgcn_sched_barrier(0);
                  GDN_TR(4); GDN_TR(5); GDN_TR(6); GDN_TR(7);
                  GDN_SUP(0); GDN_SUP(1); GDN_SUP(2); GDN_SUP(3);
                  asm volatile("s_waitcnt lgkmcnt(0)" ::: "memory"); __builtin_amdgcn_sched_barrier(0);
                  GDN_SUP(4); GDN_SUP(5); GDN_SUP(6); GDN_SUP(7);
#undef GDN_TR
#undef GDN_SUP
                }
#pragma unroll
                for (int m = 0; m < 4; ++m)
#pragma unroll
                    for (int r = 0; r < 4; ++r) { const int pv = p0 + 16 * m + 4 * lq + r; const int tk = dir ? SEQ - 1 - pv : pv;
                        Od[((size_t)dir * T + b * SEQ + tk) * 512 + h * 128 + c0 + cw + li] = f2bf(ao[m][r]); }
            }
        }
    }
    __syncthreads();
}


constexpr size_t OFF_SUMSQ = OFF_SH;
constexpr size_t OFF_KPE = OFF_R4;
__device__ __forceinline__ void cvt_tile(const float* src, int K, int N, const float* scale, bf16_t* dst, int Kpad, int tk, int tn, float* tile, int tid) {
    const int k0 = tk * 64, n0 = tn * 64;
#pragma unroll
    for (int i = 0; i < 2; ++i) { const int r = (tid >> 4) + 32 * i, k = k0 + r, n = n0 + (tid & 15) * 4; f32x4 v = {0.f, 0.f, 0.f, 0.f};
        if (k < K) { const float sc = scale ? scale[k] : 1.f;
            if (n + 3 < N) v = *(const f32x4*)(src + (size_t)k * N + n) * sc;
            else { for (int e = 0; e < 4; ++e) if (n + e < N) v[e] = src[(size_t)k * N + n + e] * sc; } }
#pragma unroll
        for (int e = 0; e < 4; ++e) tile[r * 65 + (tid & 15) * 4 + e] = v[e]; }
    __syncthreads();
    { const int nl = tid >> 3, kc = (tid & 7) * 8; float f[8];
#pragma unroll
      for (int j = 0; j < 8; ++j) f[j] = tile[(kc + j) * 65 + nl];
      *(u32x4*)(dst + (size_t)(n0 + nl) * Kpad + k0 + kc) = pack8(f); }
    __syncthreads();
}
__device__ __forceinline__ void ph0_v2(const Ctx& c, const Params& p) {
    unsigned char* ws = p.ws;
    constexpr int T0 = 16 * 40, T1 = T0 + 4 * 12, T2 = T1 + 4 * 16, T3 = T2 + 16 * 16, T4 = T3 + 16 * 32;
    for (int tile = c.bid; tile < T4; tile += c.nb) {
        if (tile < T0) cvt_tile(p.w_in, 1024, IN_W, p.ln1_w, (bf16_t*)(ws + OFF_WIN), 1024, tile % 16, tile / 16, c.lds, c.tid);
        else if (tile < T1) { const int r = tile - T0; cvt_tile(p.w_q_up, QRANK, 768, p.q_a_norm_w, (bf16_t*)(ws + OFF_WQUP), 256, r % 4, r / 4, c.lds, c.tid); }
        else if (tile < T2) { const int r = tile - T1; cvt_tile(p.w_kv_up, KVRANK, 1024, p.kv_a_norm_w, (bf16_t*)(ws + OFF_WKVUP), 256, r % 4, r / 4, c.lds, c.tid); }
        else if (tile < T3) { const int r = tile - T2; cvt_tile(p.w_out, 1024, 1024, nullptr, (bf16_t*)(ws + OFF_WOUT), 1024, r % 16, r / 16, c.lds, c.tid); }
        else { const int r = tile - T3; cvt_tile(p.peer_wq, 1024, 2048, p.ln2_w, (bf16_t*)(ws + OFF_WPQ), 1024, r % 16, r / 16, c.lds, c.tid); }
    }
    { bf16_t* d = (bf16_t*)(ws + OFF_SUBK); const int total4 = PH * 2 * NKEYS * 128 / 4;
      for (int i = c.bid * NT + c.tid; i < total4; i += c.nb * NT) { const f32x4 v = ((const f32x4*)p.sub_keys)[i]; u32x2 o; o.x = gdn::cvtpk(v.x, v.y); o.y = gdn::cvtpk(v.z, v.w); ((u32x2*)d)[i] = o; } }
    { float* sq = (float*)(ws + OFF_SUMSQ); for (int i = c.bid * NT + c.tid; i < T; i += c.nb * NT) sq[i] = 0.f; }
    bf16_t* xb = (bf16_t*)(ws + OFF_R2); float* rstd1 = (float*)(ws + OFF_VEC);
    for (int m = c.gw; m < T; m += c.ngw) {
        const f32x4* xr = (const f32x4*)(p.x + (size_t)m * D_MODEL) + c.lane;
        f32x4 v[4]; float s = 0.f;
#pragma unroll
        for (int j = 0; j < 4; ++j) { v[j] = xr[64 * j]; s += v[j].x * v[j].x + v[j].y * v[j].y + v[j].z * v[j].z + v[j].w * v[j].w; }
        s = wave_sum(s);
        const float rs = rsqrtf(s * (1.f / D_MODEL) + EPS);
        if (c.lane == 0) rstd1[m] = rs;
        u32x2* o = (u32x2*)(xb + (size_t)m * D_MODEL) + c.lane;
#pragma unroll
        for (int j = 0; j < 4; ++j) { u32x2 w; w.x = gdn::cvtpk(v[j].x * rs, v[j].y * rs); w.y = gdn::cvtpk(v[j].z * rs, v[j].w * rs); o[64 * j] = w; }
    }
}

__device__ __forceinline__ void ph2a1_v2(const Ctx& c, const Params& p) {
    const int lane = opaque_tid() & 63;
    const bf16_t* proj = (const bf16_t*)(p.ws + OFF_R1);
    bf16_t* gq = (bf16_t*)(p.ws + OFF_R2); bf16_t* gk = gq + (size_t)T * 512; bf16_t* gv = gk + (size_t)T * 512; bf16_t* zs = gv + (size_t)T * 512;
    const int part = c.gw & 3;
    float cw[5][8];
#pragma unroll
    for (int j = 0; j < 5; ++j)
#pragma unroll
        for (int e = 0; e < 8; ++e) cw[j][e] = part < 3 ? p.conv_w[j * GDN_QKV + part * 512 + 8 * lane + e] : 0.f;
    for (int run = c.gw >> 2; run < T / 16; run += c.ngw >> 2) {
        const int t0 = run * 16, b = t0 / SEQ, s0 = t0 % SEQ;
        if (part == 3) {
#pragma unroll 4
            for (int i = 0; i < 16; ++i) { float f[8]; unpack8(*(const u32x4*)(proj + (size_t)(t0 + i) * IN_WP + C_Z + 8 * lane), f);
#pragma unroll
                for (int e = 0; e < 8; ++e) f[e] = siluf_(f[e]);
                *(u32x4*)(zs + (size_t)(t0 + i) * 512 + 8 * lane) = pack8(f); }
        } else {
            const bf16_t* base = proj + (size_t)t0 * IN_WP + C_QKV + part * 512 + 8 * lane;
            const u32x4 zero = {0u, 0u, 0u, 0u};
            u32x4 xw[5];
            xw[0] = s0 >= 2 ? *(const u32x4*)(base - 2 * IN_WP) : zero; xw[1] = s0 >= 1 ? *(const u32x4*)(base - IN_WP) : zero;
            xw[2] = *(const u32x4*)(base); xw[3] = *(const u32x4*)(base + IN_WP);
            bf16_t* dst = (part == 0 ? gq : part == 1 ? gk : gv) + ((size_t)(b * GH + (lane >> 4)) * SEQ + s0) * 128 + (lane & 15) * 8;
#pragma unroll
            for (int i = 0; i < 16; ++i) {
                xw[4] = (s0 + i + 2 < SEQ) ? *(const u32x4*)(base + (size_t)(i + 2) * IN_WP) : zero;
                float y[8];
#pragma unroll
                for (int e = 0; e < 8; ++e) y[e] = 0.f;
#pragma unroll
                for (int j = 0; j < 5; ++j) { float f[8]; unpack8(xw[j], f);
#pragma unroll
                    for (int e = 0; e < 8; ++e) y[e] += cw[j][e] * f[e]; }
                float ss = 0.f;
#pragma unroll
                for (int e = 0; e < 8; ++e) { y[e] = siluf_(y[e]); ss += y[e] * y[e]; }
                if (part < 2) { ss += __shfl_xor(ss, 1); ss += __shfl_xor(ss, 2); ss += __shfl_xor(ss, 4); ss += __shfl_xor(ss, 8);
                    const float rs = rsqrtf(ss + EPS) * (part == 0 ? 0.08838834764831845f : 1.f);
#pragma unroll
                    for (int e = 0; e < 8; ++e) y[e] *= rs; }
                *(u32x4*)(dst + (size_t)i * 128) = pack8(y);
                xw[0] = xw[1]; xw[1] = xw[2]; xw[2] = xw[3]; xw[3] = xw[4];
            }
        }
    }
    { float* Gg = (float*)(p.ws + OFF_GATE); float* Gb = Gg + 2 * T * GH;
      for (int t = c.bid * NT + c.tid; t < T; t += c.nb * NT) { const int b = t / SEQ, s = t % SEQ; float f0[8], f1[8];
          unpack8(*(const u32x4*)(proj + (size_t)t * IN_WP + C_GATE), f0); unpack8(*(const u32x4*)(proj + (size_t)t * IN_WP + C_GATE + 8), f1);
#pragma unroll
          for (int h = 0; h < 4; ++h) { const size_t gi = (size_t)(b * GH + h) * SEQ + s;
              Gg[gi] = -expf(p.a_log_f[h]) * softplusf_(f0[h] + p.dt_bias_f[h]); Gb[gi] = sigmoidf_(f0[4 + h]);
              Gg[(size_t)T * GH + gi] = -expf(p.a_log_b[h]) * softplusf_(f1[h] + p.dt_bias_b[h]); Gb[(size_t)T * GH + gi] = sigmoidf_(f1[4 + h]); } } }
    { float* rq = (float*)(p.ws + OFF_VEC) + T; float* rkv = rq + T; bf16_t* kpe = (bf16_t*)(p.ws + OFF_KPE);
      for (int t = c.gw; t < T; t += c.ngw) { u32x4 v = {0u, 0u, 0u, 0u}; if (lane < 56) v = *(const u32x4*)(proj + (size_t)t * IN_WP + 8 * lane);
          float f[8]; unpack8(v, f); float ss = 0.f;
#pragma unroll
          for (int e = 0; e < 8; ++e) ss += f[e] * f[e];
          const float sq = wave_sum(lane < 32 ? ss : 0.f), sk = wave_sum((lane >= 32 && lane < 48) ? ss : 0.f);
          if (lane == 0) { rq[t] = rsqrtf(sq * (1.f / QRANK) + EPS); rkv[t] = rsqrtf(sk * (1.f / KVRANK) + EPS); }
          if (lane >= 48 && lane < 56) *(u32x4*)(kpe + (size_t)t * 64 + (lane - 48) * 8) = v; } }
}

__device__ __forceinline__ void ph2a3_v2(const Ctx& c, const Params& p) {
    const int lane = opaque_tid() & 63;
    const bf16_t* qraw = (const bf16_t*)(p.ws + OFF_R5); const bf16_t* kvraw = (const bf16_t*)(p.ws + OFF_R3); const bf16_t* kpe = (const bf16_t*)(p.ws + OFF_KPE);
    const float* rq = (const float*)(p.ws + OFF_VEC) + T; const float* rkv = rq + T;
    bf16_t* Q = (bf16_t*)p.out; bf16_t* Kk = Q + (size_t)T * MLA_H * QKD; bf16_t* V = Kk + (size_t)T * MLA_H * QKD;
    const int h = lane >> 4, cc = lane & 15, hh = (lane >> 2) & 3, pc = lane & 3;
    const float inv = expf(-(float)(lane & 31) * (9.210340371976184f / 32.f));
    for (int t = c.gw; t < T; t += c.ngw) {
        const int b = t / SEQ, s = t % SEQ; const float rqv = rq[t], rkvv = rkv[t];
        float sn, cs; sincosf((float)p.pos[t] * inv, &sn, &cs);
        const size_t qo = ((size_t)(b * MLA_H + h) * SEQ + s) * QKD, vo = ((size_t)(b * MLA_H + h) * SEQ + s) * VDIM;
        { float f[8]; unpack8(*(const u32x4*)(qraw + (size_t)t * 768 + h * 192 + cc * 8), f);
#pragma unroll
          for (int e = 0; e < 8; ++e) f[e] *= rqv;
          *(u32x4*)(Q + qo + cc * 8) = pack8(f);
          unpack8(*(const u32x4*)(kvraw + (size_t)t * 1024 + h * 256 + cc * 8), f);
#pragma unroll
          for (int e = 0; e < 8; ++e) f[e] *= rkvv;
          *(u32x4*)(Kk + qo + cc * 8) = pack8(f);
          unpack8(*(const u32x4*)(kvraw + (size_t)t * 1024 + h * 256 + 128 + cc * 8), f);
#pragma unroll
          for (int e = 0; e < 8; ++e) f[e] *= rkvv;
          *(u32x4*)(V + vo + cc * 8) = pack8(f); }
        float cs8[8], sn8[8];
#pragma unroll
        for (int e = 0; e < 8; ++e) { cs8[e] = __shfl(cs, pc * 8 + e); sn8[e] = __shfl(sn, pc * 8 + e); }
        if (lane < 16) {
            const size_t ro = ((size_t)(b * MLA_H + hh) * SEQ + s) * QKD;
            float a[8], bq[8], o1[8], o2[8];
            unpack8(*(const u32x4*)(qraw + (size_t)t * 768 + hh * 192 + 128 + pc * 8), a); unpack8(*(const u32x4*)(qraw + (size_t)t * 768 + hh * 192 + 160 + pc * 8), bq);
#pragma unroll
            for (int e = 0; e < 8; ++e) { o1[e] = (a[e] * cs8[e] - bq[e] * sn8[e]) * rqv; o2[e] = (bq[e] * cs8[e] + a[e] * sn8[e]) * rqv; }
            *(u32x4*)(Q + ro + 128 + pc * 8) = pack8(o1); *(u32x4*)(Q + ro + 160 + pc * 8) = pack8(o2);
            unpack8(*(const u32x4*)(kpe + (size_t)t * 64 + pc * 8), a); unpack8(*(const u32x4*)(kpe + (size_t)t * 64 + 32 + pc * 8), bq);
#pragma unroll
            for (int e = 0; e < 8; ++e) { o1[e] = a[e] * cs8[e] - bq[e] * sn8[e]; o2[e] = bq[e] * cs8[e] + a[e] * sn8[e]; }
            *(u32x4*)(Kk + ro + 128 + pc * 8) = pack8(o1); *(u32x4*)(Kk + ro + 160 + pc * 8) = pack8(o2);
        }
    }
}

__device__ __forceinline__ void ph4a_v2(const Ctx& c, const Params& p, bool split) {
    const int lane = opaque_tid() & 63;
    const bf16_t* Od = (const bf16_t*)(p.ws + OFF_R3); const bf16_t* omla = (const bf16_t*)(p.ws + OFF_R4);
    const bf16_t* zs = (const bf16_t*)(p.ws + OFF_R2) + (size_t)3 * T * 512; bf16_t* cat = (bf16_t*)(p.ws + OFF_R1);
    float gw8[8];
#pragma unroll
    for (int e = 0; e < 8; ++e) gw8[e] = p.gdn_norm_w[(lane & 15) * 8 + e];
    for (int t = c.gw; t < T; t += c.ngw) {
        float a[8], bb[8], z[8];
        unpack8(*(const u32x4*)(Od + (size_t)t * 512 + lane * 8), a); unpack8(*(const u32x4*)(Od + ((size_t)T + t) * 512 + lane * 8), bb); unpack8(*(const u32x4*)(zs + (size_t)t * 512 + lane * 8), z);
        float ss = 0.f;
#pragma unroll
        for (int e = 0; e < 8; ++e) { a[e] += bb[e]; ss += a[e] * a[e]; }
        ss += __shfl_xor(ss, 1); ss += __shfl_xor(ss, 2); ss += __shfl_xor(ss, 4); ss += __shfl_xor(ss, 8);
        const float r = rsqrtf(ss * (1.f / 128.f) + EPS);
#pragma unroll
        for (int e = 0; e < 8; ++e) a[e] = a[e] * r * gw8[e] * z[e];
        *(u32x4*)(cat + (size_t)t * 1024 + 512 + lane * 8) = pack8(a);
        const int s_ = t % SEQ;
        if (split && s_ >= 28 * 256) {
            const int lu = ((s_ >> 8) - 28) * 8 + (t / SEQ) * 4 + (lane >> 4), row = s_ & 255;
            const float* ml = (const float*)(p.ws + OFF_PARTML) + ((size_t)lu * 7 * 256 + row) * 2; const bf16_t* po = (const bf16_t*)(p.ws + OFF_PART) + ((size_t)lu * 7 * 256 + row) * 128 + (lane & 15) * 8;
            float mp[7], lp[7], M = -3e38f;
#pragma unroll
            for (int q = 0; q < 7; ++q) { mp[q] = ml[q * 512]; lp[q] = ml[q * 512 + 1]; M = fmaxf(M, mp[q]); }
            float o8[8], L = 0.f;
#pragma unroll
            for (int e = 0; e < 8; ++e) o8[e] = 0.f;
#pragma unroll
            for (int q = 0; q < 7; ++q) { const float w = exp2f((mp[q] - M) * (attn::SCALE * 1.4426950408889634f)); L += w * lp[q]; float f[8]; unpack8(*(const u32x4*)(po + (size_t)q * 256 * 128), f);
#pragma unroll
                for (int e = 0; e < 8; ++e) o8[e] += w * f[e]; }
            const float il = 1.f / L;
#pragma unroll
            for (int e = 0; e < 8; ++e) o8[e] *= il;
            *(u32x4*)(cat + (size_t)t * 1024 + lane * 8) = pack8(o8);
        } else
        *(u32x4*)(cat + (size_t)t * 1024 + lane * 8) = *(const u32x4*)(omla + (size_t)t * 512 + lane * 8);
    }
}


constexpr size_t OFF_HQ = OFF_R1;
constexpr size_t OFF_HSC = OFF_VEC + 3 * (size_t)T * 4;
constexpr size_t OFF_CBUF = OFF_R3;
constexpr size_t OFF_SUMSQ2 = OFF_VEC + (size_t)T * 4;
__device__ __forceinline__ float gelu_as(float v) {
    const float av = fabsf(v), t = __builtin_amdgcn_rcpf(av * 0.2316418882f + 1.0f);
    float q = t * 0.5307027145f + (-0.7265760135f); q = q * t + 0.7107068705f; q = q * t + (-0.142248368f); q = q * t + 0.127414796f; q = q * t;
    const float m = v * (q * __builtin_amdgcn_exp2f((v * v) * (-0.72134752044f)));
    return v < 0.f ? m : v - m;
}
__device__ __forceinline__ void peer_hq(const Ctx& c, const Params& p) {
    const int lane = c.lane; unsigned char* hq = p.ws + OFF_HQ; float* hsc = (float*)(p.ws + OFF_HSC);
    for (int t = c.gw; t < T; t += c.ngw) {
        const float* row = p.out + (size_t)t * 1024 + 16 * lane; f32x4 hr[4]; float ssq = 0.f, mx = 0.f;
#pragma unroll
        for (int j = 0; j < 4; ++j) { hr[j] = *(const f32x4*)(row + 4 * j);
#pragma unroll
            for (int k = 0; k < 4; ++k) { ssq += hr[j][k] * hr[j][k]; mx = fmaxf(mx, fabsf(hr[j][k])); } }
        ssq = wave_sum(ssq); mx = fmaxf(wave_max(mx), 1e-30f);
        const float qinv = 127.f / mx;
        u32x4 hv; hv.x = q4(hr[0].x, hr[0].y, hr[0].z, hr[0].w, qinv, 0); hv.y = q4(hr[1].x, hr[1].y, hr[1].z, hr[1].w, qinv, 0);
        hv.z = q4(hr[2].x, hr[2].y, hr[2].z, hr[2].w, qinv, 0); hv.w = q4(hr[3].x, hr[3].y, hr[3].z, hr[3].w, qinv, 0);
        *(u32x4*)(hq + (size_t)t * 1024 + 16 * lane) = hv;
        if (lane == 0) hsc[t] = rsqrtf(ssq * (1.f / 1024.f) + EPS) * mx * (1.f / 127.f);
    }
}
template <int VAR>
__device__ __forceinline__ void peer_H3(const Ctx& c, const Params& p) {
    const int tid = opaque_tid(), lane = tid & 63, wid = __builtin_amdgcn_readfirstlane(tid >> 6), grp = lane >> 3, sub = lane & 7;
    const unsigned char* hq = p.ws + OFF_HQ; const float* hsc = (const float*)(p.ws + OFF_HSC);
    const unsigned char* u8 = p.ws + OFF_R5; const float* su = (const float*)(p.ws + OFF_SU);
    const int* experts = (const int*)(p.ws + OFF_R4); const float* gates = (const float*)(p.ws + OFF_R4 + 8 * MB);
    float* cbuf = (float*)(p.ws + OFF_CBUF);
    { float* s2 = (float*)(p.ws + OFF_SUMSQ2); for (int i = c.bid * NT + tid; i < T; i += c.nb * NT) s2[i] = 0.f; }
    const int x = c.bid & 7, nslw = ((c.nb - x + 7) >> 3) * (NT / 64), wx = (c.bid >> 3) * (NT / 64) + wid;
    int* cE = (int*)c.lds + wid * 384; float* cG = (float*)(cE + 128); int* cS = cE + 256;
    int e0n = 0, e1n = 0; float g0n = 0.f, g1n = 0.f, hsn = 0.f; u32x4 hvn[8];
#define PH_FETCH(t_) do { e0n = experts[(size_t)(t_) * 128 + lane]; e1n = experts[(size_t)(t_) * 128 + 64 + lane]; g0n = gates[(size_t)(t_) * 128 + lane]; g1n = gates[(size_t)(t_) * 128 + 64 + lane]; hsn = hsc[t_]; \
    _Pragma("unroll") for (int j_ = 0; j_ < 8; ++j_) hvn[j_] = *(const u32x4*)(hq + (size_t)(t_) * 1024 + sub * 16 + j_ * 128); } while (0)
    if (wx < T) PH_FETCH(wx);
    for (int t = wx; t < T; t += nslw) {
        const int e0 = e0n, e1 = e1n; const float g0 = g0n, g1 = g1n, hs = hsn; u32x4 hv[8];
#pragma unroll
        for (int j = 0; j < 8; ++j) hv[j] = hvn[j];
        { const int tn = t + nslw < T ? t + nslw : t; PH_FETCH(tn); }
        const bool in0 = (e0 >> 11) == x, in1 = (e1 >> 11) == x;
        const unsigned long long m0 = __ballot(in0), m1 = __ballot(in1);
        const int n0 = __popcll(m0), cnt = n0 + __popcll(m1);
        const int r0 = __builtin_amdgcn_mbcnt_hi((unsigned)(m0 >> 32), __builtin_amdgcn_mbcnt_lo((unsigned)m0, 0));
        const int r1 = n0 + __builtin_amdgcn_mbcnt_hi((unsigned)(m1 >> 32), __builtin_amdgcn_mbcnt_lo((unsigned)m1, 0));
        if (in0) { cE[r0] = e0; cG[r0] = g0; cS[r0] = lane; }
        if (in1) { cE[r1] = e1; cG[r1] = g1; cS[r1] = 64 + lane; }
        for (int b0 = 0; b0 < (VAR == 1 ? 0 : cnt); b0 += 24) {
            int me[3]; float mg[3], msu[3]; int ms[3]; u32x4 ur[3][8];
            const bool third = cnt - b0 > 16;
#pragma unroll
            for (int q = 0; q < 3; ++q) { const int ent = min(b0 + 8 * q + grp, cnt - 1); me[q] = cE[ent]; mg[q] = cG[ent]; ms[q] = cS[ent]; }
#pragma unroll
            for (int q = 0; q < 3; ++q) if (q < 2 || third) { msu[q] = su[me[q]]; const unsigned char* pr = u8 + (size_t)me[q] * 1024 + sub * 16;
#pragma unroll
                for (int j = 0; j < 8; ++j) { if (VAR == 3) ur[q][j] = hv[j]; else ur[q][j] = *(const u32x4*)(pr + j * 128); } }
            __builtin_amdgcn_sched_barrier(0);
#pragma unroll
            for (int q = 0; q < 3; ++q) if (q < 2 || third) {
                int s0 = 0, s1 = 0, s2_ = 0, s3 = 0;
                if (VAR == 2) { s0 = (int)(ur[q][0].x ^ ur[q][1].x ^ ur[q][2].x ^ ur[q][3].x ^ ur[q][4].x ^ ur[q][5].x ^ ur[q][6].x ^ ur[q][7].x); }
                else
#pragma unroll
                for (int j = 0; j < 8; ++j) { s0 = __builtin_amdgcn_sdot4((int)hv[j].x, (int)ur[q][j].x, s0, false); s1 = __builtin_amdgcn_sdot4((int)hv[j].y, (int)ur[q][j].y, s1, false);
                    s2_ = __builtin_amdgcn_sdot4((int)hv[j].z, (int)ur[q][j].z, s2_, false); s3 = __builtin_amdgcn_sdot4((int)hv[j].w, (int)ur[q][j].w, s3, false); }
                int s = (s0 + s1) + (s2_ + s3);
                s += __builtin_amdgcn_update_dpp(0, s, 0xB1, 0xf, 0xf, true);
                s += __builtin_amdgcn_update_dpp(0, s, 0x4E, 0xf, 0xf, true);
                s += __builtin_amdgcn_update_dpp(0, s, 0x141, 0xf, 0xf, true);
                const float cc = mg[q] * gelu_as(hs * msu[q] * (float)s);
                if (sub == 0 && b0 + 8 * q + grp < cnt) cbuf[(size_t)t * 128 + ms[q]] = cc;
            }
        }
    }
#undef PH_FETCH
}

__device__ __forceinline__ void peer_H4(const Ctx& c, const Params& p) {
    const int tid = opaque_tid(), lane = tid & 63, wid = __builtin_amdgcn_readfirstlane(tid >> 6), grp = lane >> 3, sub = lane & 7;
    const unsigned char* hq = p.ws + OFF_HQ; const float* hsc = (const float*)(p.ws + OFF_HSC);
    const unsigned char* u8 = p.ws + OFF_R5; const float* su = (const float*)(p.ws + OFF_SU);
    const int* experts = (const int*)(p.ws + OFF_R4); const float* gates = (const float*)(p.ws + OFF_R4 + 8 * MB);
    float* cbuf = (float*)(p.ws + OFF_CBUF);
    { float* s2 = (float*)(p.ws + OFF_SUMSQ2); for (int i = c.bid * NT + tid; i < T; i += c.nb * NT) s2[i] = 0.f; }
    const int x = c.bid & 7, nslw = ((c.nb - x + 7) >> 3) * (NT / 64), wx = (c.bid >> 3) * (NT / 64) + wid;
    int* cE = (int*)c.lds + wid * 768; float* cG = (float*)(cE + 128); int* cS = cE + 256;
    int e0n[2], e1n[2]; float g0n[2], g1n[2];
#define PH_FETCH(u_, t_) do { e0n[u_] = experts[(size_t)(t_) * 128 + lane]; e1n[u_] = experts[(size_t)(t_) * 128 + 64 + lane]; g0n[u_] = gates[(size_t)(t_) * 128 + lane]; g1n[u_] = gates[(size_t)(t_) * 128 + 64 + lane]; } while (0)
#define PH_DOT(S_, HV_, UR_) do { int s0_ = 0, s1_ = 0, s2__ = 0, s3_ = 0; \
    _Pragma("unroll") for (int j_ = 0; j_ < 8; ++j_) { s0_ = __builtin_amdgcn_sdot4((int)HV_[j_].x, (int)UR_[j_].x, s0_, false); s1_ = __builtin_amdgcn_sdot4((int)HV_[j_].y, (int)UR_[j_].y, s1_, false); \
        s2__ = __builtin_amdgcn_sdot4((int)HV_[j_].z, (int)UR_[j_].z, s2__, false); s3_ = __builtin_amdgcn_sdot4((int)HV_[j_].w, (int)UR_[j_].w, s3_, false); } \
    S_ = (s0_ + s1_) + (s2__ + s3_); \
    S_ += __builtin_amdgcn_update_dpp(0, S_, 0xB1, 0xf, 0xf, true); S_ += __builtin_amdgcn_update_dpp(0, S_, 0x4E, 0xf, 0xf, true); S_ += __builtin_amdgcn_update_dpp(0, S_, 0x141, 0xf, 0xf, true); } while (0)
#pragma unroll
    for (int u = 0; u < 2; ++u) { const int tt = wx + u * nslw < T ? wx + u * nslw : 0; PH_FETCH(u, tt); }
    for (int t = wx; t < T; t += 2 * nslw) {
        int cnt[2]; u32x4 hv[2][8]; float hs[2]; int tt[2]; bool val[2];
#pragma unroll
        for (int u = 0; u < 2; ++u) {
            val[u] = t + u * nslw < T; tt[u] = val[u] ? t + u * nslw : 0;
            const int e0 = e0n[u], e1 = e1n[u]; const float g0 = g0n[u], g1 = g1n[u];
#pragma unroll
            for (int j = 0; j < 8; ++j) hv[u][j] = *(const u32x4*)(hq + (size_t)tt[u] * 1024 + sub * 16 + j * 128);
            hs[u] = hsc[tt[u]];
            const bool in0 = (e0 >> 11) == x, in1 = (e1 >> 11) == x;
            const unsigned long long m0 = __ballot(in0), m1 = __ballot(in1);
            const int n0 = __popcll(m0); cnt[u] = n0 + __popcll(m1);
            const int r0 = __builtin_amdgcn_mbcnt_hi((unsigned)(m0 >> 32), __builtin_amdgcn_mbcnt_lo((unsigned)m0, 0));
            const int r1 = n0 + __builtin_amdgcn_mbcnt_hi((unsigned)(m1 >> 32), __builtin_amdgcn_mbcnt_lo((unsigned)m1, 0));
            int* E_ = cE + u * 384; float* G_ = cG + u * 384; int* S_ = cS + u * 384;
            if (in0) { E_[r0] = e0; G_[r0] = g0; S_[r0] = lane; }
            if (in1) { E_[r1] = e1; G_[r1] = g1; S_[r1] = 64 + lane; }
        }
#pragma unroll
        for (int u = 0; u < 2; ++u) { const int tn = t + (2 + u) * nslw; const int t2 = tn < T ? tn : 0; PH_FETCH(u, t2); }
        int me[2][2]; float mg[2][2], msu[2][2]; int ms[2][2]; u32x4 ur[2][2][8];
#pragma unroll
        for (int u = 0; u < 2; ++u)
#pragma unroll
            for (int q = 0; q < 2; ++q) { const int ent = min(8 * q + grp, max(cnt[u] - 1, 0)); me[u][q] = cE[u * 384 + ent]; mg[u][q] = cG[u * 384 + ent]; ms[u][q] = cS[u * 384 + ent];
                if (cnt[u] == 0) me[u][q] = 2048 * x;
                msu[u][q] = su[me[u][q]]; const unsigned char* pr = u8 + (size_t)me[u][q] * 1024 + sub * 16;
#pragma unroll
                for (int j = 0; j < 8; ++j) ur[u][q][j] = *(const u32x4*)(pr + j * 128); }
        __builtin_amdgcn_sched_barrier(0);
#pragma unroll
        for (int u = 0; u < 2; ++u)
#pragma unroll
            for (int q = 0; q < 2; ++q) { int s; PH_DOT(s, hv[u], ur[u][q]);
                const float cc = mg[u][q] * gelu_as(hs[u] * msu[u][q] * (float)s);
                if (sub == 0 && val[u] && 8 * q + grp < cnt[u]) cbuf[(size_t)tt[u] * 128 + ms[u][q]] = cc; }
#pragma unroll
        for (int u = 0; u < 2; ++u)
            for (int b0 = 16; b0 < cnt[u]; b0 += 8) { const int ent = min(b0 + grp, cnt[u] - 1); const int me_ = cE[u * 384 + ent]; const float mg_ = cG[u * 384 + ent]; const int ms_ = cS[u * 384 + ent];
                const float msu_ = su[me_]; const unsigned char* pr = u8 + (size_t)me_ * 1024 + sub * 16; u32x4 ux[8];
#pragma unroll
                for (int j = 0; j < 8; ++j) ux[j] = *(const u32x4*)(pr + j * 128);
                int s; PH_DOT(s, hv[u], ux);
                const float cc = mg_ * gelu_as(hs[u] * msu_ * (float)s);
                if (sub == 0 && val[u] && b0 + grp < cnt[u]) cbuf[(size_t)tt[u] * 128 + ms_] = cc; }
    }
#undef PH_FETCH
#undef PH_DOT
}
template <int DRY>
__device__ __forceinline__ void peer_O2(const Ctx& c, const Params& p) {
    typedef float f32x2 __attribute__((ext_vector_type(2)));
    const int tid = opaque_tid(), lane = tid & 63, wid = __builtin_amdgcn_readfirstlane(tid >> 6);
    const unsigned char* v8 = p.ws + OFF_R5 + (size_t)NEXP * 1024;
    const int* experts = (const int*)(p.ws + OFF_R4); const float* cbuf = (const float*)(p.ws + OFF_CBUF); float* s2 = (float*)(p.ws + OFF_SUMSQ2);
    const int x = c.bid & 7, nslw = ((c.nb - x + 7) >> 3) * (NT / 64), wx = (c.bid >> 3) * (NT / 64) + wid;
    const int grp = lane >> 3, sub = lane & 7, col = 128 * x + 16 * sub;
    const unsigned char* v8x = v8 + (size_t)x * ((size_t)NEXP * 128) + 16 * sub;
    u32x4 En[2][4];
#define PO_FETCH(u_, t_) do { _Pragma("unroll") for (int j_ = 0; j_ < 4; ++j_) En[u_][j_] = *(const u32x4*)(experts + (size_t)(t_) * 128 + grp * 16 + 4 * j_); } while (0)
#pragma unroll
    for (int u = 0; u < 2; ++u) { const int tt = wx + u * nslw < T ? wx + u * nslw : 0; PO_FETCH(u, tt); }
    for (int t = wx; t < T; t += 2 * nslw) {
        u32x4 vr[2][16]; f32x4 cv[2][4]; f32x4 hpre[2][4];
#pragma unroll
        for (int u = 0; u < 2; ++u) { const int tt = t + u * nslw < T ? t + u * nslw : 0;
#pragma unroll
            for (int j = 0; j < 4; ++j) hpre[u][j] = *(const f32x4*)(p.out + (size_t)tt * 1024 + col + 4 * j);
#pragma unroll
            for (int j = 0; j < 4; ++j) { cv[u][j] = *(const f32x4*)(cbuf + (size_t)tt * 128 + grp * 16 + 4 * j);
#pragma unroll
                for (int k = 0; k < 4; ++k) { int e = (int)En[u][j][k]; if (DRY == 2) e &= 7; vr[u][4 * j + k] = *(const u32x4*)(v8x + (size_t)e * 128); } } }
#pragma unroll
        for (int u = 0; u < 2; ++u) { const int tn = t + (2 + u) * nslw; const int tt = tn < T ? tn : 0; PO_FETCH(u, tt); }
        __builtin_amdgcn_sched_barrier(0);
#pragma unroll
        for (int u = 0; u < 2; ++u) {
            f32x2 acc[8];
#pragma unroll
            for (int i = 0; i < 8; ++i) acc[i] = f32x2{0.f, 0.f};
#pragma unroll
            for (int it = 0; it < 16; ++it) { const float cs_ = cv[u][it >> 2][it & 3]; const f32x2 cc = {cs_, cs_};
#pragma unroll
                for (int w = 0; w < 4; ++w) { const int q = (int)vr[u][it][w];
                    acc[2 * w] += __builtin_amdgcn_cvt_pk_f32_fp8(q, false) * cc; acc[2 * w + 1] += __builtin_amdgcn_cvt_pk_f32_fp8(q, true) * cc; } }
            float a16[16];
#pragma unroll
            for (int i = 0; i < 8; ++i) { a16[2 * i] = acc[i].x; a16[2 * i + 1] = acc[i].y; }
#pragma unroll
            for (int i = 0; i < 16; ++i) { float v = a16[i];
                v += __builtin_amdgcn_update_dpp(0.f, v, 0x128, 0xf, 0xf, true);
                { auto r = __builtin_amdgcn_permlane16_swap(__float_as_uint(v), __float_as_uint(v), false, false); v = __uint_as_float(r[0]) + __uint_as_float(r[1]); }
                { auto r = __builtin_amdgcn_permlane32_swap(__float_as_uint(v), __float_as_uint(v), false, false); v = __uint_as_float(r[0]) + __uint_as_float(r[1]); }
                a16[i] = v; }
            const int tt = t + u * nslw; float ss = 0.f;
            if (grp == 0 && tt < T) { float* hrow = p.out + (size_t)tt * 1024 + col;
#pragma unroll
                for (int j = 0; j < 4; ++j) { f32x4 hv = hpre[u][j];
                    hv[0] += a16[4 * j]; hv[1] += a16[4 * j + 1]; hv[2] += a16[4 * j + 2]; hv[3] += a16[4 * j + 3];
                    ss += hv[0] * hv[0] + hv[1] * hv[1] + hv[2] * hv[2] + hv[3] * hv[3];
                    if (!DRY) *(f32x4*)(hrow + 4 * j) = hv; } }
            ss += __builtin_amdgcn_update_dpp(0.f, ss, 0xB1, 0xf, 0xf, true); ss += __builtin_amdgcn_update_dpp(0.f, ss, 0x4E, 0xf, 0xf, true); ss += __builtin_amdgcn_update_dpp(0.f, ss, 0x141, 0xf, 0xf, true);
            if (DRY) asm volatile("" :: "v"(ss)); else if (lane == 0 && tt < T) unsafeAtomicAdd(s2 + tt, ss);
        }
    }
#undef PO_FETCH
}
__device__ __forceinline__ void peer_N(const Ctx& c, const Params& p) {
    const int lane = c.lane; const float* s2 = (const float*)(p.ws + OFF_SUMSQ2);
    for (int t = c.gw; t < T; t += c.ngw) {
        float* row = p.out + (size_t)t * 1024 + 4 * lane; const float r = rsqrtf(s2[t] * (1.f / 1024.f) + EPS);
#pragma unroll
        for (int j = 0; j < 4; ++j) *(f32x4*)(row + 256 * j) = *(const f32x4*)(row + 256 * j) * r * *(const f32x4*)(p.final_w + 4 * lane + 256 * j);
    }
}

constexpr int LDS_BYTES = 144 * 1024;
__global__ void __launch_bounds__(NT, 2) fwd_megakernel(Params p) {
    extern __shared__ __attribute__((aligned(16))) unsigned char lds_raw[];
    cg::grid_group grid = cg::this_grid();
#define MKCTX() ({ Ctx c_; c_.tid = opaque_tid(); c_.lane = c_.tid & 63; c_.wave = __builtin_amdgcn_readfirstlane(c_.tid >> 6); c_.bid = blockIdx.x; c_.nb = gridDim.x; \
    c_.gw = c_.bid * (NT / 64) + c_.wave; c_.ngw = c_.nb * (NT / 64); c_.lds = (float*)lds_raw; c_; })
    Ctx c = MKCTX();
    volatile LAS unsigned* xb_st = (volatile LAS unsigned*)(lds_raw + LDS_BYTES - 16);
    if (threadIdx.x < 4) xb_st[threadIdx.x] = 0u;
    __syncthreads();
    const XcdBarrier xbar = xcd_barrier_post((unsigned*)(p.ws + OFF_BAR), xb_st);
#define GSYNC() do { xcd_barrier(xbar); c = MKCTX(); } while (0)
#define RP(k, call) for (int r_ = 0; r_ < ((PROBE_PH == (k)) ? 2 : 1); ++r_) { call; }
    if (PROBE_PH == 30 && c.tid == 0) __hip_atomic_store((unsigned*)(p.ws + OFF_BAR + 16384) + c.bid, xb_xcc_id(), __ATOMIC_RELAXED, __HIP_MEMORY_SCOPE_AGENT);
    RP(0, ph0_v2(c, p));
    if (p.ws == nullptr) grid.sync();
    GSYNC();
    RP(1, ph1_mfma(c, p)); GSYNC();
    RP(2, ph2a1_v2(c, p)); RP(3, ph2a2_v2(c, p)); GSYNC();
    RP(4, ph2a3_v2(c, p)); if (PROBE_PH == 24) ph2b_v4<1>(c, p);
    if (PROBE_PH == 25) ph2b_v4<2>(c, p);
    RP(5, ph2b_v4<0>(c, p)); GSYNC();
    const bool split = c.nb == 256; constexpr int TAB_SPLIT = NEXP / 2;
    if (split) {
        if (c.bid >= 32) { RP(6, ph3a_split(c, p)); }
        else { RP(7, ph3b_mfma<0>(c, p)); RP(9, ph4a_tables_q8(c, p, c.gw, 32 * (NT / 64), 0, TAB_SPLIT)); }
    } else {
        ph3a_mfma(c, p);
        if (c.bid < 32) ph3b_mfma<0>(c, p); else ph4a_tables_q8(c, p, (c.bid - 32) * (NT / 64) + c.wave, (c.nb - 32) * (NT / 64), 0, TAB_SPLIT);
    }
    GSYNC();
    RP(8, ph4a_v2(c, p, split)); RP(11, ph4a_tables_q8(c, p, c.gw, c.ngw, TAB_SPLIT, 2 * NEXP)); GSYNC();
    RP(10, ph4b_v2(c, p)); GSYNC();
    RP(12, ph5_v2(c, p)); GSYNC();
    RP(13, ph6_fast(c, p));
    if (PROBE_PH == 30 && c.bid == 0 && c.tid == 0) {
        const unsigned* ids = (const unsigned*)(p.ws + OFF_BAR + 16384); bool ok = true;
        for (int b_ = 0; b_ < c.nb; ++b_) ok = ok && (__hip_atomic_load(ids + b_, __ATOMIC_RELAXED, __HIP_MEMORY_SCOPE_AGENT) == __hip_atomic_load(ids + (b_ & 7), __ATOMIC_RELAXED, __HIP_MEMORY_SCOPE_AGENT));
        for (int b_ = 0; b_ < 8; ++b_) for (int c_ = 0; c_ < b_; ++c_) ok = ok && (__hip_atomic_load(ids + b_, __ATOMIC_RELAXED, __HIP_MEMORY_SCOPE_AGENT) != __hip_atomic_load(ids + c_, __ATOMIC_RELAXED, __HIP_MEMORY_SCOPE_AGENT));
        if (!ok) for (int i_ = 0; i_ < 1024 * 64; ++i_) ((float*)p.out)[i_ * 16] = 1e30f; }
    RP(17, peer_hq(c, p)); GSYNC();
    if (PROBE_PH == 26) peer_H3<1>(c, p);
    if (PROBE_PH == 27) peer_H3<2>(c, p);
    if (PROBE_PH == 28) peer_H3<3>(c, p);
    RP(18, peer_H4(c, p)); GSYNC();
    if (PROBE_PH == 19) peer_O2<1>(c, p);
    if (PROBE_PH == 22) peer_O2<2>(c, p);
    peer_O2<0>(c, p); GSYNC();
    peer_N(c, p);
    if (PROBE_PH == 15) { for (int r_ = 0; r_ < 10; ++r_) GSYNC(); }
}

extern "C" void kernel_launch(void* const* d_in, const int* in_sizes, int n_in, void* d_out, int out_size, void* d_ws, size_t ws_size, hipStream_t stream) {
    static int grid_blocks = 0;
    if (grid_blocks == 0) {
        if (n_in != 21 || out_size != T * D_MODEL || ws_size < WS_END) { fprintf(stderr, "kernel_launch: unexpected shapes n_in %d out %d ws %zu\n", n_in, out_size, ws_size); grid_blocks = -1; return; }
        int dev = 0, cus = 0, per_cu = 0;
        hipGetDevice(&dev); hipDeviceGetAttribute(&cus, hipDeviceAttributeMultiprocessorCount, dev);
        if (hipFuncSetAttribute((const void*)fwd_megakernel, hipFuncAttributeMaxDynamicSharedMemorySize, LDS_BYTES) != hipSuccess) { fprintf(stderr, "kernel_launch: hipFuncSetAttribute failed\n"); grid_blocks = -1; return; }
        if (hipOccupancyMaxActiveBlocksPerMultiprocessor(&per_cu, (const void*)fwd_megakernel, NT, LDS_BYTES) != hipSuccess || per_cu < 1) { fprintf(stderr, "kernel_launch: occupancy query failed (%d)\n", per_cu); grid_blocks = -1; return; }
        grid_blocks = cus * per_cu;
    }
    if (grid_blocks < 0) return;
    Params p{};
    p.x = (const float*)d_in[0]; p.pos = (const int*)d_in[1]; p.ln1_w = (const float*)d_in[2]; p.w_in = (const float*)d_in[3]; p.q_a_norm_w = (const float*)d_in[4];
    p.w_q_up = (const float*)d_in[5]; p.kv_a_norm_w = (const float*)d_in[6]; p.w_kv_up = (const float*)d_in[7]; p.conv_w = (const float*)d_in[8];
    p.a_log_f = (const float*)d_in[9]; p.dt_bias_f = (const float*)d_in[10]; p.a_log_b = (const float*)d_in[11]; p.dt_bias_b = (const float*)d_in[12];
    p.gdn_norm_w = (const float*)d_in[13]; p.w_out = (const float*)d_in[14]; p.ln2_w = (const float*)d_in[15]; p.peer_wq = (const float*)d_in[16];
    p.sub_keys = (const float*)d_in[17]; p.peer_u = (const float*)d_in[18]; p.peer_v = (const float*)d_in[19]; p.final_w = (const float*)d_in[20];
    p.out = (float*)d_out; p.ws = (unsigned char*)d_ws;
    if (hipMemsetAsync((char*)d_ws + OFF_BAR, 0, 16384, stream) != hipSuccess) { fprintf(stderr, "kernel_launch: memset of barrier words failed\n"); return; }
    void* args[] = {&p};
    hipError_t e = hipLaunchCooperativeKernel((const void*)fwd_megakernel, dim3(grid_blocks), dim3(NT), args, LDS_BYTES, stream);
    if (e != hipSuccess) fprintf(stderr, "cooperative launch failed: %s (grid %d)\n", hipGetErrorString(e), grid_blocks);
}
```

```cpp
#include <hip/hip_runtime.h>
#include <hip/hip_cooperative_groups.h>
#include <cstdio>
#include <cstdint>
namespace cg = cooperative_groups;

#ifndef PROBE_PH
#define PROBE_PH -1
#endif
constexpr int D_MODEL = 1024, BATCH = 2, SEQ = 8192, T = BATCH * SEQ;
constexpr int MLA_H = 4, QRANK = 256, KVRANK = 128, NOPE = 128, ROPE = 64, VDIM = 128, QKD = 192;
constexpr int GH = 4, DK = 128, DV = 128, CHUNK = 64, NCH = SEQ / CHUNK;
constexpr int GDN_QKV = 1536, IN_W = 2512, IN_WP = 2560;
constexpr int C_QKV = 448, C_Z = 1984, C_GATE = 2496;
constexpr int PH = 8, NKEYS = 128, TOPK = 16, NEXP = 16384;
constexpr float EPS = 1e-6f;
constexpr int NT = 512;

typedef unsigned short bf16_t;
typedef float f32x4 __attribute__((ext_vector_type(4)));
typedef unsigned u32x4 __attribute__((ext_vector_type(4)));
typedef unsigned u32x2 __attribute__((ext_vector_type(2)));

__device__ __forceinline__ int opaque_tid() { int t; asm volatile("v_mov_b32 %0, %1" : "=v"(t) : "v"((int)threadIdx.x)); return t; }
__device__ __forceinline__ float bf2f(bf16_t v) { return __uint_as_float((unsigned)v << 16); }
__device__ __forceinline__ bf16_t f2bf(float f) { unsigned u = __float_as_uint(f); u += 0x7fffu + ((u >> 16) & 1u); return (bf16_t)(u >> 16); }
__device__ __forceinline__ float bflo(unsigned w) { return __uint_as_float(w << 16); }
__device__ __forceinline__ float bfhi(unsigned w) { return __uint_as_float(w & 0xffff0000u); }
__device__ __forceinline__ unsigned pk2(float lo, float hi) { return (unsigned)f2bf(lo) | ((unsigned)f2bf(hi) << 16); }
__device__ __forceinline__ float wave_sum(float v) {
#pragma unroll
    for (int o = 1; o < 64; o <<= 1) v += __shfl_xor(v, o);
    return v;
}
__device__ __forceinline__ float sigmoidf_(float x) { return 1.f / (1.f + __expf(-x)); }
__device__ __forceinline__ float siluf_(float x) { return x * sigmoidf_(x); }
__device__ __forceinline__ float softplusf_(float x) { return x > 20.f ? x : log1pf(expf(x)); }
__device__ __forceinline__ float gelu_erf(float x) { return 0.5f * x * (1.f + erff(x * 0.70710678118654752f)); }

namespace pg8 {
#define PG8_LAS __attribute__((address_space(3)))
typedef unsigned short bf16_t;
typedef short bf16x8 __attribute__((ext_vector_type(8)));
typedef float f32x4 __attribute__((ext_vector_type(4)));
typedef unsigned u32x4 __attribute__((ext_vector_type(4)));
constexpr int BM = 256, BK = 64, HALF = 128, HTB = HALF * BK * 2  , STAGE_BYTES = 8 * HTB, NXCD = 8, WGM = 8;

__host__ __device__ __forceinline__ int lds_byte(int r, int c) { const int st = (r >> 4) * 2 + (c >> 5), rr = r & 15, cc = c & 31, ob = rr * 64 + cc * 2; return st * 1024 + (ob ^ (((ob >> 9) & 1) << 5)); }
__host__ __device__ __forceinline__ void stage_rc(int b, int& R, int& C) { const int st = b / 1024, sb = b % 1024, swz = sb ^ (((sb >> 9) & 1) << 5); R = (st >> 1) * 16 + swz / 64; C = (st & 1) * 32 + (swz % 64) / 2; }
__host__ __device__ __forceinline__ int perm32(int rho) { const int n = rho >> 4, i = rho & 15; return 8 * (i >> 2) + 4 * n + (i & 3); }

struct Unit { int pm, pn; };
struct Gemm { const bf16_t* A; const bf16_t* Bt; int M, N, K, lda, ldb; };

struct StaticOrder {
    int nM, nN, nwg, G, c;
    __host__ __device__ void init(int M, int N, int G_, int c_) { nM = M / BM; nN = N / BM; nwg = nM * nN; G = G_; c = c_; }
    __host__ __device__ bool next(int i, Unit& u) const {
        const long L = (long)i * G + c; if (L >= nwg) return false;
        int wgid = (int)L; { const int q = nwg / NXCD, r = nwg % NXCD, xcd = wgid % NXCD, off = wgid / NXCD; wgid = (xcd < r ? xcd * (q + 1) : r * (q + 1) + (xcd - r) * q) + off; }
        const int nig = WGM * nN, gid = wgid / nig, fm = gid * WGM, gsz = (nM - fm) < WGM ? (nM - fm) : WGM;
        u.pm = fm + ((wgid % nig) % gsz); u.pn = (wgid % nig) / gsz; return true;
    }
    __device__ __forceinline__ void a_ready(const Unit&) const {}
    __device__ __forceinline__ void done(const Unit&) const {}
};
__device__ __forceinline__ unsigned cvt_pk_bf16(float lo, float hi) { unsigned r; asm volatile("v_cvt_pk_bf16_f32 %0, %1, %2" : "=v"(r) : "v"(lo), "v"(hi)); return r; }
typedef float f32x2 __attribute__((ext_vector_type(2)));
template <class Epi, class Sched, bool ALIGN_EPI = false, bool SP2 = false>
__device__ __forceinline__ void gemm_phase(PG8_LAS unsigned char* lds, const Gemm g, const Sched& S, const Epi& E) {
    const int tid = opaque_tid(), wid = __builtin_amdgcn_readfirstlane(tid >> 6), lane = tid & 63, wr = wid >> 2, wc = wid & 3, fr = lane & 15, fq = lane >> 4;
    const int K = g.K, nt = K / BK;
    unsigned voffA[2], voffB[2];
#pragma unroll
    for (int i = 0; i < 2; ++i) { int R, C; stage_rc(tid * 16 + i * 8192, R, C); const int Rb = Epi::PERM ? ((R & ~31) + perm32(R & 31)) : R;
        voffA[i] = (unsigned)(R * g.lda + C) * 2u; voffB[i] = (unsigned)(Rb * g.ldb + C) * 2u; }
    const size_t kstep = (size_t)(BK * 2);
    const size_t hstepA = (size_t)HALF * g.lda * 2, hstepB = (size_t)HALF * g.ldb * 2;
    const size_t tstepA = 2 * hstepA, tstepB = 2 * hstepB;
    const unsigned ldsw = (unsigned)wid * 1024u;
    const int aoff = lds_byte(wr * 64 + fr, fq * 8), boff = lds_byte(wc * 32 + fr, fq * 8);
#define PG8_SA(b, h) (((b) * 2 + (h)) * HTB)
#define PG8_SB(b, h) ((4 + (b) * 2 + (h)) * HTB)
#define PG8_STAGE(bufoff, gbase, voff) do { _Pragma("unroll") for (int _i = 0; _i < 2; ++_i) \
        __builtin_amdgcn_global_load_lds((const unsigned*)((const char*)(gbase) + (voff)[_i]), (PG8_LAS unsigned*)(lds + (bufoff) + ldsw + _i * 8192), 16, 0, 0); } while (0)
#define PG8_LDA(dst, b, h) do { _Pragma("unroll") for (int m = 0; m < 4; ++m) _Pragma("unroll") for (int k = 0; k < 2; ++k) dst[m][k] = *(const PG8_LAS bf16x8*)(lds + PG8_SA(b, h) + aoff + m * 2048 + k * 1024); } while (0)
#define PG8_LDB(dst, b, h) do { _Pragma("unroll") for (int n = 0; n < 2; ++n) _Pragma("unroll") for (int k = 0; k < 2; ++k) dst[n][k] = *(const PG8_LAS bf16x8*)(lds + PG8_SB(b, h) + boff + n * 2048 + k * 1024); } while (0)
#define PG8_MMA(ai, bj, At, Bt) do { __builtin_amdgcn_s_setprio(1); _Pragma("unroll") for (int m = 0; m < 4; ++m) _Pragma("unroll") for (int n = 0; n < 2; ++n) _Pragma("unroll") for (int k = 0; k < 2; ++k) \
        acc[ai][bj][m][n] = __builtin_amdgcn_mfma_f32_16x16x32_bf16(Bt[n][k], At[m][k], acc[ai][bj][m][n], 0, 0, 0); __builtin_amdgcn_s_setprio(0); } while (0)
#define PG8_WAIT_V(n) asm volatile("s_waitcnt vmcnt(" #n ")" ::: "memory")
#define PG8_WAIT_L(n) asm volatile("s_waitcnt lgkmcnt(" #n ")" ::: "memory")
#define PG8_BAR __builtin_amdgcn_s_barrier()
#define PG8_SCHED __builtin_amdgcn_sched_barrier(0)
    Unit cur, nxt; int ui = 0;
    if (!S.next(0, cur)) return;
    f32x4 acc[2][2][4][2];
#pragma unroll
    for (int a = 0; a < 2; ++a)
#pragma unroll
        for (int b = 0; b < 2; ++b)
#pragma unroll
            for (int m = 0; m < 4; ++m)
#pragma unroll
                for (int n = 0; n < 2; ++n) acc[a][b][m][n] = (f32x4){0.f, 0.f, 0.f, 0.f};
    bf16x8 At[4][2], B0[2][2], B1[2][2];
    const char* cA = (const char*)g.A + (size_t)cur.pm * tstepA; const char* cB = (const char*)g.Bt + (size_t)cur.pn * tstepB;
    S.a_ready(cur);
    if constexpr (SP2) {
        PG8_STAGE(PG8_SB(0, 0), cB, voffB); PG8_STAGE(PG8_SB(0, 1), cB + hstepB, voffB); PG8_STAGE(PG8_SA(0, 0), cA, voffA); PG8_STAGE(PG8_SA(0, 1), cA + hstepA, voffA);
        if (wr == 1) PG8_BAR;
        PG8_WAIT_V(2); PG8_BAR;
        PG8_STAGE(PG8_SB(1, 0), cB + kstep, voffB); PG8_STAGE(PG8_SA(1, 0), cA + kstep, voffA); PG8_STAGE(PG8_SB(1, 1), cB + hstepB + kstep, voffB);
        PG8_WAIT_V(6); PG8_BAR;
    } else {
        PG8_STAGE(PG8_SB(0, 0), cB, voffB); PG8_STAGE(PG8_SA(0, 0), cA, voffA); PG8_STAGE(PG8_SB(0, 1), cB + hstepB, voffB); PG8_STAGE(PG8_SA(0, 1), cA + hstepA, voffA);
        if (wr == 1) PG8_BAR;
        PG8_WAIT_V(4); PG8_BAR;
        PG8_STAGE(PG8_SB(1, 0), cB + kstep, voffB); PG8_STAGE(PG8_SA(1, 0), cA + kstep, voffA); PG8_STAGE(PG8_SB(1, 1), cB + hstepB + kstep, voffB);
        PG8_WAIT_V(6); PG8_BAR;
    }
    for (;;) {
        const bool has_next = S.next(ui + 1, nxt);
        const char* nA = has_next ? (const char*)g.A + (size_t)nxt.pm * tstepA : cA; const char* nB = has_next ? (const char*)g.Bt + (size_t)nxt.pn * tstepB : cB;
        for (int t = 0; t < nt; t += 2) {
            const bool last = (t == nt - 2);
            const char* a1 = cA + (size_t)(t + 1) * kstep;
            const char* a2 = last ? nA : cA + (size_t)(t + 2) * kstep; const char* b2 = last ? nB : cB + (size_t)(t + 2) * kstep;
            const char* a3 = a2 + kstep; const char* b3 = b2 + kstep;
            if (last && has_next) S.a_ready(nxt);
            if constexpr (SP2) {
            PG8_LDB(B0, 0, 0); PG8_LDB(B1, 0, 1); PG8_SCHED; PG8_LDA(At, 0, 0); PG8_STAGE(PG8_SA(1, 1), a1 + hstepA, voffA);
            PG8_WAIT_V(8); PG8_WAIT_L(0); PG8_BAR; PG8_MMA(0, 0, At, B0); PG8_MMA(0, 1, At, B1); PG8_BAR; PG8_SCHED;
            PG8_LDA(At, 0, 1); PG8_STAGE(PG8_SB(0, 0), b2, voffB); PG8_STAGE(PG8_SB(0, 1), b2 + hstepB, voffB); PG8_STAGE(PG8_SA(0, 0), a2, voffA);
            PG8_WAIT_V(8); PG8_WAIT_L(0); PG8_BAR; PG8_MMA(1, 0, At, B0); PG8_MMA(1, 1, At, B1); PG8_BAR; PG8_SCHED;
            PG8_LDB(B0, 1, 0); PG8_LDB(B1, 1, 1); PG8_SCHED; PG8_LDA(At, 1, 0); PG8_STAGE(PG8_SA(0, 1), a2 + hstepA, voffA);
            PG8_WAIT_V(8); PG8_WAIT_L(0); PG8_BAR; PG8_MMA(0, 0, At, B0); PG8_MMA(0, 1, At, B1); PG8_BAR; PG8_SCHED;
            PG8_LDA(At, 1, 1); PG8_STAGE(PG8_SB(1, 0), b3, voffB); PG8_STAGE(PG8_SB(1, 1), b3 + hstepB, voffB); PG8_STAGE(PG8_SA(1, 0), a3, voffA);
            PG8_WAIT_V(8); PG8_WAIT_L(0); PG8_BAR; PG8_MMA(1, 0, At, B0); PG8_MMA(1, 1, At, B1); PG8_BAR; PG8_SCHED;
            } else {
            PG8_LDB(B0, 0, 0); PG8_SCHED; PG8_LDA(At, 0, 0); PG8_STAGE(PG8_SA(1, 1), a1 + hstepA, voffA);
            PG8_WAIT_L(8); PG8_BAR; PG8_WAIT_L(0); PG8_MMA(0, 0, At, B0); PG8_BAR; PG8_SCHED;
            PG8_LDB(B1, 0, 1); PG8_STAGE(PG8_SB(0, 0), b2, voffB);
            PG8_BAR; PG8_WAIT_L(0); PG8_MMA(0, 1, At, B1); PG8_BAR;
            PG8_LDA(At, 0, 1); PG8_STAGE(PG8_SA(0, 0), a2, voffA);
            PG8_BAR; PG8_WAIT_L(0); PG8_MMA(1, 0, At, B0); PG8_BAR; PG8_SCHED;
            PG8_STAGE(PG8_SB(0, 1), b2 + hstepB, voffB);
            PG8_WAIT_V(6); PG8_BAR; PG8_MMA(1, 1, At, B1); PG8_BAR;
            PG8_LDB(B0, 1, 0); PG8_SCHED; PG8_LDA(At, 1, 0); PG8_STAGE(PG8_SA(0, 1), a2 + hstepA, voffA);
            PG8_WAIT_L(8); PG8_BAR; PG8_WAIT_L(0); PG8_MMA(0, 0, At, B0); PG8_BAR; PG8_SCHED;
            PG8_LDB(B1, 1, 1); PG8_STAGE(PG8_SB(1, 0), b3, voffB);
            PG8_BAR; PG8_WAIT_L(0); PG8_MMA(0, 1, At, B1); PG8_BAR;
            PG8_LDA(At, 1, 1); PG8_STAGE(PG8_SA(1, 0), a3, voffA);
            PG8_BAR; PG8_WAIT_L(0); PG8_MMA(1, 0, At, B0); PG8_BAR; PG8_SCHED;
            PG8_STAGE(PG8_SB(1, 1), b3 + hstepB, voffB);
            PG8_WAIT_V(6); PG8_BAR; PG8_MMA(1, 1, At, B1); PG8_BAR;
            }
        }
        if constexpr (ALIGN_EPI) { if (wr == 0) PG8_BAR; }
        if constexpr (!Epi::AFTER_DRAIN) { E(acc, cur, wr, wc, fr, fq); S.done(cur); }
        if (!has_next) break;
#pragma unroll
        for (int a = 0; a < 2; ++a)
#pragma unroll
            for (int b = 0; b < 2; ++b)
#pragma unroll
                for (int m = 0; m < 4; ++m)
#pragma unroll
                    for (int n = 0; n < 2; ++n) acc[a][b][m][n] = (f32x4){0.f, 0.f, 0.f, 0.f};
        cur = nxt; cA = nA; cB = nB; ++ui;
        if constexpr (ALIGN_EPI) { if (wr == 1) PG8_BAR; }
    }
    PG8_WAIT_V(0);
    if constexpr (!ALIGN_EPI) { if (wr == 0) PG8_BAR; }
    PG8_BAR;
    if constexpr (Epi::AFTER_DRAIN) { E.fused(acc, cur, wr, wc, fr, fq, lds, wid, lane); S.done(cur); }
#undef PG8_SA
#undef PG8_SB
#undef PG8_STAGE
#undef PG8_LDA
#undef PG8_LDB
#undef PG8_MMA
#undef PG8_WAIT_V
#undef PG8_WAIT_L
#undef PG8_BAR
#undef PG8_SCHED
}

struct EpiScaleBf16 {
    static constexpr bool PERM = true, AFTER_DRAIN = false;
    bf16_t* O; int ldc; const float* rs;
    __device__ __forceinline__ void operator()(const f32x4 (&acc)[2][2][4][2], const Unit& u, int wr, int wc, int fr, int fq) const {
        const int row0 = u.pm * BM + wr * 64 + fr, col0 = u.pn * BM + wc * 32 + 8 * fq;
#pragma unroll
        for (int ai = 0; ai < 2; ++ai)
#pragma unroll
            for (int m = 0; m < 4; ++m) { const int r = row0 + ai * HALF + m * 16; const float sc = rs ? rs[r] : 1.f; bf16_t* rowp = O + (size_t)r * ldc + col0;
#pragma unroll
                for (int bj = 0; bj < 2; ++bj) { const f32x4 v0 = acc[ai][bj][m][0] * sc, v1 = acc[ai][bj][m][1] * sc;
                    u32x4 w; w.x = cvt_pk_bf16(v0[0], v0[1]); w.y = cvt_pk_bf16(v0[2], v0[3]); w.z = cvt_pk_bf16(v1[0], v1[1]); w.w = cvt_pk_bf16(v1[2], v1[3]);
                    *(u32x4*)(rowp + bj * HALF) = w; } }
    }
};
struct EpiResF32 {
    static constexpr bool PERM = false, AFTER_DRAIN = false;
    const float* base; float* out; int ldc;
    __device__ __forceinline__ void operator()(const f32x4 (&acc)[2][2][4][2], const Unit& u, int wr, int wc, int fr, int fq) const {
        const int row0 = u.pm * BM + wr * 64 + fr, col0 = u.pn * BM + wc * 32 + 4 * fq;
#pragma unroll
        for (int ai = 0; ai < 2; ++ai)
#pragma unroll
            for (int m = 0; m < 4; ++m) { const size_t off = (size_t)(row0 + ai * HALF + m * 16) * ldc + col0;
#pragma unroll
                for (int bj = 0; bj < 2; ++bj)
#pragma unroll
                    for (int n = 0; n < 2; ++n) { const f32x4 b = *(const f32x4*)(base + off + bj * HALF + n * 16); *(f32x4*)(out + off + bj * HALF + n * 16) = b + acc[ai][bj][m][n]; } }
    }
};
struct EpiResF32Hb {
    static constexpr bool PERM = false, AFTER_DRAIN = false;
    const float* base; float* out; bf16_t* hb; float* sumsq; int ldc;
    __device__ __forceinline__ void operator()(const f32x4 (&acc)[2][2][4][2], const Unit& u, int wr, int wc, int fr, int fq) const {
        const int row0 = u.pm * BM + wr * 64 + fr, col0 = u.pn * BM + wc * 32 + 4 * fq;
#pragma unroll
        for (int ai = 0; ai < 2; ++ai)
#pragma unroll
            for (int m = 0; m < 4; ++m) { const int r = row0 + ai * HALF + m * 16; const size_t off = (size_t)r * ldc + col0; float ss = 0.f;
#pragma unroll
                for (int bj = 0; bj < 2; ++bj)
#pragma unroll
                    for (int n = 0; n < 2; ++n) { const f32x4 o = *(const f32x4*)(base + off + bj * HALF + n * 16) + acc[ai][bj][m][n];
                        ss += o[0] * o[0] + o[1] * o[1] + o[2] * o[2] + o[3] * o[3];
                        typedef unsigned u32x2v __attribute__((ext_vector_type(2))); u32x2v w; w.x = cvt_pk_bf16(o[0], o[1]); w.y = cvt_pk_bf16(o[2], o[3]);
                        *(u32x2v*)(hb + off + bj * HALF + n * 16) = w; }
                ss += __shfl_xor(ss, 16); ss += __shfl_xor(ss, 32);
                if (fq == 0) unsafeAtomicAdd(sumsq + r, ss); }
    }
};
}

#define XB_TMO      128
#define XB_XCNT(j)  (256  + 64 * (j))
#define XB_XSUB(j)  (1280 + 64 * (j))
#define XB_XGEN(j)  (2304 + 64 * (j))
#define XB_TOP      3328
#define XB_TOPGEN   3392
#define XCD_BAR_WORDS 3456
#define XB_SPIN_CAP (1u << 18)
#define LAS __attribute__((address_space(3)))

__device__ __forceinline__ unsigned xb_ld(unsigned* p)              { return __hip_atomic_load(p, __ATOMIC_RELAXED, __HIP_MEMORY_SCOPE_AGENT); }
__device__ __forceinline__ unsigned xb_add(unsigned* p, unsigned v) { return __hip_atomic_fetch_add(p, v, __ATOMIC_RELAXED, __HIP_MEMORY_SCOPE_AGENT); }
__device__ __forceinline__ unsigned xb_xcc_id() { return (unsigned)__builtin_amdgcn_s_getreg((3 << 11) | 20) & 0xFu; }
#define XB_SPIN(cond, bar) do { unsigned _sp = 0; while (cond) { __builtin_amdgcn_s_sleep(1); \
    if ((++_sp & 255u) == 0u) { if (xb_ld(&(bar)[XB_TMO])) break; if (_sp > XB_SPIN_CAP) { atomicAdd(&(bar)[XB_TMO], 1u); break; } } } } while (0)

struct XcdBarrier {
    unsigned* bar; unsigned x;
    volatile LAS unsigned* st;
};

__device__ __forceinline__ XcdBarrier xcd_barrier_post(unsigned* bar, volatile LAS unsigned* st) {
    XcdBarrier b; b.bar = bar; b.x = xb_xcc_id(); b.st = st;
    if (threadIdx.x == 0) (void)xb_add(&bar[XB_XCNT(b.x)], 1u);
    return b;
}
__device__ __forceinline__ void xcd_barrier_complete(unsigned* bar, unsigned x, unsigned& nloc, unsigned& nx) {
    const unsigned G = gridDim.x * gridDim.y * gridDim.z;
    unsigned sum, cnt, mine, sp = 0u;
    for (;;) {
        sum = 0u; cnt = 0u; mine = 0u;
#pragma unroll
        for (unsigned j = 0; j < 16; ++j) { const unsigned c = xb_ld(&bar[XB_XCNT(j)]); sum += c; cnt += (c > 0u) ? 1u : 0u; mine = (j == x) ? c : mine; }
        if (sum == G) break;
        __builtin_amdgcn_s_sleep(1);
        if ((++sp & 255u) == 0u) { if (xb_ld(&bar[XB_TMO])) break; if (sp > XB_SPIN_CAP) { atomicAdd(&bar[XB_TMO], 1u); break; } }
    }
    nloc = mine > 0u ? mine : 1u; nx = cnt > 0u ? cnt : 1u;
}

__device__ __forceinline__ void xcd_barrier(const XcdBarrier& b) {
    asm volatile("s_waitcnt vmcnt(0)" ::: "memory");
    __syncthreads();
    if (threadIdx.x == 0) {
        unsigned* bar = b.bar;
        __builtin_amdgcn_s_waitcnt(0);
        unsigned nloc = b.st[0], nx = b.st[1];
        if (nloc == 0u) { xcd_barrier_complete(bar, b.x, nloc, nx); b.st[0] = nloc; b.st[1] = nx; }
        const unsigned old = xb_add(&bar[XB_XSUB(b.x)], 1u);
        const unsigned gen = old / nloc;
        if (old + 1u == (gen + 1u) * nloc) {
            __builtin_amdgcn_fence(__ATOMIC_RELEASE, "agent");
            asm volatile("s_waitcnt vmcnt(0)" ::: "memory");
            const unsigned og = xb_add(&bar[XB_TOP], 1u);
            const unsigned tg = og / nx;
            if (og + 1u == (tg + 1u) * nx) xb_add(&bar[XB_TOPGEN], 1u);
            else XB_SPIN(xb_ld(&bar[XB_TOPGEN]) == tg, bar);
            __builtin_amdgcn_fence(__ATOMIC_ACQUIRE, "agent");
            xb_add(&bar[XB_XGEN(b.x)], 1u);
            asm volatile("s_waitcnt vmcnt(0)" ::: "memory");
        } else {
            XB_SPIN(xb_ld(&bar[XB_XGEN(b.x)]) == gen, bar);
            __builtin_amdgcn_fence(__ATOMIC_ACQUIRE, "agent");
            asm volatile("s_waitcnt vmcnt(0)" ::: "memory");
        }
    }
    __syncthreads();
}

constexpr size_t MB = 1u << 20;
constexpr size_t OFF_WIN = 0;
constexpr size_t OFF_WQUP = 5 * MB;
constexpr size_t OFF_WKVUP = 5 * MB + 512 * 1024;
constexpr size_t OFF_WOUT = 6 * MB;
constexpr size_t OFF_WPQ = 8 * MB;
constexpr size_t OFF_SUBK = 12 * MB;
constexpr size_t OFF_VEC = 12 * MB + 512 * 1024;
constexpr size_t OFF_SU = OFF_VEC + 4 * (size_t)T * 4, OFF_SV = OFF_SU + (size_t)NEXP * 4, OFF_SH = OFF_SV + (size_t)NEXP * 4;
constexpr size_t OFF_GATE = 13 * MB;
constexpr size_t OFF_BAR = 15 * MB;
constexpr size_t OFF_R1 = 16 * MB;
constexpr size_t OFF_R2 = 96 * MB;
constexpr size_t OFF_R3 = 160 * MB;
constexpr size_t OFF_R4 = 192 * MB;
constexpr size_t OFF_R5 = 208 * MB;
constexpr size_t WS_END = 256 * MB;

struct Params {
    const float* x; const int* pos; const float *ln1_w, *w_in, *q_a_norm_w, *w_q_up, *kv_a_norm_w, *w_kv_up, *conv_w, *a_log_f, *dt_bias_f, *a_log_b,
        *dt_bias_b, *gdn_norm_w, *w_out, *ln2_w, *peer_wq, *sub_keys, *peer_u, *peer_v, *final_w;
    float* out; unsigned char* ws;
};

struct Ctx {
    int tid, lane, wave, bid, nb, gw, ngw;
    float* lds;
};

#define LDS3 ((PG8_LAS unsigned char*)c.lds)
__device__ __forceinline__ void gemm_scale_bf16(const Ctx& c, const bf16_t* A, int lda, const bf16_t* Bt, int ldb, int N, int K, bf16_t* O, int ldc, const float* rs) {
    pg8::Gemm g{A, Bt, T, N, K, lda, ldb}; pg8::StaticOrder S; S.init(T, N, c.nb, c.bid);
    pg8::EpiScaleBf16 E{O, ldc, rs};
    pg8::gemm_phase<pg8::EpiScaleBf16, pg8::StaticOrder, true, true>(LDS3, g, S, E);
}
__device__ __forceinline__ void ph1_mfma(const Ctx& c, const Params& p) {
    gemm_scale_bf16(c, (const bf16_t*)(p.ws + OFF_R2), 1024, (const bf16_t*)(p.ws + OFF_WIN), 1024, IN_WP, 1024, (bf16_t*)(p.ws + OFF_R1), IN_WP, nullptr);
}
__device__ __forceinline__ void ph2a2_v2(const Ctx& c, const Params& p) {
    const bf16_t* proj = (const bf16_t*)(p.ws + OFF_R1);
    gemm_scale_bf16(c, proj, IN_WP, (const bf16_t*)(p.ws + OFF_WQUP), 256, 768, 256, (bf16_t*)(p.ws + OFF_R5), 768, nullptr);
    gemm_scale_bf16(c, proj + 256, IN_WP, (const bf16_t*)(p.ws + OFF_WKVUP), 256, 1024, 256, (bf16_t*)(p.ws + OFF_R3), 1024, nullptr);
}
__device__ __forceinline__ void ph4b_v2(const Ctx& c, const Params& p) {
    pg8::Gemm g{(const bf16_t*)(p.ws + OFF_R1), (const bf16_t*)(p.ws + OFF_WOUT), T, 1024, 1024, 1024, 1024}; pg8::StaticOrder S; S.init(T, 1024, c.nb, c.bid);
    pg8::EpiResF32Hb E{p.x, p.out, (bf16_t*)(p.ws + OFF_R3), (float*)(p.ws + OFF_SH), 1024};
    pg8::gemm_phase<pg8::EpiResF32Hb, pg8::StaticOrder, true, true>(LDS3, g, S, E);
}
__device__ __forceinline__ void ph5_v2(const Ctx& c, const Params& p) {
    gemm_scale_bf16(c, (const bf16_t*)(p.ws + OFF_R3), 1024, (const bf16_t*)(p.ws + OFF_WPQ), 1024, 2048, 1024, (bf16_t*)(p.ws + OFF_R2), 2048, nullptr);
}

namespace attn {
constexpr int SDEPTH = 1;
constexpr int NW = 8, QBLK = 32, KVBLK = 64, LDQ = 192, LDK = 192, LDV = 128, LDO = 512;
constexpr float SCALE = 0.07216878364870322f;
constexpr float THR = 8.f;
constexpr size_t SHM_V = KVBLK * 128 * 2, SHM_K = KVBLK * 192 * 2, SHM_ATTN = 2 * SHM_V + 2 * SHM_K + NW * 64 * 4 + NW * 6144;
constexpr int QREG = 6;
using bf16 = unsigned short;
using bf16x8 = __attribute__((ext_vector_type(8))) short;
using s16x4  = __attribute__((ext_vector_type(4))) short;
using f32x16 = __attribute__((ext_vector_type(16))) float;
using f32x8  = __attribute__((ext_vector_type(8))) float;
using u32x4a = __attribute__((ext_vector_type(4))) unsigned;
#define KSWZ(row, colB) ((row) * 384 + ((colB) ^ ((((row) >> 1) & 7) << 4)))
#define SBAR() __builtin_amdgcn_sched_barrier(0)
__device__ __forceinline__ int crow(int r, int hi) { return (r & 3) + 8 * (r >> 2) + 4 * hi; }
__device__ __forceinline__ unsigned cvtpk(float lo, float hi) {
  unsigned r; asm volatile("v_cvt_pk_bf16_f32 %0, %1, %2" : "=v"(r) : "v"(lo), "v"(hi)); return r;
}
__device__ __forceinline__ void partialSM(f32x16& p0, f32x16& p1, float& m_reg, float& mn, float& alpha) {
  constexpr float C = SCALE * 1.4426950408889634f;
  float pmax = p0[0]; for (int r = 1; r < 16; ++r) pmax = fmaxf(pmax, p0[r]); for (int r = 0; r < 16; ++r) pmax = fmaxf(pmax, p1[r]);
  { auto rr = __builtin_amdgcn_permlane32_swap(__float_as_uint(pmax), __float_as_uint(pmax), false, false);
    pmax = fmaxf(__uint_as_float(rr[0]), __uint_as_float(rr[1])); }
  if (__builtin_expect(__all(pmax - m_reg <= THR / SCALE), 1)) { mn = m_reg; alpha = 1.f; }
  else { mn = fmaxf(m_reg, pmax); alpha = __builtin_amdgcn_exp2f((m_reg - mn) * C); m_reg = mn; }
  float mnC = -mn * C;
  for (int r = 0; r < 16; ++r) p0[r] = fmaf(p0[r], C, mnC); for (int r = 0; r < 16; ++r) p1[r] = fmaf(p1[r], C, mnC);
  for (int r = 0; r < 16; ++r) p0[r] = __builtin_amdgcn_exp2f(p0[r]);
}
__device__ __forceinline__ void finishSM(f32x16& p0, f32x16& p1, float alpha, float& l_reg, bf16x8& pa0, bf16x8& pa1, bf16x8& pa2, bf16x8& pa3) {
  for (int r = 0; r < 16; ++r) p1[r] = __builtin_amdgcn_exp2f(p1[r]);
  float ps = 0; for (int r = 0; r < 16; ++r) ps += p0[r]; for (int r = 0; r < 16; ++r) ps += p1[r];
  { auto rr = __builtin_amdgcn_permlane32_swap(__float_as_uint(ps), __float_as_uint(ps), false, false);
    ps = __uint_as_float(rr[0]) + __uint_as_float(rr[1]); }
  l_reg = l_reg * alpha + ps;
#define PK4(P, BASE, OUT) do { unsigned a0 = cvtpk(P[BASE + 0], P[BASE + 1]), a1 = cvtpk(P[BASE + 2], P[BASE + 3]);   \
    unsigned b0 = cvtpk(P[BASE + 4], P[BASE + 5]), b1 = cvtpk(P[BASE + 6], P[BASE + 7]);                              \
    auto r0 = __builtin_amdgcn_permlane32_swap(a0, b0, false, false); auto r1 = __builtin_amdgcn_permlane32_swap(a1, b1, false, false); \
    u32x4a w = {r0[0], r1[0], r0[1], r1[1]}; OUT = *reinterpret_cast<bf16x8*>(&w); } while (0)
  PK4(p0, 0, pa0); PK4(p0, 8, pa1); PK4(p1, 0, pa2); PK4(p1, 8, pa3);
#undef PK4
}
__device__ __forceinline__ void qkt(f32x16& p0, f32x16& p1, const bf16* Ks, const bf16x8* qr, const bf16x8* qro, int r32, int hi) {
  p0 = f32x16{}; p1 = f32x16{};
  for (int d0 = 0; d0 < 12; ++d0) { int cb = (d0 * 16 + hi * 8) * 2;
    bf16x8 b0 = *reinterpret_cast<const bf16x8*>((const char*)Ks + KSWZ(r32, cb));
    bf16x8 b1 = *reinterpret_cast<const bf16x8*>((const char*)Ks + KSWZ(32 + r32, cb));
    const bf16x8 qf = d0 < QREG ? qr[d0 < QREG ? d0 : 0] : qro[(d0 - QREG) * 64];
    p0 = __builtin_amdgcn_mfma_f32_32x32x16_bf16(b0, qf, p0, 0, 0, 0);
    p1 = __builtin_amdgcn_mfma_f32_32x32x16_bf16(b1, qf, p1, 0, 0, 0); }
}
__device__ __forceinline__ int v_st(int k, int c) { const int kk = (k & ~0xC) | ((k & 4) << 1) | ((k & 8) >> 1); return ((kk >> 3) * 4 + (c >> 5)) * 512 + ((kk & 7) * 32 + (c & 31)) * 2; }
__device__ __forceinline__ int v_rd_base(int lane) { return ((lane & 3) << 3) | (((lane >> 2) & 3) << 6) | (((lane >> 4) & 1) << 5) | (((lane >> 5) & 1) << 8); }
constexpr int v_rd_off(int d0, int ks, int half) { return d0 * 512 + ks * 4096 + half * 2048; }
template <int OFF> __device__ __forceinline__ s16x4 tr_read(int vb) {
  s16x4 r; asm volatile("ds_read_b64_tr_b16 %0, %1 offset:%2" : "=&v"(r) : "v"(vb), "i"(OFF) : "memory"); return r;
}
template <int D0> __device__ __forceinline__ void pv_one(f32x16& od, int vb, bf16x8 pa0, bf16x8 pa1, bf16x8 pa2, bf16x8 pa3) {
  const s16x4 l0 = tr_read<v_rd_off(D0, 0, 0)>(vb), h0 = tr_read<v_rd_off(D0, 0, 1)>(vb), l1 = tr_read<v_rd_off(D0, 1, 0)>(vb), h1 = tr_read<v_rd_off(D0, 1, 1)>(vb);
  const s16x4 l2 = tr_read<v_rd_off(D0, 2, 0)>(vb), h2 = tr_read<v_rd_off(D0, 2, 1)>(vb), l3 = tr_read<v_rd_off(D0, 3, 0)>(vb), h3 = tr_read<v_rd_off(D0, 3, 1)>(vb);
  asm volatile("s_waitcnt lgkmcnt(0)" ::: "memory"); SBAR();
#define PK(L, H) (bf16x8){L[0], L[1], L[2], L[3], H[0], H[1], H[2], H[3]}
  od = __builtin_amdgcn_mfma_f32_32x32x16_bf16(pa0, PK(l0, h0), od, 0, 0, 0);
  od = __builtin_amdgcn_mfma_f32_32x32x16_bf16(pa1, PK(l1, h1), od, 0, 0, 0);
  od = __builtin_amdgcn_mfma_f32_32x32x16_bf16(pa2, PK(l2, h2), od, 0, 0, 0);
  od = __builtin_amdgcn_mfma_f32_32x32x16_bf16(pa3, PK(l3, h3), od, 0, 0, 0);
#undef PK
}
__device__ __forceinline__ void pv_d0(f32x16* o, int vb, bf16x8 pa0, bf16x8 pa1, bf16x8 pa2, bf16x8 pa3) {
  pv_one<0>(o[0], vb, pa0, pa1, pa2, pa3); pv_one<1>(o[1], vb, pa0, pa1, pa2, pa3); pv_one<2>(o[2], vb, pa0, pa1, pa2, pa3); pv_one<3>(o[3], vb, pa0, pa1, pa2, pa3);
}


template <bool PARTIAL>
__device__ __forceinline__ void attn_dense_body(const bf16* __restrict__ Qb, const bf16* __restrict__ Kh, const bf16* __restrict__ Vh,
                                                bf16* __restrict__ Ob, int seq, char* lds, float* __restrict__ ML = nullptr) {
  const int tid = opaque_tid(), wid = __builtin_amdgcn_readfirstlane(tid >> 6), lane = tid & 63, r32 = lane & 31, hi = lane >> 5;
  bf16* V_lds = (bf16*)lds; bf16* K_lds = (bf16*)(lds + 2 * SHM_V);
  float* ws = (float*)(lds + 2 * SHM_V + 2 * SHM_K) + wid * 64; float* li_l = ws; float* al_l = ws + 32;
  float m_reg = -1e30f, l_reg = 0; f32x16 o[4] = {}; bf16x8 qr[QREG];
  const bf16* Qw = Qb + (long)(wid * QBLK + r32) * LDQ + hi * 8;
#pragma unroll
  for (int d0 = 0; d0 < QREG; ++d0) qr[d0] = *reinterpret_cast<const bf16x8*>(Qw + d0 * 16);
  bf16x8* qro = (bf16x8*)(lds + 2 * SHM_V + 2 * SHM_K + NW * 64 * 4) + wid * 384 + lane;
#pragma unroll
  for (int d0 = QREG; d0 < 12; ++d0) qro[(d0 - QREG) * 64] = *reinterpret_cast<const bf16x8*>(Qw + d0 * 16);
  const int sr = tid >> 4, sc = (tid & 15) * 8, vst0 = v_st(sr, sc), vst1 = v_st(32 + sr, sc);
  const int vb0 = (int)(uintptr_t)V_lds + v_rd_base(lane);
  const int kr0 = tid / 24, kc0 = (tid % 24) * 16, kr1 = (tid + 512) / 24, kc1 = ((tid + 512) % 24) * 16, kr2 = (tid + 1024) / 24, kc2 = ((tid + 1024) % 24) * 16;
  const int kst0 = KSWZ(kr0, kc0), kst1 = KSWZ(kr1, kc1), kst2 = KSWZ(kr2, kc2);
  struct { bf16x8 vs0, vs1, ks0, ks1, ks2; } sr_[SDEPTH];
#define SLOAD(i, k0) do { sr_[i].vs0 = *(const bf16x8*)(&Vh[(long)((k0) + sr) * LDV + sc]); sr_[i].vs1 = *(const bf16x8*)(&Vh[(long)((k0) + 32 + sr) * LDV + sc]); \
    const bf16* kt_ = Kh + (long)(k0) * LDK + tid * 8; sr_[i].ks0 = *(const bf16x8*)(kt_); sr_[i].ks1 = *(const bf16x8*)(kt_ + 4096); sr_[i].ks2 = *(const bf16x8*)(kt_ + 8192); } while (0)
#define SWRITE(b, i) do { *(bf16x8*)((char*)V_lds + (b) * SHM_V + vst0) = sr_[i].vs0;          \
    *(bf16x8*)((char*)V_lds + (b) * SHM_V + vst1) = sr_[i].vs1;                                 \
    *(bf16x8*)((char*)K_lds + (b) * SHM_K + kst0) = sr_[i].ks0;                                 \
    *(bf16x8*)((char*)K_lds + (b) * SHM_K + kst1) = sr_[i].ks1;                                 \
    *(bf16x8*)((char*)K_lds + (b) * SHM_K + kst2) = sr_[i].ks2; } while (0)
#define SWAIT() do { if constexpr (SDEPTH == 2) asm volatile("s_waitcnt vmcnt(5)" ::: "memory"); else asm volatile("s_waitcnt vmcnt(0)" ::: "memory"); } while (0)
#define RESC(a) do { if (__any((a) < 1.f)) { if (hi == 0) al_l[r32] = (a); asm volatile("s_waitcnt lgkmcnt(0)" ::: "memory"); \
    for (int d = 0; d < 4; ++d) for (int r = 0; r < 16; ++r) o[d][r] *= al_l[crow(r, hi)]; } } while (0)
  f32x16 pA0, pA1, pB0, pB1; float mnA, mnB, alA, alB; bf16x8 pa0, pa1, pa2, pa3; const int NT = seq / KVBLK;
  constexpr int SE = 0, SO = SDEPTH - 1;
  SLOAD(SE, 0); asm volatile("s_waitcnt vmcnt(0)" ::: "memory"); SWRITE(0, SE); __syncthreads();
  qkt(pA0, pA1, K_lds, qr, qro, r32, hi); partialSM(pA0, pA1, m_reg, mnA, alA);
  SLOAD(SO, KVBLK); if constexpr (SDEPTH == 2) { if (2 < NT) SLOAD(SE, 2 * KVBLK); }
  SWAIT(); SWRITE(1, SO); __syncthreads();
  for (int j = 1; j + 1 < NT; j += 2) {
    SBAR(); qkt(pB0, pB1, (bf16*)((char*)K_lds + SHM_K), qr, qro, r32, hi);
    finishSM(pA0, pA1, alA, l_reg, pa0, pa1, pa2, pa3); SBAR();
    SLOAD(SO, (j + SDEPTH) * KVBLK); SBAR();
    pv_d0(o, vb0, pa0, pa1, pa2, pa3); partialSM(pB0, pB1, m_reg, mnB, alB);
    __syncthreads(); SWAIT(); SWRITE(0, SE);
    RESC(alB); __syncthreads();
    SBAR(); qkt(pA0, pA1, K_lds, qr, qro, r32, hi);
    finishSM(pB0, pB1, alB, l_reg, pa0, pa1, pa2, pa3); SBAR();
    if (SDEPTH == 1 || j + 3 < NT) SLOAD(SE, (j + 1 + SDEPTH) * KVBLK); SBAR();
    pv_d0(o, vb0 + (int)SHM_V, pa0, pa1, pa2, pa3); partialSM(pA0, pA1, m_reg, mnA, alA);
    __syncthreads(); SWAIT(); SWRITE(1, SO);
    RESC(alA); __syncthreads();
  }
  SBAR(); qkt(pB0, pB1, (bf16*)((char*)K_lds + SHM_K), qr, qro, r32, hi);
  finishSM(pA0, pA1, alA, l_reg, pa0, pa1, pa2, pa3); SBAR();
  pv_d0(o, vb0, pa0, pa1, pa2, pa3); partialSM(pB0, pB1, m_reg, mnB, alB);
  __syncthreads(); RESC(alB);
  finishSM(pB0, pB1, alB, l_reg, pa0, pa1, pa2, pa3); SBAR();
  pv_d0(o, vb0 + (int)SHM_V, pa0, pa1, pa2, pa3);
  if constexpr (PARTIAL) {
    if (hi == 0) { ML[(wid * QBLK + r32) * 2] = m_reg; ML[(wid * QBLK + r32) * 2 + 1] = l_reg; }
    bf16* Ow = Ob + (long)(wid * QBLK) * 128;
#pragma unroll
    for (int r = 0; r < 16; ++r) { int orow = crow(r, hi);
      for (int d0 = 0; d0 < 4; ++d0) Ow[(long)orow * 128 + d0 * 32 + r32] = (bf16)(cvtpk(o[d0][r], 0.f) & 0xffffu); }
  } else {
  if (hi == 0) li_l[r32] = l_reg; asm volatile("s_waitcnt lgkmcnt(0)" ::: "memory");
  float rli[16];
#pragma unroll
  for (int r = 0; r < 16; ++r) rli[r] = __builtin_amdgcn_rcpf(li_l[crow(r, hi)]);
  bf16* Ow = Ob + (long)(wid * QBLK) * LDO;
#pragma unroll
  for (int r = 0; r < 16; ++r) { int orow = crow(r, hi);
    for (int d0 = 0; d0 < 4; ++d0) Ow[(long)orow * LDO + d0 * 32 + r32] = (bf16)(cvtpk(o[d0][r] * rli[r], 0.f) & 0xffffu); }
  }
  __syncthreads();
#undef SLOAD
#undef SWRITE
#undef SWAIT
#undef RESC
}

}

__device__ __forceinline__ void ph3a_mfma(const Ctx& c, const Params& p) {
    const bf16_t* Q = (const bf16_t*)p.out; const bf16_t* Kk = Q + (size_t)T * MLA_H * QKD; const bf16_t* V = Kk + (size_t)T * MLA_H * QKD;
    bf16_t* omla = (bf16_t*)(p.ws + OFF_R4);
    for (int unit = c.bid; unit < BATCH * MLA_H * (SEQ / 256); unit += c.nb) {
        const int bh = unit & 7, qb = unit >> 3, b = bh >> 2, h = bh & 3;
        const size_t base = (size_t)bh * SEQ;
        attn::attn_dense_body<false>(Q + (base + qb * 256) * QKD, Kk + base * QKD, V + base * VDIM, omla + (size_t)(b * SEQ + qb * 256) * 512 + h * 128, SEQ, (char*)c.lds);
    }
}
constexpr size_t OFF_PART = 240 * MB, OFF_PARTML = 255 * MB;
__device__ __forceinline__ void ph3a_split(const Ctx& c, const Params& p) {
    const bf16_t* Q = (const bf16_t*)p.out; const bf16_t* Kk = Q + (size_t)T * MLA_H * QKD; const bf16_t* V = Kk + (size_t)T * MLA_H * QKD;
    bf16_t* omla = (bf16_t*)(p.ws + OFF_R4);
    const int j = c.bid - 32, bh = j & 7, b = bh >> 2, h = bh & 3; const size_t base = (size_t)bh * SEQ;
    { const int qb = j >> 3;
      attn::attn_dense_body<false>(Q + (base + qb * 256) * QKD, Kk + base * QKD, V + base * VDIM, omla + (size_t)(b * SEQ + qb * 256) * 512 + h * 128, SEQ, (char*)c.lds); }
    { const int r = j >> 3, qb = 28 + r / 7, part = r % 7, k0 = part * 18 * 64, nk = (part == 6 ? 20 : 18) * 64, lu = (qb - 28) * 8 + bh;
      attn::attn_dense_body<true>(Q + (base + qb * 256) * QKD, Kk + (base + k0) * QKD, V + (base + k0) * VDIM, (bf16_t*)(p.ws + OFF_PART) + ((size_t)(lu * 7 + part) * 256) * 128, nk,
                                  (char*)c.lds, (float*)(p.ws + OFF_PARTML) + (size_t)(lu * 7 + part) * 512); }
}


namespace pk {
typedef float f32x16 __attribute__((ext_vector_type(16)));
typedef short bf16x8 __attribute__((ext_vector_type(8)));
__device__ __forceinline__ int f2ord(float f) { const int b = __float_as_int(f); return b ^ ((b >> 31) & 0x7fffffff); }
__device__ __forceinline__ float ord2f(int k) { return __int_as_float(k ^ ((k >> 31) & 0x7fffffff)); }
__device__ __forceinline__ void ce(int& a, int& b) { const int mx = max(a, b), mn = min(a, b); a = mx; b = mn; }
__device__ __forceinline__ void sort16(int (&v)[16]) {
#pragma unroll
    for (int k = 2; k <= 16; k <<= 1)
#pragma unroll
        for (int j = k >> 1; j > 0; j >>= 1)
#pragma unroll
            for (int i = 0; i < 16; ++i) { const int l = i ^ j; if (l > i) { if ((i & k) == 0) ce(v[i], v[l]); else ce(v[l], v[i]); } }
}
__device__ __forceinline__ void merge16(int (&v)[16]) {
#pragma unroll
    for (int j = 8; j > 0; j >>= 1)
#pragma unroll
        for (int i = 0; i < 16; ++i) { const int l = i ^ j; if (l > i) ce(v[i], v[l]); }
}
__device__ __forceinline__ void top_merge(int (&best)[16], int (&g)[16]) {
#pragma unroll
    for (int i = 0; i < 16; ++i) best[i] = max(best[i], g[15 - i]);
    merge16(best);
}
__device__ __forceinline__ int lookup16(unsigned long long lo, unsigned long long hi8, int i) {
    const unsigned long long s = (i & 8) ? hi8 : lo;
    return (int)((s >> ((i & 7) * 8)) & 0xffull);
}
}
__device__ __forceinline__ void ph6_fast(const Ctx& c, const Params& p) {
    using namespace pk;
    const int tid = opaque_tid(), wid = __builtin_amdgcn_readfirstlane(tid >> 6), lane = tid & 63, r32 = lane & 31, hi = lane >> 5;
    const bf16_t* qp = (const bf16_t*)(p.ws + OFF_R2); const bf16_t* subk = (const bf16_t*)(p.ws + OFF_SUBK);
    int* experts = (int*)(p.ws + OFF_R4); float* gates = (float*)(p.ws + OFF_R4 + 8 * MB);
    char* lds = (char*)c.lds;
    constexpr int NU = PH * (T / 256);
    const int per = (NU + c.nb - 1) / c.nb;
    int cur_h = -1;
    for (int ui = 0; ui < per; ++ui) {
        const int u = c.bid * per + ui; if (u >= NU) break;
        const int h = u / (T / 256), t0 = (u % (T / 256)) * 256;
        if (h != cur_h) {
            __syncthreads();
            for (int ch = tid; ch < 4096; ch += NT) { const int row = ch >> 4, cb = (ch & 15) * 16;
                const u32x4 v = *(const u32x4*)(subk + (size_t)h * 32768 + (size_t)row * 128 + (cb >> 1));
                *(u32x4*)(lds + row * 256 + (cb ^ ((row & 7) << 4))) = v; }
            __syncthreads(); cur_h = h;
        }
        const int t = t0 + wid * 32 + r32;
        int A[2][16];
#pragma unroll
        for (int pp = 0; pp < 2; ++pp) {
            bf16x8 bq[8];
#pragma unroll
            for (int ks = 0; ks < 8; ++ks) bq[ks] = *(const bf16x8*)(qp + (size_t)t * 2048 + h * 256 + pp * 128 + ks * 16 + hi * 8);
            f32x16 acc[4];
#pragma unroll
            for (int kt = 0; kt < 4; ++kt) acc[kt] = f32x16{};
#pragma unroll
            for (int ks = 0; ks < 8; ++ks)
#pragma unroll
                for (int kt = 0; kt < 4; ++kt) { const int row = pp * 128 + kt * 32 + r32, cb = (ks * 16 + hi * 8) * 2;
                    const bf16x8 a = *(const bf16x8*)(lds + row * 256 + (cb ^ ((row & 7) << 4)));
                    acc[kt] = __builtin_amdgcn_mfma_f32_32x32x16_bf16(a, bq[ks], acc[kt], 0, 0, 0); }
            int best[16], g[16];
#pragma unroll
            for (int kt = 0; kt < 4; ++kt) {
#pragma unroll
                for (int r = 0; r < 16; ++r) { const int idx = kt * 32 + (r & 3) + 8 * (r >> 2) + 4 * hi; const int k = (f2ord(acc[kt][r]) & ~127) | idx; if (kt == 0) best[r] = k; else g[r] = k; }
                if (kt == 0) sort16(best); else { sort16(g); top_merge(best, g); }
            }
#pragma unroll
            for (int i = 0; i < 16; ++i) g[i] = __shfl_xor(best[i], 32);
            top_merge(best, g);
#pragma unroll
            for (int i = 0; i < 16; ++i) A[pp][i] = best[i];
        }
        constexpr int CI[50] = {0,0,0,0,0,0,0,0,0,0,0,0,0,0,0,0,1,1,1,1,1,1,1,1,2,2,2,2,2,3,3,3,3,4,4,4,5,5,6,6,7,7,8,9,10,11,12,13,14,15};
        constexpr int CJ[50] = {0,1,2,3,4,5,6,7,8,9,10,11,12,13,14,15,0,1,2,3,4,5,6,7,0,1,2,3,4,0,1,2,3,0,1,2,0,1,0,1,0,1,0,0,0,0,0,0,0,0};
        float fa[16], fb[16]; unsigned long long wa0 = 0, wa1 = 0, wb0 = 0, wb1 = 0;
#pragma unroll
        for (int i = 0; i < 16; ++i) { fa[i] = ord2f(A[0][i] & ~127); fb[i] = ord2f(A[1][i] & ~127);
            if (i < 8) { wa0 |= (unsigned long long)(A[0][i] & 127) << (i * 8); wb0 |= (unsigned long long)(A[1][i] & 127) << (i * 8); }
            else { wa1 |= (unsigned long long)(A[0][i] & 127) << ((i - 8) * 8); wb1 |= (unsigned long long)(A[1][i] & 127) << ((i - 8) * 8); } }
        int best[16], g[16];
#pragma unroll
        for (int gi = 0; gi < 4; ++gi) {
#pragma unroll
            for (int r = 0; r < 16; ++r) { const int n = gi * 16 + r; int k = (int)0x80000000;
                if (n < 50) k = (f2ord(fa[CI[n < 50 ? n : 0]] + fb[CJ[n < 50 ? n : 0]]) & ~255) | (CI[n < 50 ? n : 0] << 4) | CJ[n < 50 ? n : 0];
                if (gi == 0) best[r] = k; else g[r] = k; }
            if (gi == 0) sort16(best); else { sort16(g); top_merge(best, g); }
        }
        float fs[16]; int fe[16]; float sum = 0.f; const float s0 = ord2f(best[0] & ~255);
        const float rs2 = rsqrtf(((const float*)(p.ws + OFF_SH))[t] * (1.f / 1024.f) + EPS);
#pragma unroll
        for (int k = 0; k < 16; ++k) { const int code = best[k] & 255; fe[k] = lookup16(wa0, wa1, code >> 4) * NKEYS + lookup16(wb0, wb1, code & 15);
            fs[k] = __expf((ord2f(best[k] & ~255) - s0) * rs2); sum += fs[k]; }
        const float inv = 1.f / sum;
        if (hi == 0) { int* eo = experts + (size_t)t * 128 + h * 16;
#pragma unroll
            for (int k = 0; k < 16; k += 4) *(u32x4*)(eo + k) = u32x4{(unsigned)fe[k], (unsigned)fe[k + 1], (unsigned)fe[k + 2], (unsigned)fe[k + 3]}; }
        else { float* go = gates + (size_t)t * 128 + h * 16;
#pragma unroll
            for (int k = 0; k < 16; k += 4) *(f32x4*)(go + k) = f32x4{fs[k] * inv, fs[k + 1] * inv, fs[k + 2] * inv, fs[k + 3] * inv}; }
    }
    __syncthreads();
}


__device__ __forceinline__ float wave_max(float v) {
#pragma unroll
    for (int o = 1; o < 64; o <<= 1) v = fmaxf(v, __shfl_xor(v, o));
    return v;
}
__device__ __forceinline__ unsigned q4(float a, float b, float cc, float d, float inv, int off) {
    const int x = (int)rintf(a * inv) + off, y = (int)rintf(b * inv) + off, z = (int)rintf(cc * inv) + off, w = (int)rintf(d * inv) + off;
    return (unsigned)(x & 255) | ((unsigned)(y & 255) << 8) | ((unsigned)(z & 255) << 16) | ((unsigned)(w & 255) << 24);
}
__device__ __forceinline__ void quant_row(const float* row, const float* mul, int lane, unsigned char* dst, float* scale_out, int off) {
    f32x4 v[4]; float mx = 0.f;
#pragma unroll
    for (int j = 0; j < 4; ++j) { v[j] = *(const f32x4*)(row + 16 * lane + 4 * j); if (mul) v[j] = v[j] * *(const f32x4*)(mul + 16 * lane + 4 * j);
        mx = fmaxf(mx, fmaxf(fmaxf(fabsf(v[j].x), fabsf(v[j].y)), fmaxf(fabsf(v[j].z), fabsf(v[j].w)))); }
    mx = fmaxf(wave_max(mx), 1e-30f);
    const float inv = 127.f / mx;
    u32x4 o; o.x = q4(v[0].x, v[0].y, v[0].z, v[0].w, inv, off); o.y = q4(v[1].x, v[1].y, v[1].z, v[1].w, inv, off);
    o.z = q4(v[2].x, v[2].y, v[2].z, v[2].w, inv, off); o.w = q4(v[3].x, v[3].y, v[3].z, v[3].w, inv, off);
    *(u32x4*)(dst + 16 * lane) = o;
    if (lane == 0) *scale_out = mx * (1.f / 127.f);
}
__device__ __forceinline__ void fp8_row(const float* row, int lane, unsigned char* dst) {
    u32x4 o;
#pragma unroll
    for (int j = 0; j < 4; ++j) { const f32x4 v = *(const f32x4*)(row + 16 * lane + 4 * j);
        int w = __builtin_amdgcn_cvt_pk_fp8_f32(v.x, v.y, 0, false); w = __builtin_amdgcn_cvt_pk_fp8_f32(v.z, v.w, w, true); o[j] = (unsigned)w; }
    *(u32x4*)(dst + (size_t)(lane >> 3) * ((size_t)NEXP * 128) + (lane & 7) * 16) = o;
}
__device__ __forceinline__ void ph4a_tables_q8(const Ctx& c, const Params& p, int gw, int ngw, int r_lo, int r_hi) {
    unsigned char* u8 = p.ws + OFF_R5; unsigned char* v8 = u8 + (size_t)NEXP * 1024;
    float* su = (float*)(p.ws + OFF_SU); float* sv = (float*)(p.ws + OFF_SV);
    for (int r = r_lo + gw; r < r_hi; r += ngw) {
        if (r < NEXP) quant_row(p.peer_u + (size_t)r * 1024, p.ln2_w, c.lane, u8 + (size_t)r * 1024, su + r, 0);
        else { const int e = r - NEXP; fp8_row(p.peer_v + (size_t)e * 1024, c.lane, v8 + (size_t)e * 128); }
    }
}


namespace gdn {
typedef short bf16x8 __attribute__((ext_vector_type(8)));
typedef short s16x4 __attribute__((ext_vector_type(4)));
typedef float f32x4v __attribute__((ext_vector_type(4)));
typedef float f32x2c __attribute__((ext_vector_type(2))); typedef __bf16 bf16x2c __attribute__((ext_vector_type(2)));
__device__ __forceinline__ unsigned cvtpk(float lo, float hi) { const f32x2c v = {lo, hi}; const bf16x2c r = __builtin_convertvector(v, bf16x2c); return *(const unsigned*)&r; }
__device__ __forceinline__ int wperm(int d) { const int x = d & 31; return (d & ~31) | (8 * ((x >> 2) & 3) + 4 * (x >> 4) + (x & 3)); }
}
__device__ __forceinline__ void unpack8(const u32x4 w, float (&f)[8]) {
    f[0] = bflo(w.x); f[1] = bfhi(w.x); f[2] = bflo(w.y); f[3] = bfhi(w.y); f[4] = bflo(w.z); f[5] = bfhi(w.z); f[6] = bflo(w.w); f[7] = bfhi(w.w); }
__device__ __forceinline__ u32x4 pack8(const float (&f)[8]) { u32x4 w; w.x = gdn::cvtpk(f[0], f[1]); w.y = gdn::cvtpk(f[2], f[3]); w.z = gdn::cvtpk(f[4], f[5]); w.w = gdn::cvtpk(f[6], f[7]); return w; }


template <int VAR>
__device__ __forceinline__ void ph2b_v4(const Ctx& c, const Params& p) {
    using namespace gdn;
    const int tid = opaque_tid(), wid = __builtin_amdgcn_readfirstlane(tid >> 6), lane = tid & 63, li = lane & 15, lq = lane >> 4;
    const bf16_t* gq = (const bf16_t*)(p.ws + OFF_R2); const bf16_t* gk = gq + (size_t)T * 512; const bf16_t* gv = gk + (size_t)T * 512;
    const float* Gg = (const float*)(p.ws + OFF_GATE); const float* Gb = Gg + 2 * T * GH; float* Gcs = (float*)(p.ws + OFF_GATE) + 4 * T * GH;
    bf16_t* U = (bf16_t*)(p.ws + OFF_R1); bf16_t* W = U + (size_t)2 * T * 512; bf16_t* AT = W + (size_t)2 * T * 512;
    char* lds = (char*)c.lds;
    char* kL = lds; char* qL = lds + 16384;
    float (*Gm)[68] = (float (*)[68])(lds + 32768); float (*QKm)[68] = Gm + 64;
    float (*Lm)[64][68] = (float (*)[64][68])(lds + 32768 + 2 * 64 * 68 * 4);
    float* gcsL = (float*)(lds + 32768 + 4 * 64 * 68 * 4); float* betaL = gcsL + 128; float* gL = betaL + 128;
    for (int unit = c.bid; unit < BATCH * GH * NCH; unit += c.nb) {
        const int nt = unit % NCH, h = (unit / NCH) % GH, b = unit / (NCH * GH);
        const int p0 = nt * CHUNK; const size_t bh = (size_t)(b * GH + h) * SEQ;
        __syncthreads();
#pragma unroll
        for (int i = 0; i < 2; ++i) { const int ch = tid + i * NT, row = ch >> 4, a = ch & 15; const int off = row * 256 + ((a * 16) ^ ((row & 15) << 4));
            *(u32x4*)(kL + off) = *(const u32x4*)(gk + (bh + p0 + row) * 128 + a * 8); *(u32x4*)(qL + off) = *(const u32x4*)(gq + (bh + p0 + row) * 128 + a * 8); }
        if (tid < 128) { const int d = tid >> 6, i = tid & 63; gL[tid] = Gg[(size_t)d * T * GH + bh + p0 + i]; betaL[tid] = Gb[(size_t)d * T * GH + bh + p0 + i]; }
        __syncthreads();
        if (wid < 2) { float v = gL[wid * 64 + (wid ? 63 - lane : lane)];
#pragma unroll
            for (int o = 1; o < 64; o <<= 1) { const float t_ = __shfl_up(v, o); if (lane >= o) v += t_; }
            gcsL[wid * 64 + lane] = v; }
        { const int mt = wid & 3; const char* Asrc = wid < 4 ? kL : qL; f32x4v acc[4];
#pragma unroll
          for (int n = 0; n < 4; ++n) acc[n] = f32x4v{0.f, 0.f, 0.f, 0.f};
#pragma unroll
          for (int s = 0; s < 4; ++s) { const int cb = 64 * s + 16 * lq;
              const bf16x8 af = *(const bf16x8*)(Asrc + (16 * mt + li) * 256 + (cb ^ (li << 4)));
#pragma unroll
              for (int n = 0; n < 4; ++n) { const bf16x8 bfr = *(const bf16x8*)(kL + (16 * n + li) * 256 + (cb ^ (li << 4)));
                  acc[n] = __builtin_amdgcn_mfma_f32_16x16x32_bf16(af, bfr, acc[n], 0, 0, 0); } }
          float (*dst)[68] = wid < 4 ? Gm : QKm;
#pragma unroll
          for (int n = 0; n < 4; ++n)
#pragma unroll
              for (int r = 0; r < 4; ++r) dst[16 * mt + 4 * lq + r][16 * n + li] = acc[n][r];
        }
        __syncthreads();
        if (tid < 128) { const int d = tid >> 6, i = tid & 63; const int nv = d ? NCH - 1 - nt : nt; Gcs[(size_t)d * T * GH + bh + nv * CHUNK + i] = gcsL[tid]; }
        const int tid2 = opaque_tid();
#pragma unroll 2
        for (int idx = tid2; idx < (VAR == 2 ? 0 : 2 * 4096); idx += NT) { const int d = idx >> 12, i = (idx >> 6) & 63, j = idx & 63; const int ti = d ? 63 - i : i, tj = d ? 63 - j : j;
            const float dec = __expf(gcsL[d * 64 + i] - gcsL[d * 64 + j]);
            Lm[d][j][i] = i > j ? betaL[d * 64 + ti] * Gm[ti][tj] * dec : 0.f;
            const int nv = d ? NCH - 1 - nt : nt;
            AT[((size_t)(d * BATCH * GH + b * GH + h) * NCH + nv) * 4096 + i * 64 + wperm(j)] = f2bf(i >= j ? QKm[ti][tj] * dec : 0.f); }
        __syncthreads();
        if (VAR == 1) continue;
        char* RL = lds;
        char* Dv = lds + 32768 + 4 * 64 * 68 * 4 + 1536;
        char* Lb = Dv + 4096;
        for (int ch = tid; ch < 4096; ch += NT) { const int d = ch >> 11, j = (ch >> 5) & 63, cc = ch & 31, tj = d ? 63 - j : j, col0 = cc * 8;
            const bf16_t* sp = (col0 < 128 ? gv + (bh + p0 + tj) * 128 + col0 : gk + (bh + p0 + tj) * 128 + (col0 - 128));
            float f[8]; unpack8(*(const u32x4*)sp, f);
            const float sc = betaL[d * 64 + tj] * (col0 < 128 ? 1.f : __expf(gcsL[d * 64 + j]));
#pragma unroll
            for (int e = 0; e < 8; ++e) f[e] *= sc;
            *(u32x4*)(RL + d * 33792 + (j >> 2) * 2112 + (cc >> 1) * 128 + (j & 3) * 32 + (cc & 1) * 16) = pack8(f); }
        if (tid < 128) {
            const int d = tid >> 6, bb = (tid >> 4) & 3, cc = tid & 15; float x[16];
#pragma unroll
            for (int i = 0; i < 16; ++i) x[i] = (i == cc) ? 1.f : 0.f;
#pragma unroll
            for (int j = 0; j < 15; ++j) { const float xj = x[j];
#pragma unroll
                for (int i = j + 1; i < 16; ++i) x[i] -= Lm[d][16 * bb + j][16 * bb + i] * xj; }
#pragma unroll
            for (int i = 0; i < 16; ++i) *(bf16_t*)(Dv + ((d * 4 + bb) * 16 + i) * 32 + cc * 2) = f2bf(x[i]);
        } else {
            for (int e = tid - 128; e < 2 * 6 * 256; e += NT - 128) { const int d = e / 1536, r = e % 1536, pi = r >> 8, i = (r >> 4) & 15, k = r & 15;
                const int bb = pi == 0 ? 1 : (pi < 3 ? 2 : 3), aa = pi - bb * (bb - 1) / 2;
                *(bf16_t*)(Lb + ((d * 6 + pi) * 16 + i) * 32 + k * 2) = f2bf(-Lm[d][16 * aa + k][16 * bb + i]); }
        }
        __syncthreads();
        { typedef short s16x4v __attribute__((ext_vector_type(4)));
          const int d = wid >> 2, nv = d ? NCH - 1 - nt : nt; const size_t rowbase = ((size_t)d * T * GH + bh + nv * CHUNK) * 128;
          const char* RLd = RL + d * 33792; const char* Dvd = Dv + d * 2048; const char* Lbd = Lb + d * 3072;
#pragma unroll
          for (int tp = 0; tp < 2; ++tp) {
              f32x4v acc[2][4]; s16x4v xb[2][4];
#pragma unroll
              for (int u = 0; u < 2; ++u) { const int ntile = 4 * (wid & 3) + 2 * tp + u;
#pragma unroll
                  for (int bb = 0; bb < 4; ++bb)
#pragma unroll
                      for (int r = 0; r < 4; ++r) acc[u][bb][r] = bf2f(*(const bf16_t*)(RLd + (4 * bb + lq) * 2112 + ntile * 128 + r * 32 + li * 2)); }
#pragma unroll
              for (int bb = 0; bb < 4; ++bb) {
#pragma unroll
                  for (int aa = 0; aa < bb; ++aa) { const s16x4v lf = *(const s16x4v*)(Lbd + ((bb * (bb - 1) / 2 + aa) * 16 + li) * 32 + lq * 8);
#pragma unroll
                      for (int u = 0; u < 2; ++u) acc[u][bb] = __builtin_amdgcn_mfma_f32_16x16x16bf16_1k(lf, xb[u][aa], acc[u][bb], 0, 0, 0); }
                  const s16x4v df = *(const s16x4v*)(Dvd + (bb * 16 + li) * 32 + lq * 8);
#pragma unroll
                  for (int u = 0; u < 2; ++u) { u32x2 w; w.x = cvtpk(acc[u][bb][0], acc[u][bb][1]); w.y = cvtpk(acc[u][bb][2], acc[u][bb][3]);
                      const s16x4v rb = *(s16x4v*)&w; acc[u][bb] = __builtin_amdgcn_mfma_f32_16x16x16bf16_1k(df, rb, f32x4v{0.f, 0.f, 0.f, 0.f}, 0, 0, 0);
                      u32x2 w2; w2.x = cvtpk(acc[u][bb][0], acc[u][bb][1]); w2.y = cvtpk(acc[u][bb][2], acc[u][bb][3]); xb[u][bb] = *(s16x4v*)&w2; }
              }
#pragma unroll
              for (int u = 0; u < 2; ++u) { const int col = 16 * (4 * (wid & 3) + 2 * tp + u) + li; bf16_t* dst = (col < 128 ? U + rowbase + col : W + rowbase + wperm(col - 128));
#pragma unroll
                  for (int bb = 0; bb < 4; ++bb)
#pragma unroll
                      for (int r = 0; r < 4; ++r) dst[(size_t)(16 * bb + 4 * lq + r) * 128] = (bf16_t)((unsigned short)xb[u][bb][r]); }
          }
        }
    }
    __syncthreads();
}

template <int VAR>
__device__ __forceinline__ void ph3b_mfma(const Ctx& c, const Params& p) {
    using namespace gdn;
    constexpr int W_OFF = 0, QD_OFF = 16384, KD_OFF = 32768, AT_OFF = 51200, U_OFF = 59392, MISC_OFF = 68608, BUF = 69632;
    const int tid = opaque_tid(), wid = __builtin_amdgcn_readfirstlane(tid >> 6), lane = tid & 63, li = lane & 15, lq = lane >> 4;
    const bf16_t* gq = (const bf16_t*)(p.ws + OFF_R2); const bf16_t* gk = gq + (size_t)T * 512;
    const float* Gcs = (const float*)(p.ws + OFF_GATE) + 4 * T * GH;
    const bf16_t* Ug = (const bf16_t*)(p.ws + OFF_R1); const bf16_t* Wg = Ug + (size_t)2 * T * 512; const bf16_t* ATg = Wg + (size_t)2 * T * 512;
    bf16_t* Od = (bf16_t*)(p.ws + OFF_R3);
    char* lds = (char*)c.lds;
    for (int unit = c.bid; unit < 2 * BATCH * GH * 2; unit += c.nb) {
        const int chain = (unit & 7) | ((unit >> 4) << 3), vh = (unit >> 3) & 1, h = chain & 3, b = (chain >> 2) & 1, dir = chain >> 3;
        const size_t bh = (size_t)(b * GH + h) * SEQ; const size_t dbh = (size_t)dir * T * GH + bh; const int c0 = vh * 64;
        __syncthreads();
        if (wid >= 4) {
            const int lt = tid - 256;
            struct LSet { u32x4 rw[4], rq[4], rk[4], ra[2], ru[2]; float gc[4], gl; };
            LSet sA, sB;
            const int r0 = lt >> 4, a0 = lt & 15;
            const unsigned offW = (unsigned)(r0 * 256 + a0 * 16);
            const unsigned offQ = (unsigned)((dir ? 63 - r0 : r0) * 256 + a0 * 16);
            const int r1 = lt >> 3, a1 = lt & 7;
            const unsigned offA = (unsigned)(r1 * 128 + a1 * 16), offU = (unsigned)(r1 * 256 + a1 * 16), offG = (unsigned)(r0 * 4);
            const int qstep = dir ? -4096 : 4096;
            const unsigned swW = (unsigned)((r0 & 15) << 4);
            const unsigned ldsW = (unsigned)(r0 * 256) + (((unsigned)a0 * 16u) ^ swW);
            const int s_ = a0 >> 2, a2 = a0 & 3; const int pos0 = ((2 * a2) & 3) * 2 + (a2 >> 1), pos1 = ((2 * a2 + 1) & 3) * 2 + (a2 >> 1);
            const unsigned ldsQ0 = (unsigned)(r0 * 256) + (((unsigned)(64 * s_ + 8 * pos0)) ^ swW), ldsQ1 = (unsigned)(r0 * 256) + (((unsigned)(64 * s_ + 8 * pos1)) ^ swW);
            const unsigned ldsK = (unsigned)((r0 >> 2) * 1152 + (a0 >> 1) * 128 + (r0 & 3) * 32 + (a0 & 1) * 16);
            const unsigned ldsA = (unsigned)(r1 * 128) + (((unsigned)a1 * 16u) ^ (unsigned)(((r1 >> 1) & 7) << 4)), ldsU = (unsigned)(r1 * 144 + a1 * 16);
            const char* Wb = (const char*)(Wg + dbh * 128); const char* Ub = (const char*)(Ug + dbh * 128 + c0);
            const char* Qb = (const char*)(gq + (bh + (dir ? SEQ - 64 : 0)) * 128); const char* Kb = (const char*)(gk + (bh + (dir ? SEQ - 64 : 0)) * 128);
            const char* Ab = (const char*)(ATg + (size_t)(dir * BATCH * GH + b * GH + h) * NCH * 4096); const char* Gb_ = (const char*)(Gcs + dbh);
#define GDN_LOAD(S_, nreal_) do { const int n_ = VAR == 1 ? 0 : (nreal_); const long cw_ = (long)(n_) * 16384, cq_ = dir ? -(long)(n_) * 16384 : (long)(n_) * 16384; \
    _Pragma("unroll") for (int i = 0; i < 4; ++i) { \
        S_.rw[i] = *(const u32x4*)(Wb + cw_ + i * 4096 + offW); S_.rq[i] = *(const u32x4*)(Qb + cq_ + i * qstep + offQ); S_.rk[i] = *(const u32x4*)(Kb + cq_ + i * qstep + offQ); \
        S_.gc[i] = *(const float*)(Gb_ + (long)(n_) * 256 + i * 64 + offG); } \
    _Pragma("unroll") for (int i = 0; i < 2; ++i) { \
        S_.ra[i] = *(const u32x4*)(Ab + (long)(n_) * 8192 + i * 4096 + offA); S_.ru[i] = *(const u32x4*)(Ub + cw_ + i * 8192 + offU); } \
    S_.gl = *(const float*)(Gb_ + (long)(n_) * 256 + 252); } while (0)
#define GDN_SCALE2(w_, f_) cvtpk(bflo(w_) * (f_), bfhi(w_) * (f_))
#define GDN_WRITE(S_, buf_) do { char* B_ = lds + (buf_) * BUF; \
    _Pragma("unroll") for (int i = 0; i < 4; ++i) { \
        *(u32x4*)(B_ + W_OFF + i * 4096 + ldsW) = S_.rw[i]; \
        const float fq_ = __expf(S_.gc[i]), fk_ = __expf(S_.gl - S_.gc[i]); \
        u32x2 q0, q1; q0.x = GDN_SCALE2(S_.rq[i].x, fq_); q0.y = GDN_SCALE2(S_.rq[i].y, fq_); q1.x = GDN_SCALE2(S_.rq[i].z, fq_); q1.y = GDN_SCALE2(S_.rq[i].w, fq_); \
        *(u32x2*)(B_ + QD_OFF + i * 4096 + ldsQ0) = q0; *(u32x2*)(B_ + QD_OFF + i * 4096 + ldsQ1) = q1; \
        u32x4 k_; k_.x = GDN_SCALE2(S_.rk[i].x, fk_); k_.y = GDN_SCALE2(S_.rk[i].y, fk_); k_.z = GDN_SCALE2(S_.rk[i].z, fk_); k_.w = GDN_SCALE2(S_.rk[i].w, fk_); \
        *(u32x4*)(B_ + KD_OFF + i * 4608 + ldsK) = k_; } \
    _Pragma("unroll") for (int i = 0; i < 2; ++i) { \
        *(u32x4*)(B_ + AT_OFF + i * 4096 + ldsA) = S_.ra[i]; *(u32x4*)(B_ + U_OFF + i * 4608 + ldsU) = S_.ru[i]; } \
    if (lt == 0) *(float*)(B_ + MISC_OFF) = __expf(S_.gl); } while (0)
            GDN_LOAD(sA, 0); GDN_WRITE(sA, 0); GDN_LOAD(sB, 1); GDN_LOAD(sA, 2);
            for (int n = 0; n < NCH; n += 2) {
                __syncthreads();
                GDN_WRITE(sB, 1);
                { const int nn = n + 3 < NCH ? n + 3 : NCH - 1; GDN_LOAD(sB, nn); }
                __syncthreads();
                GDN_WRITE(sA, 0);
                { const int nn = n + 4 < NCH ? n + 4 : NCH - 1; GDN_LOAD(sA, nn); }
            }
#undef GDN_LOAD
#undef GDN_WRITE
#undef GDN_SCALE2
        } else {
            f32x4v S[8];
#pragma unroll
            for (int m = 0; m < 8; ++m) S[m] = f32x4v{0.f, 0.f, 0.f, 0.f};
            const int cw = 16 * wid;
            for (int n = 0; n < NCH; ++n) {
                __syncthreads();
                if (VAR == 2) continue;
                const char* B = lds + (n & 1) * BUF; const int p0 = n * CHUNK;
                const float egl = *(const float*)(B + MISC_OFF);
                bf16x8 Sb[4];
#pragma unroll
                for (int s = 0; s < 4; ++s) { u32x4 w; w.x = cvtpk(S[2 * s][0], S[2 * s][1]); w.y = cvtpk(S[2 * s][2], S[2 * s][3]); w.z = cvtpk(S[2 * s + 1][0], S[2 * s + 1][1]); w.w = cvtpk(S[2 * s + 1][2], S[2 * s + 1][3]); Sb[s] = *(bf16x8*)&w; }
                f32x4v av[4], ao[4];
#pragma unroll
                for (int m = 0; m < 4; ++m) { av[m] = f32x4v{0.f, 0.f, 0.f, 0.f}; ao[m] = f32x4v{0.f, 0.f, 0.f, 0.f}; }
#pragma unroll
                for (int s = 0; s < 4; ++s)
#pragma unroll
                    for (int m = 0; m < 4; ++m) { const int off = (16 * m + li) * 256 + ((64 * s + 16 * lq) ^ (li << 4));
                        av[m] = __builtin_amdgcn_mfma_f32_16x16x32_bf16(*(const bf16x8*)(B + W_OFF + off), Sb[s], av[m], 0, 0, 0);
                        ao[m] = __builtin_amdgcn_mfma_f32_16x16x32_bf16(*(const bf16x8*)(B + QD_OFF + off), Sb[s], ao[m], 0, 0, 0); }
#pragma unroll
                for (int m = 0; m < 4; ++m)
#pragma unroll
                    for (int r = 0; r < 4; ++r) av[m][r] = bf2f(*(const bf16_t*)(B + U_OFF + (16 * m + 4 * lq + r) * 144 + (cw + li) * 2)) - av[m][r];
                bf16x8 Vb[2];
#pragma unroll
                for (int s = 0; s < 2; ++s) { u32x4 w; w.x = cvtpk(av[2 * s][0], av[2 * s][1]); w.y = cvtpk(av[2 * s][2], av[2 * s][3]); w.z = cvtpk(av[2 * s + 1][0], av[2 * s + 1][1]); w.w = cvtpk(av[2 * s + 1][2], av[2 * s + 1][3]); Vb[s] = *(bf16x8*)&w; }
#pragma unroll
                for (int s = 0; s < 2; ++s)
#pragma unroll
                    for (int m = 0; m < 4; ++m) { const int row = 16 * m + li;
                        ao[m] = __builtin_amdgcn_mfma_f32_16x16x32_bf16(*(const bf16x8*)(B + AT_OFF + row * 128 + ((64 * s + 16 * lq) ^ (((row >> 1) & 7) << 4))), Vb[s], ao[m], 0, 0, 0); }
#pragma unroll
                for (int m = 0; m < 8; ++m) S[m] = S[m] * egl;
                { s16x4 tr[8][4]; const int base = (int)(uintptr_t)(B + KD_OFF) + lq * 1152 + 8 * li;
#define GDN_TR(m_) do { asm volatile("ds_read_b64_tr_b16 %0, %1 offset:%2" : "=&v"(tr[m_][0]) : "v"(base), "i"((m_) * 128) : "memory"); \
    asm volatile("ds_read_b64_tr_b16 %0, %1 offset:%2" : "=&v"(tr[m_][1]) : "v"(base), "i"((m_) * 128 + 4608) : "memory"); \
    asm volatile("ds_read_b64_tr_b16 %0, %1 offset:%2" : "=&v"(tr[m_][2]) : "v"(base), "i"((m_) * 128 + 9216) : "memory"); \
    asm volatile("ds_read_b64_tr_b16 %0, %1 offset:%2" : "=&v"(tr[m_][3]) : "v"(base), "i"((m_) * 128 + 13824) : "memory"); } while (0)
#define GDN_SUP(m_) do { const bf16x8 k0 = bf16x8{tr[m_][0][0], tr[m_][0][1], tr[m_][0][2], tr[m_][0][3], tr[m_][1][0], tr[m_][1][1], tr[m_][1][2], tr[m_][1][3]}, \
        k1 = bf16x8{tr[m_][2][0], tr[m_][2][1], tr[m_][2][2], tr[m_][2][3], tr[m_][3][0], tr[m_][3][1], tr[m_][3][2], tr[m_][3][3]}; \
    S[m_] = __builtin_amdgcn_mfma_f32_16x16x32_bf16(k0, Vb[0], S[m_], 0, 0, 0); S[m_] = __builtin_amdgcn_mfma_f32_16x16x32_bf16(k1, Vb[1], S[m_], 0, 0, 0); } while (0)
                  GDN_TR(0); GDN_TR(1); GDN_TR(2); GDN_TR(3);
                  asm volatile("s_waitcnt lgkmcnt(0)" ::: "memory"); __builtin_amdgcn_sched_barrier(0);
                  GDN_TR(4); GDN_TR(5); GDN_TR(6); GDN_TR(7);
                  GDN_SUP(0); GDN_SUP(1); GDN_SUP(2); GDN_SUP(3);
                  asm volatile("s_waitcnt lgkmcnt(0)" ::: "memory"); __builtin_amdgcn_sched_barrier(0);
                  GDN_SUP(4); GDN_SUP(5); GDN_SUP(6); GDN_SUP(7);
#undef GDN_TR
#undef GDN_SUP
                }
#pragma unroll
                for (int m = 0; m < 4; ++m)
#pragma unroll
                    for (int r = 0; r < 4; ++r) { const int pv = p0 + 16 * m + 4 * lq + r; const int tk = dir ? SEQ - 1 - pv : pv;
                        Od[((size_t)dir * T + b * SEQ + tk) * 512 + h * 128 + c0 + cw + li] = f2bf(ao[m][r]); }
            }
        }
    }
    __syncthreads();
}


constexpr size_t OFF_SUMSQ = OFF_SH;
constexpr size_t OFF_KPE = OFF_R4;
__device__ __forceinline__ void cvt_tile(const float* src, int K, int N, const float* scale, bf16_t* dst, int Kpad, int tk, int tn, float* tile, int tid) {
    const int k0 = tk * 64, n0 = tn * 64;
#pragma unroll
    for (int i = 0; i < 2; ++i) { const int r = (tid >> 4) + 32 * i, k = k0 + r, n = n0 + (tid & 15) * 4; f32x4 v = {0.f, 0.f, 0.f, 0.f};
        if (k < K) { const float sc = scale ? scale[k] : 1.f;
            if (n + 3 < N) v = *(const f32x4*)(src + (size_t)k * N + n) * sc;
            else { for (int e = 0; e < 4; ++e) if (n + e < N) v[e] = src[(size_t)k * N + n + e] * sc; } }
#pragma unroll
        for (int e = 0; e < 4; ++e) tile[r * 65 + (tid & 15) * 4 + e] = v[e]; }
    __syncthreads();
    { const int nl = tid >> 3, kc = (tid & 7) * 8; float f[8];
#pragma unroll
      for (int j = 0; j < 8; ++j) f[j] = tile[(kc + j) * 65 + nl];
      *(u32x4*)(dst + (size_t)(n0 + nl) * Kpad + k0 + kc) = pack8(f); }
    __syncthreads();
}
__device__ __forceinline__ void ph0_v2(const Ctx& c, const Params& p) {
    unsigned char* ws = p.ws;
    constexpr int T0 = 16 * 40, T1 = T0 + 4 * 12, T2 = T1 + 4 * 16, T3 = T2 + 16 * 16, T4 = T3 + 16 * 32;
    for (int tile = c.bid; tile < T4; tile += c.nb) {
        if (tile < T0) cvt_tile(p.w_in, 1024, IN_W, p.ln1_w, (bf16_t*)(ws + OFF_WIN), 1024, tile % 16, tile / 16, c.lds, c.tid);
        else if (tile < T1) { const int r = tile - T0; cvt_tile(p.w_q_up, QRANK, 768, p.q_a_norm_w, (bf16_t*)(ws + OFF_WQUP), 256, r % 4, r / 4, c.lds, c.tid); }
        else if (tile < T2) { const int r = tile - T1; cvt_tile(p.w_kv_up, KVRANK, 1024, p.kv_a_norm_w, (bf16_t*)(ws + OFF_WKVUP), 256, r % 4, r / 4, c.lds, c.tid); }
        else if (tile < T3) { const int r = tile - T2; cvt_tile(p.w_out, 1024, 1024, nullptr, (bf16_t*)(ws + OFF_WOUT), 1024, r % 16, r / 16, c.lds, c.tid); }
        else { const int r = tile - T3; cvt_tile(p.peer_wq, 1024, 2048, p.ln2_w, (bf16_t*)(ws + OFF_WPQ), 1024, r % 16, r / 16, c.lds, c.tid); }
    }
    { bf16_t* d = (bf16_t*)(ws + OFF_SUBK); const int total4 = PH * 2 * NKEYS * 128 / 4;
      for (int i = c.bid * NT + c.tid; i < total4; i += c.nb * NT) { const f32x4 v = ((const f32x4*)p.sub_keys)[i]; u32x2 o; o.x = gdn::cvtpk(v.x, v.y); o.y = gdn::cvtpk(v.z, v.w); ((u32x2*)d)[i] = o; } }
    { float* sq = (float*)(ws + OFF_SUMSQ); for (int i = c.bid * NT + c.tid; i < T; i += c.nb * NT) sq[i] = 0.f; }
    bf16_t* xb = (bf16_t*)(ws + OFF_R2); float* rstd1 = (float*)(ws + OFF_VEC);
    for (int m = c.gw; m < T; m += c.ngw) {
        const f32x4* xr = (const f32x4*)(p.x + (size_t)m * D_MODEL) + c.lane;
        f32x4 v[4]; float s = 0.f;
#pragma unroll
        for (int j = 0; j < 4; ++j) { v[j] = xr[64 * j]; s += v[j].x * v[j].x + v[j].y * v[j].y + v[j].z * v[j].z + v[j].w * v[j].w; }
        s = wave_sum(s);
        const float rs = rsqrtf(s * (1.f / D_MODEL) + EPS);
        if (c.lane == 0) rstd1[m] = rs;
        u32x2* o = (u32x2*)(xb + (size_t)m * D_MODEL) + c.lane;
#pragma unroll
        for (int j = 0; j < 4; ++j) { u32x2 w; w.x = gdn::cvtpk(v[j].x * rs, v[j].y * rs); w.y = gdn::cvtpk(v[j].z * rs, v[j].w * rs); o[64 * j] = w; }
    }
}

__device__ __forceinline__ void ph2a1_v2(const Ctx& c, const Params& p) {
    const int lane = opaque_tid() & 63;
    const bf16_t* proj = (const bf16_t*)(p.ws + OFF_R1);
    bf16_t* gq = (bf16_t*)(p.ws + OFF_R2); bf16_t* gk = gq + (size_t)T * 512; bf16_t* gv = gk + (size_t)T * 512; bf16_t* zs = gv + (size_t)T * 512;
    const int part = c.gw & 3;
    float cw[5][8];
#pragma unroll
    for (int j = 0; j < 5; ++j)
#pragma unroll
        for (int e = 0; e < 8; ++e) cw[j][e] = part < 3 ? p.conv_w[j * GDN_QKV + part * 512 + 8 * lane + e] : 0.f;
    for (int run = c.gw >> 2; run < T / 16; run += c.ngw >> 2) {
        const int t0 = run * 16, b = t0 / SEQ, s0 = t0 % SEQ;
        if (part == 3) {
#pragma unroll 4
            for (int i = 0; i < 16; ++i) { float f[8]; unpack8(*(const u32x4*)(proj + (size_t)(t0 + i) * IN_WP + C_Z + 8 * lane), f);
#pragma unroll
                for (int e = 0; e < 8; ++e) f[e] = siluf_(f[e]);
                *(u32x4*)(zs + (size_t)(t0 + i) * 512 + 8 * lane) = pack8(f); }
        } else {
            const bf16_t* base = proj + (size_t)t0 * IN_WP + C_QKV + part * 512 + 8 * lane;
            const u32x4 zero = {0u, 0u, 0u, 0u};
            u32x4 xw[5];
            xw[0] = s0 >= 2 ? *(const u32x4*)(base - 2 * IN_WP) : zero; xw[1] = s0 >= 1 ? *(const u32x4*)(base - IN_WP) : zero;
            xw[2] = *(const u32x4*)(base); xw[3] = *(const u32x4*)(base + IN_WP);
            bf16_t* dst = (part == 0 ? gq : part == 1 ? gk : gv) + ((size_t)(b * GH + (lane >> 4)) * SEQ + s0) * 128 + (lane & 15) * 8;
#pragma unroll
            for (int i = 0; i < 16; ++i) {
                xw[4] = (s0 + i + 2 < SEQ) ? *(const u32x4*)(base + (size_t)(i + 2) * IN_WP) : zero;
                float y[8];
#pragma unroll
                for (int e = 0; e < 8; ++e) y[e] = 0.f;
#pragma unroll
                for (int j = 0; j < 5; ++j) { float f[8]; unpack8(xw[j], f);
#pragma unroll
                    for (int e = 0; e < 8; ++e) y[e] += cw[j][e] * f[e]; }
                float ss = 0.f;
#pragma unroll
                for (int e = 0; e < 8; ++e) { y[e] = siluf_(y[e]); ss += y[e] * y[e]; }
                if (part < 2) { ss += __shfl_xor(ss, 1); ss += __shfl_xor(ss, 2); ss += __shfl_xor(ss, 4); ss += __shfl_xor(ss, 8);
                    const float rs = rsqrtf(ss + EPS) * (part == 0 ? 0.08838834764831845f : 1.f);
#pragma unroll
                    for (int e = 0; e < 8; ++e) y[e] *= rs; }
                *(u32x4*)(dst + (size_t)i * 128) = pack8(y);
                xw[0] = xw[1]; xw[1] = xw[2]; xw[2] = xw[3]; xw[3] = xw[4];
            }
        }
    }
    { float* Gg = (float*)(p.ws + OFF_GATE); float* Gb = Gg + 2 * T * GH;
      for (int t = c.bid * NT + c.tid; t < T; t += c.nb * NT) { const int b = t / SEQ, s = t % SEQ; float f0[8], f1[8];
          unpack8(*(const u32x4*)(proj + (size_t)t * IN_WP + C_GATE), f0); unpack8(*(const u32x4*)(proj + (size_t)t * IN_WP + C_GATE + 8), f1);
#pragma unroll
          for (int h = 0; h < 4; ++h) { const size_t gi = (size_t)(b * GH + h) * SEQ + s;
              Gg[gi] = -expf(p.a_log_f[h]) * softplusf_(f0[h] + p.dt_bias_f[h]); Gb[gi] = sigmoidf_(f0[4 + h]);
              Gg[(size_t)T * GH + gi] = -expf(p.a_log_b[h]) * softplusf_(f1[h] + p.dt_bias_b[h]); Gb[(size_t)T * GH + gi] = sigmoidf_(f1[4 + h]); } } }
    { float* rq = (float*)(p.ws + OFF_VEC) + T; float* rkv = rq + T; bf16_t* kpe = (bf16_t*)(p.ws + OFF_KPE);
      for (int t = c.gw; t < T; t += c.ngw) { u32x4 v = {0u, 0u, 0u, 0u}; if (lane < 56) v = *(const u32x4*)(proj + (size_t)t * IN_WP + 8 * lane);
          float f[8]; unpack8(v, f); float ss = 0.f;
#pragma unroll
          for (int e = 0; e < 8; ++e) ss += f[e] * f[e];
          const float sq = wave_sum(lane < 32 ? ss : 0.f), sk = wave_sum((lane >= 32 && lane < 48) ? ss : 0.f);
          if (lane == 0) { rq[t] = rsqrtf(sq * (1.f / QRANK) + EPS); rkv[t] = rsqrtf(sk * (1.f / KVRANK) + EPS); }
          if (lane >= 48 && lane < 56) *(u32x4*)(kpe + (size_t)t * 64 + (lane - 48) * 8) = v; } }
}

__device__ __forceinline__ void ph2a3_v2(const Ctx& c, const Params& p) {
    const int lane = opaque_tid() & 63;
    const bf16_t* qraw = (const bf16_t*)(p.ws + OFF_R5); const bf16_t* kvraw = (const bf16_t*)(p.ws + OFF_R3); const bf16_t* kpe = (const bf16_t*)(p.ws + OFF_KPE);
    const float* rq = (const float*)(p.ws + OFF_VEC) + T; const float* rkv = rq + T;
    bf16_t* Q = (bf16_t*)p.out; bf16_t* Kk = Q + (size_t)T * MLA_H * QKD; bf16_t* V = Kk + (size_t)T * MLA_H * QKD;
    const int h = lane >> 4, cc = lane & 15, hh = (lane >> 2) & 3, pc = lane & 3;
    const float inv = expf(-(float)(lane & 31) * (9.210340371976184f / 32.f));
    for (int t = c.gw; t < T; t += c.ngw) {
        const int b = t / SEQ, s = t % SEQ; const float rqv = rq[t], rkvv = rkv[t];
        float sn, cs; sincosf((float)p.pos[t] * inv, &sn, &cs);
        const size_t qo = ((size_t)(b * MLA_H + h) * SEQ + s) * QKD, vo = ((size_t)(b * MLA_H + h) * SEQ + s) * VDIM;
        { float f[8]; unpack8(*(const u32x4*)(qraw + (size_t)t * 768 + h * 192 + cc * 8), f);
#pragma unroll
          for (int e = 0; e < 8; ++e) f[e] *= rqv;
          *(u32x4*)(Q + qo + cc * 8) = pack8(f);
          unpack8(*(const u32x4*)(kvraw + (size_t)t * 1024 + h * 256 + cc * 8), f);
#pragma unroll
          for (int e = 0; e < 8; ++e) f[e] *= rkvv;
          *(u32x4*)(Kk + qo + cc * 8) = pack8(f);
          unpack8(*(const u32x4*)(kvraw + (size_t)t * 1024 + h * 256 + 128 + cc * 8), f);
#pragma unroll
          for (int e = 0; e < 8; ++e) f[e] *= rkvv;
          *(u32x4*)(V + vo + cc * 8) = pack8(f); }
        float cs8[8], sn8[8];
#pragma unroll
        for (int e = 0; e < 8; ++e) { cs8[e] = __shfl(cs, pc * 8 + e); sn8[e] = __shfl(sn, pc * 8 + e); }
        if (lane < 16) {
            const size_t ro = ((size_t)(b * MLA_H + hh) * SEQ + s) * QKD;
            float a[8], bq[8], o1[8], o2[8];
            unpack8(*(const u32x4*)(qraw + (size_t)t * 768 + hh * 192 + 128 + pc * 8), a); unpack8(*(const u32x4*)(qraw + (size_t)t * 768 + hh * 192 + 160 + pc * 8), bq);
#pragma unroll
            for (int e = 0; e < 8; ++e) { o1[e] = (a[e] * cs8[e] - bq[e] * sn8[e]) * rqv; o2[e] = (bq[e] * cs8[e] + a[e] * sn8[e]) * rqv; }
            *(u32x4*)(Q + ro + 128 + pc * 8) = pack8(o1); *(u32x4*)(Q + ro + 160 + pc * 8) = pack8(o2);
            unpack8(*(const u32x4*)(kpe + (size_t)t * 64 + pc * 8), a); unpack8(*(const u32x4*)(kpe + (size_t)t * 64 + 32 + pc * 8), bq);
#pragma unroll
            for (int e = 0; e < 8; ++e) { o1[e] = a[e] * cs8[e] - bq[e] * sn8[e]; o2[e] = bq[e] * cs8[e] + a[e] * sn8[e]; }
            *(u32x4*)(Kk + ro + 128 + pc * 8) = pack8(o1); *(u32x4*)(Kk + ro + 160 + pc * 8) = pack8(o2);
        }
    }
}

__device__ __forceinline__ void ph4a_v2(const Ctx& c, const Params& p, bool split) {
    const int lane = opaque_tid() & 63;
    const bf16_t* Od = (const bf16_t*)(p.ws + OFF_R3); const bf16_t* omla = (const bf16_t*)(p.ws + OFF_R4);
    const bf16_t* zs = (const bf16_t*)(p.ws + OFF_R2) + (size_t)3 * T * 512; bf16_t* cat = (bf16_t*)(p.ws + OFF_R1);
    float gw8[8];
#pragma unroll
    for (int e = 0; e < 8; ++e) gw8[e] = p.gdn_norm_w[(lane & 15) * 8 + e];
    for (int t = c.gw; t < T; t += c.ngw) {
        float a[8], bb[8], z[8];
        unpack8(*(const u32x4*)(Od + (size_t)t * 512 + lane * 8), a); unpack8(*(const u32x4*)(Od + ((size_t)T + t) * 512 + lane * 8), bb); unpack8(*(const u32x4*)(zs + (size_t)t * 512 + lane * 8), z);
        float ss = 0.f;
#pragma unroll
        for (int e = 0; e < 8; ++e) { a[e] += bb[e]; ss += a[e] * a[e]; }
        ss += __shfl_xor(ss, 1); ss += __shfl_xor(ss, 2); ss += __shfl_xor(ss, 4); ss += __shfl_xor(ss, 8);
        const float r = rsqrtf(ss * (1.f / 128.f) + EPS);
#pragma unroll
        for (int e = 0; e < 8; ++e) a[e] = a[e] * r * gw8[e] * z[e];
        *(u32x4*)(cat + (size_t)t * 1024 + 512 + lane * 8) = pack8(a);
        const int s_ = t % SEQ;
        if (split && s_ >= 28 * 256) {
            const int lu = ((s_ >> 8) - 28) * 8 + (t / SEQ) * 4 + (lane >> 4), row = s_ & 255;
            const float* ml = (const float*)(p.ws + OFF_PARTML) + ((size_t)lu * 7 * 256 + row) * 2; const bf16_t* po = (const bf16_t*)(p.ws + OFF_PART) + ((size_t)lu * 7 * 256 + row) * 128 + (lane & 15) * 8;
            float mp[7], lp[7], M = -3e38f;
#pragma unroll
            for (int q = 0; q < 7; ++q) { mp[q] = ml[q * 512]; lp[q] = ml[q * 512 + 1]; M = fmaxf(M, mp[q]); }
            float o8[8], L = 0.f;
#pragma unroll
            for (int e = 0; e < 8; ++e) o8[e] = 0.f;
#pragma unroll
            for (int q = 0; q < 7; ++q) { const float w = exp2f((mp[q] - M) * (attn::SCALE * 1.4426950408889634f)); L += w * lp[q]; float f[8]; unpack8(*(const u32x4*)(po + (size_t)q * 256 * 128), f);
#pragma unroll
                for (int e = 0; e < 8; ++e) o8[e] += w * f[e]; }
            const float il = 1.f / L;
#pragma unroll
            for (int e = 0; e < 8; ++e) o8[e] *= il;
            *(u32x4*)(cat + (size_t)t * 1024 + lane * 8) = pack8(o8);
        } else
        *(u32x4*)(cat + (size_t)t * 1024 + lane * 8) = *(const u32x4*)(omla + (size_t)t * 512 + lane * 8);
    }
}


constexpr size_t OFF_HQ = OFF_R1;
constexpr size_t OFF_HSC = OFF_VEC + 3 * (size_t)T * 4;
constexpr size_t OFF_CBUF = OFF_R2;
constexpr size_t OFF_SUMSQ2 = OFF_VEC + (size_t)T * 4;
__device__ __forceinline__ float gelu_as(float v) {
    const float av = fabsf(v), t = __builtin_amdgcn_rcpf(av * 0.2316418882f + 1.0f);
    float q = t * 0.5307027145f + (-0.7265760135f); q = q * t + 0.7107068705f; q = q * t + (-0.142248368f); q = q * t + 0.127414796f; q = q * t;
    const float m = v * (q * __builtin_amdgcn_exp2f((v * v) * (-0.72134752044f)));
    return v < 0.f ? m : v - m;
}
__device__ __forceinline__ void peer_hq(const Ctx& c, const Params& p) {
    const int lane = c.lane; unsigned char* hq = p.ws + OFF_HQ; float* hsc = (float*)(p.ws + OFF_HSC);
    for (int t = c.gw; t < T; t += c.ngw) {
        const bf16_t* row = (const bf16_t*)(p.ws + OFF_R3) + (size_t)t * 1024 + 16 * lane; f32x4 hr[4]; float ssq = 0.f, mx = 0.f;
        { float f0[8], f1[8]; unpack8(*(const u32x4*)row, f0); unpack8(*(const u32x4*)(row + 8), f1);
          hr[0] = f32x4{f0[0], f0[1], f0[2], f0[3]}; hr[1] = f32x4{f0[4], f0[5], f0[6], f0[7]}; hr[2] = f32x4{f1[0], f1[1], f1[2], f1[3]}; hr[3] = f32x4{f1[4], f1[5], f1[6], f1[7]}; }
#pragma unroll
        for (int j = 0; j < 4; ++j) {
#pragma unroll
            for (int k = 0; k < 4; ++k) { ssq += hr[j][k] * hr[j][k]; mx = fmaxf(mx, fabsf(hr[j][k])); } }
        ssq = wave_sum(ssq); mx = fmaxf(wave_max(mx), 1e-30f);
        const float qinv = 127.f / mx;
        u32x4 hv; hv.x = q4(hr[0].x, hr[0].y, hr[0].z, hr[0].w, qinv, 0); hv.y = q4(hr[1].x, hr[1].y, hr[1].z, hr[1].w, qinv, 0);
        hv.z = q4(hr[2].x, hr[2].y, hr[2].z, hr[2].w, qinv, 0); hv.w = q4(hr[3].x, hr[3].y, hr[3].z, hr[3].w, qinv, 0);
        *(u32x4*)(hq + (size_t)t * 1024 + 16 * lane) = hv;
        if (lane == 0) hsc[t] = rsqrtf(ssq * (1.f / 1024.f) + EPS) * mx * (1.f / 127.f);
    }
}
template <int VAR>
__device__ __forceinline__ void peer_H3(const Ctx& c, const Params& p) {
    const int tid = opaque_tid(), lane = tid & 63, wid = __builtin_amdgcn_readfirstlane(tid >> 6), grp = lane >> 3, sub = lane & 7;
    const unsigned char* hq = p.ws + OFF_HQ; const float* hsc = (const float*)(p.ws + OFF_HSC);
    const unsigned char* u8 = p.ws + OFF_R5; const float* su = (const float*)(p.ws + OFF_SU);
    const int* experts = (const int*)(p.ws + OFF_R4); const float* gates = (const float*)(p.ws + OFF_R4 + 8 * MB);
    float* cbuf = (float*)(p.ws + OFF_CBUF);
    { float* s2 = (float*)(p.ws + OFF_SUMSQ2); for (int i = c.bid * NT + tid; i < T; i += c.nb * NT) s2[i] = 0.f; }
    const int x = c.bid & 7, nslw = ((c.nb - x + 7) >> 3) * (NT / 64), wx = (c.bid >> 3) * (NT / 64) + wid;
    int* cE = (int*)c.lds + wid * 384; float* cG = (float*)(cE + 128); int* cS = cE + 256;
    int e0n = 0, e1n = 0; float g0n = 0.f, g1n = 0.f, hsn = 0.f; u32x4 hvn[8];
#define PH_FETCH(t_) do { e0n = experts[(size_t)(t_) * 128 + lane]; e1n = experts[(size_t)(t_) * 128 + 64 + lane]; g0n = gates[(size_t)(t_) * 128 + lane]; g1n = gates[(size_t)(t_) * 128 + 64 + lane]; hsn = hsc[t_]; \
    _Pragma("unroll") for (int j_ = 0; j_ < 8; ++j_) hvn[j_] = *(const u32x4*)(hq + (size_t)(t_) * 1024 + sub * 16 + j_ * 128); } while (0)
    if (wx < T) PH_FETCH(wx);
    for (int t = wx; t < T; t += nslw) {
        const int e0 = e0n, e1 = e1n; const float g0 = g0n, g1 = g1n, hs = hsn; u32x4 hv[8];
#pragma unroll
        for (int j = 0; j < 8; ++j) hv[j] = hvn[j];
        { const int tn = t + nslw < T ? t + nslw : t; PH_FETCH(tn); }
        const bool in0 = (e0 >> 11) == x, in1 = (e1 >> 11) == x;
        const unsigned long long m0 = __ballot(in0), m1 = __ballot(in1);
        const int n0 = __popcll(m0), cnt = n0 + __popcll(m1);
        const int r0 = __builtin_amdgcn_mbcnt_hi((unsigned)(m0 >> 32), __builtin_amdgcn_mbcnt_lo((unsigned)m0, 0));
        const int r1 = n0 + __builtin_amdgcn_mbcnt_hi((unsigned)(m1 >> 32), __builtin_amdgcn_mbcnt_lo((unsigned)m1, 0));
        if (in0) { cE[r0] = e0; cG[r0] = g0; cS[r0] = lane; }
        if (in1) { cE[r1] = e1; cG[r1] = g1; cS[r1] = 64 + lane; }
        for (int b0 = 0; b0 < (VAR == 1 ? 0 : cnt); b0 += 24) {
            int me[3]; float mg[3], msu[3]; int ms[3]; u32x4 ur[3][8];
            const bool third = cnt - b0 > 16;
#pragma unroll
            for (int q = 0; q < 3; ++q) { const int ent = min(b0 + 8 * q + grp, cnt - 1); me[q] = cE[ent]; mg[q] = cG[ent]; ms[q] = cS[ent]; }
#pragma unroll
            for (int q = 0; q < 3; ++q) if (q < 2 || third) { msu[q] = su[me[q]]; const unsigned char* pr = u8 + (size_t)me[q] * 1024 + sub * 16;
#pragma unroll
                for (int j = 0; j < 8; ++j) { if (VAR == 3) ur[q][j] = hv[j]; else ur[q][j] = *(const u32x4*)(pr + j * 128); } }
            __builtin_amdgcn_sched_barrier(0);
#pragma unroll
            for (int q = 0; q < 3; ++q) if (q < 2 || third) {
                int s0 = 0, s1 = 0, s2_ = 0, s3 = 0;
                if (VAR == 2) { s0 = (int)(ur[q][0].x ^ ur[q][1].x ^ ur[q][2].x ^ ur[q][3].x ^ ur[q][4].x ^ ur[q][5].x ^ ur[q][6].x ^ ur[q][7].x); }
                else
#pragma unroll
                for (int j = 0; j < 8; ++j) { s0 = __builtin_amdgcn_sdot4((int)hv[j].x, (int)ur[q][j].x, s0, false); s1 = __builtin_amdgcn_sdot4((int)hv[j].y, (int)ur[q][j].y, s1, false);
                    s2_ = __builtin_amdgcn_sdot4((int)hv[j].z, (int)ur[q][j].z, s2_, false); s3 = __builtin_amdgcn_sdot4((int)hv[j].w, (int)ur[q][j].w, s3, false); }
                int s = (s0 + s1) + (s2_ + s3);
                s += __builtin_amdgcn_update_dpp(0, s, 0xB1, 0xf, 0xf, true);
                s += __builtin_amdgcn_update_dpp(0, s, 0x4E, 0xf, 0xf, true);
                s += __builtin_amdgcn_update_dpp(0, s, 0x141, 0xf, 0xf, true);
                const float cc = mg[q] * gelu_as(hs * msu[q] * (float)s);
                if (sub == 0 && b0 + 8 * q + grp < cnt) cbuf[(size_t)t * 128 + ms[q]] = cc;
            }
        }
    }
#undef PH_FETCH
}

__device__ __forceinline__ void peer_H4(const Ctx& c, const Params& p) {
    const int tid = opaque_tid(), lane = tid & 63, wid = __builtin_amdgcn_readfirstlane(tid >> 6), grp = lane >> 3, sub = lane & 7;
    const unsigned char* hq = p.ws + OFF_HQ; const float* hsc = (const float*)(p.ws + OFF_HSC);
    const unsigned char* u8 = p.ws + OFF_R5; const float* su = (const float*)(p.ws + OFF_SU);
    const int* experts = (const int*)(p.ws + OFF_R4); const float* gates = (const float*)(p.ws + OFF_R4 + 8 * MB);
    float* cbuf = (float*)(p.ws + OFF_CBUF);
    { float* s2 = (float*)(p.ws + OFF_SUMSQ2); for (int i = c.bid * NT + tid; i < T; i += c.nb * NT) s2[i] = 0.f; }
    const int x = c.bid & 7, nslw = ((c.nb - x + 7) >> 3) * (NT / 64), wx = (c.bid >> 3) * (NT / 64) + wid;
    int* cE = (int*)c.lds + wid * 768; float* cG = (float*)(cE + 128); int* cS = cE + 256;
    int e0n[2], e1n[2]; float g0n[2], g1n[2];
#define PH_FETCH(u_, t_) do { e0n[u_] = experts[(size_t)(t_) * 128 + lane]; e1n[u_] = experts[(size_t)(t_) * 128 + 64 + lane]; g0n[u_] = gates[(size_t)(t_) * 128 + lane]; g1n[u_] = gates[(size_t)(t_) * 128 + 64 + lane]; } while (0)
#define PH_DOT(S_, HV_, UR_) do { int s0_ = 0, s1_ = 0, s2__ = 0, s3_ = 0; \
    _Pragma("unroll") for (int j_ = 0; j_ < 8; ++j_) { s0_ = __builtin_amdgcn_sdot4((int)HV_[j_].x, (int)UR_[j_].x, s0_, false); s1_ = __builtin_amdgcn_sdot4((int)HV_[j_].y, (int)UR_[j_].y, s1_, false); \
        s2__ = __builtin_amdgcn_sdot4((int)HV_[j_].z, (int)UR_[j_].z, s2__, false); s3_ = __builtin_amdgcn_sdot4((int)HV_[j_].w, (int)UR_[j_].w, s3_, false); } \
    S_ = (s0_ + s1_) + (s2__ + s3_); \
    S_ += __builtin_amdgcn_update_dpp(0, S_, 0xB1, 0xf, 0xf, true); S_ += __builtin_amdgcn_update_dpp(0, S_, 0x4E, 0xf, 0xf, true); S_ += __builtin_amdgcn_update_dpp(0, S_, 0x141, 0xf, 0xf, true); } while (0)
#pragma unroll
    for (int u = 0; u < 2; ++u) { const int tt = wx + u * nslw < T ? wx + u * nslw : 0; PH_FETCH(u, tt); }
    for (int t = wx; t < T; t += 2 * nslw) {
        int cnt[2]; u32x4 hv[2][8]; float hs[2]; int tt[2]; bool val[2];
#pragma unroll
        for (int u = 0; u < 2; ++u) {
            val[u] = t + u * nslw < T; tt[u] = val[u] ? t + u * nslw : 0;
            const int e0 = e0n[u], e1 = e1n[u]; const float g0 = g0n[u], g1 = g1n[u];
#pragma unroll
            for (int j = 0; j < 8; ++j) hv[u][j] = *(const u32x4*)(hq + (size_t)tt[u] * 1024 + sub * 16 + j * 128);
            hs[u] = hsc[tt[u]];
            const bool in0 = (e0 >> 11) == x, in1 = (e1 >> 11) == x;
            const unsigned long long m0 = __ballot(in0), m1 = __ballot(in1);
            const int n0 = __popcll(m0); cnt[u] = n0 + __popcll(m1);
            const int r0 = __builtin_amdgcn_mbcnt_hi((unsigned)(m0 >> 32), __builtin_amdgcn_mbcnt_lo((unsigned)m0, 0));
            const int r1 = n0 + __builtin_amdgcn_mbcnt_hi((unsigned)(m1 >> 32), __builtin_amdgcn_mbcnt_lo((unsigned)m1, 0));
            int* E_ = cE + u * 384; float* G_ = cG + u * 384; int* S_ = cS + u * 384;
            if (in0) { E_[r0] = e0; G_[r0] = g0; S_[r0] = lane; }
            if (in1) { E_[r1] = e1; G_[r1] = g1; S_[r1] = 64 + lane; }
        }
#pragma unroll
        for (int u = 0; u < 2; ++u) { const int tn = t + (2 + u) * nslw; const int t2 = tn < T ? tn : 0; PH_FETCH(u, t2); }
        int me[2][2]; float mg[2][2], msu[2][2]; int ms[2][2]; u32x4 ur[2][2][8];
#pragma unroll
        for (int u = 0; u < 2; ++u)
#pragma unroll
            for (int q = 0; q < 2; ++q) { const int ent = min(8 * q + grp, max(cnt[u] - 1, 0)); me[u][q] = cE[u * 384 + ent]; mg[u][q] = cG[u * 384 + ent]; ms[u][q] = cS[u * 384 + ent];
                if (cnt[u] == 0) me[u][q] = 2048 * x;
                msu[u][q] = su[me[u][q]]; const unsigned char* pr = u8 + (size_t)me[u][q] * 1024 + sub * 16;
#pragma unroll
                for (int j = 0; j < 8; ++j) ur[u][q][j] = *(const u32x4*)(pr + j * 128); }
        __builtin_amdgcn_sched_barrier(0);
#pragma unroll
        for (int u = 0; u < 2; ++u)
#pragma unroll
            for (int q = 0; q < 2; ++q) { int s; PH_DOT(s, hv[u], ur[u][q]);
                const float cc = mg[u][q] * gelu_as(hs[u] * msu[u][q] * (float)s);
                if (sub == 0 && val[u] && 8 * q + grp < cnt[u]) cbuf[(size_t)tt[u] * 128 + ms[u][q]] = cc; }
#pragma unroll
        for (int u = 0; u < 2; ++u)
            for (int b0 = 16; b0 < cnt[u]; b0 += 8) { const int ent = min(b0 + grp, cnt[u] - 1); const int me_ = cE[u * 384 + ent]; const float mg_ = cG[u * 384 + ent]; const int ms_ = cS[u * 384 + ent];
                const float msu_ = su[me_]; const unsigned char* pr = u8 + (size_t)me_ * 1024 + sub * 16; u32x4 ux[8];
#pragma unroll
                for (int j = 0; j < 8; ++j) ux[j] = *(const u32x4*)(pr + j * 128);
                int s; PH_DOT(s, hv[u], ux);
                const float cc = mg_ * gelu_as(hs[u] * msu_ * (float)s);
                if (sub == 0 && val[u] && b0 + grp < cnt[u]) cbuf[(size_t)tt[u] * 128 + ms_] = cc; }
    }
#undef PH_FETCH
#undef PH_DOT
}
template <int DRY>
__device__ __forceinline__ void peer_O2(const Ctx& c, const Params& p) {
    typedef float f32x2 __attribute__((ext_vector_type(2)));
    const int tid = opaque_tid(), lane = tid & 63, wid = __builtin_amdgcn_readfirstlane(tid >> 6);
    const unsigned char* v8 = p.ws + OFF_R5 + (size_t)NEXP * 1024;
    const int* experts = (const int*)(p.ws + OFF_R4); const float* cbuf = (const float*)(p.ws + OFF_CBUF); float* s2 = (float*)(p.ws + OFF_SUMSQ2);
    const int x = c.bid & 7, nslw = ((c.nb - x + 7) >> 3) * (NT / 64), wx = (c.bid >> 3) * (NT / 64) + wid;
    const int grp = lane >> 3, sub = lane & 7, col = 128 * x + 16 * sub;
    const unsigned char* v8x = v8 + (size_t)x * ((size_t)NEXP * 128) + 16 * sub;
    u32x4 En[2][4];
#define PO_FETCH(u_, t_) do { _Pragma("unroll") for (int j_ = 0; j_ < 4; ++j_) En[u_][j_] = *(const u32x4*)(experts + (size_t)(t_) * 128 + grp * 16 + 4 * j_); } while (0)
#pragma unroll
    for (int u = 0; u < 2; ++u) { const int tt = wx + u * nslw < T ? wx + u * nslw : 0; PO_FETCH(u, tt); }
    for (int t = wx; t < T; t += 2 * nslw) {
        u32x4 vr[2][16]; f32x4 cv[2][4]; u32x4 hpre[2][2];
#pragma unroll
        for (int u = 0; u < 2; ++u) { const int tt = t + u * nslw < T ? t + u * nslw : 0;
#pragma unroll
            for (int j = 0; j < 2; ++j) hpre[u][j] = *(const u32x4*)((const bf16_t*)(p.ws + OFF_R3) + (size_t)tt * 1024 + col + 8 * j);
#pragma unroll
            for (int j = 0; j < 4; ++j) { cv[u][j] = *(const f32x4*)(cbuf + (size_t)tt * 128 + grp * 16 + 4 * j);
#pragma unroll
                for (int k = 0; k < 4; ++k) { int e = (int)En[u][j][k]; if (DRY == 2) e &= 7; vr[u][4 * j + k] = *(const u32x4*)(v8x + (size_t)e * 128); } } }
#pragma unroll
        for (int u = 0; u < 2; ++u) { const int tn = t + (2 + u) * nslw; const int tt = tn < T ? tn : 0; PO_FETCH(u, tt); }
        __builtin_amdgcn_sched_barrier(0);
#pragma unroll
        for (int u = 0; u < 2; ++u) {
            f32x2 acc[8];
#pragma unroll
            for (int i = 0; i < 8; ++i) acc[i] = f32x2{0.f, 0.f};
#pragma unroll
            for (int it = 0; it < 16; ++it) { const float cs_ = cv[u][it >> 2][it & 3]; const f32x2 cc = {cs_, cs_};
#pragma unroll
                for (int w = 0; w < 4; ++w) { const int q = (int)vr[u][it][w];
                    acc[2 * w] += __builtin_amdgcn_cvt_pk_f32_fp8(q, false) * cc; acc[2 * w + 1] += __builtin_amdgcn_cvt_pk_f32_fp8(q, true) * cc; } }
            float a16[16];
#pragma unroll
            for (int i = 0; i < 8; ++i) { a16[2 * i] = acc[i].x; a16[2 * i + 1] = acc[i].y; }
#pragma unroll
            for (int i = 0; i < 16; ++i) { float v = a16[i];
                v += __builtin_amdgcn_update_dpp(0.f, v, 0x128, 0xf, 0xf, true);
                { auto r = __builtin_amdgcn_permlane16_swap(__float_as_uint(v), __float_as_uint(v), false, false); v = __uint_as_float(r[0]) + __uint_as_float(r[1]); }
                { auto r = __builtin_amdgcn_permlane32_swap(__float_as_uint(v), __float_as_uint(v), false, false); v = __uint_as_float(r[0]) + __uint_as_float(r[1]); }
                a16[i] = v; }
            const int tt = t + u * nslw; float ss = 0.f;
            if (grp == 0 && tt < T) { bf16_t* hrow = (bf16_t*)(p.ws + OFF_R3) + (size_t)tt * 1024 + col;
#pragma unroll
                for (int j = 0; j < 2; ++j) { float f[8]; unpack8(hpre[u][j], f);
#pragma unroll
                    for (int k = 0; k < 8; ++k) { f[k] += a16[8 * j + k]; ss += f[k] * f[k]; }
                    if (!DRY) *(u32x4*)(hrow + 8 * j) = pack8(f); } }
            ss += __builtin_amdgcn_update_dpp(0.f, ss, 0xB1, 0xf, 0xf, true); ss += __builtin_amdgcn_update_dpp(0.f, ss, 0x4E, 0xf, 0xf, true); ss += __builtin_amdgcn_update_dpp(0.f, ss, 0x141, 0xf, 0xf, true);
            if (DRY) asm volatile("" :: "v"(ss)); else if (lane == 0 && tt < T) unsafeAtomicAdd(s2 + tt, ss);
        }
    }
#undef PO_FETCH
}
__device__ __forceinline__ void peer_N(const Ctx& c, const Params& p) {
    const int lane = c.lane; const float* s2 = (const float*)(p.ws + OFF_SUMSQ2);
    for (int t = c.gw; t < T; t += c.ngw) {
        float* row = p.out + (size_t)t * 1024 + 4 * lane; const bf16_t* hrow = (const bf16_t*)(p.ws + OFF_R3) + (size_t)t * 1024 + 4 * lane; const float r = rsqrtf(s2[t] * (1.f / 1024.f) + EPS);
#pragma unroll
        for (int j = 0; j < 4; ++j) { const u32x2 w = *(const u32x2*)(hrow + 256 * j); const f32x4 hv = {bflo(w.x), bfhi(w.x), bflo(w.y), bfhi(w.y)};
            *(f32x4*)(row + 256 * j) = hv * r * *(const f32x4*)(p.final_w + 4 * lane + 256 * j); }
    }
}

constexpr int LDS_BYTES = 144 * 1024;
__global__ void __launch_bounds__(NT, 2) fwd_megakernel(Params p) {
    extern __shared__ __attribute__((aligned(16))) unsigned char lds_raw[];
    cg::grid_group grid = cg::this_grid();
#define MKCTX() ({ Ctx c_; c_.tid = opaque_tid(); c_.lane = c_.tid & 63; c_.wave = __builtin_amdgcn_readfirstlane(c_.tid >> 6); c_.bid = blockIdx.x; c_.nb = gridDim.x; \
    c_.gw = c_.bid * (NT / 64) + c_.wave; c_.ngw = c_.nb * (NT / 64); c_.lds = (float*)lds_raw; c_; })
    Ctx c = MKCTX();
    volatile LAS unsigned* xb_st = (volatile LAS unsigned*)(lds_raw + LDS_BYTES - 16);
    if (threadIdx.x < 4) xb_st[threadIdx.x] = 0u;
    __syncthreads();
    const XcdBarrier xbar = xcd_barrier_post((unsigned*)(p.ws + OFF_BAR), xb_st);
#define GSYNC() do { xcd_barrier(xbar); c = MKCTX(); } while (0)
#define RP(k, call) for (int r_ = 0; r_ < ((PROBE_PH == (k)) ? 2 : 1); ++r_) { call; }
    if (PROBE_PH == 30 && c.tid == 0) __hip_atomic_store((unsigned*)(p.ws + OFF_BAR + 16384) + c.bid, xb_xcc_id(), __ATOMIC_RELAXED, __HIP_MEMORY_SCOPE_AGENT);
    RP(0, ph0_v2(c, p));
    if (p.ws == nullptr) grid.sync();
    GSYNC();
    RP(1, ph1_mfma(c, p)); GSYNC();
    RP(2, ph2a1_v2(c, p)); RP(3, ph2a2_v2(c, p)); GSYNC();
    RP(4, ph2a3_v2(c, p)); if (PROBE_PH == 24) ph2b_v4<1>(c, p);
    if (PROBE_PH == 25) ph2b_v4<2>(c, p);
    RP(5, ph2b_v4<0>(c, p)); GSYNC();
    const bool split = c.nb == 256; constexpr int TAB_SPLIT = NEXP / 2;
    if (split) {
        if (c.bid >= 32) { RP(6, ph3a_split(c, p)); }
        else { RP(7, ph3b_mfma<0>(c, p)); RP(9, ph4a_tables_q8(c, p, c.gw, 32 * (NT / 64), 0, TAB_SPLIT)); }
    } else {
        ph3a_mfma(c, p);
        if (c.bid < 32) ph3b_mfma<0>(c, p); else ph4a_tables_q8(c, p, (c.bid - 32) * (NT / 64) + c.wave, (c.nb - 32) * (NT / 64), 0, TAB_SPLIT);
    }
    GSYNC();
    RP(8, ph4a_v2(c, p, split)); RP(11, ph4a_tables_q8(c, p, c.gw, c.ngw, TAB_SPLIT, 2 * NEXP)); GSYNC();
    RP(10, ph4b_v2(c, p)); GSYNC();
    RP(12, ph5_v2(c, p)); GSYNC();
    RP(13, ph6_fast(c, p));
    if (PROBE_PH == 30 && c.bid == 0 && c.tid == 0) {
        const unsigned* ids = (const unsigned*)(p.ws + OFF_BAR + 16384); bool ok = true;
        for (int b_ = 0; b_ < c.nb; ++b_) ok = ok && (__hip_atomic_load(ids + b_, __ATOMIC_RELAXED, __HIP_MEMORY_SCOPE_AGENT) == __hip_atomic_load(ids + (b_ & 7), __ATOMIC_RELAXED, __HIP_MEMORY_SCOPE_AGENT));
        for (int b_ = 0; b_ < 8; ++b_) for (int c_ = 0; c_ < b_; ++c_) ok = ok && (__hip_atomic_load(ids + b_, __ATOMIC_RELAXED, __HIP_MEMORY_SCOPE_AGENT) != __hip_atomic_load(ids + c_, __ATOMIC_RELAXED, __HIP_MEMORY_SCOPE_AGENT));
        if (!ok) for (int i_ = 0; i_ < 1024 * 64; ++i_) ((float*)p.out)[i_ * 16] = 1e30f; }
    RP(17, peer_hq(c, p)); GSYNC();
    if (PROBE_PH == 26) peer_H3<1>(c, p);
    if (PROBE_PH == 27) peer_H3<2>(c, p);
    if (PROBE_PH == 28) peer_H3<3>(c, p);
    RP(18, peer_H4(c, p)); GSYNC();
    if (PROBE_PH == 19) peer_O2<1>(c, p);
    if (PROBE_PH == 22) peer_O2<2>(c, p);
    peer_O2<0>(c, p); GSYNC();
    peer_N(c, p);
    if (PROBE_PH == 15) { for (int r_ = 0; r_ < 10; ++r_) GSYNC(); }
}

extern "C" void kernel_launch(void* const* d_in, const int* in_sizes, int n_in, void* d_out, int out_size, void* d_ws, size_t ws_size, hipStream_t stream) {
    static int grid_blocks = 0;
    if (grid_blocks == 0) {
        if (n_in != 21 || out_size != T * D_MODEL || ws_size < WS_END) { fprintf(stderr, "kernel_launch: unexpected shapes n_in %d out %d ws %zu\n", n_in, out_size, ws_size); grid_blocks = -1; return; }
        int dev = 0, cus = 0, per_cu = 0;
        hipGetDevice(&dev); hipDeviceGetAttribute(&cus, hipDeviceAttributeMultiprocessorCount, dev);
        if (hipFuncSetAttribute((const void*)fwd_megakernel, hipFuncAttributeMaxDynamicSharedMemorySize, LDS_BYTES) != hipSuccess) { fprintf(stderr, "kernel_launch: hipFuncSetAttribute failed\n"); grid_blocks = -1; return; }
        if (hipOccupancyMaxActiveBlocksPerMultiprocessor(&per_cu, (const void*)fwd_megakernel, NT, LDS_BYTES) != hipSuccess || per_cu < 1) { fprintf(stderr, "kernel_launch: occupancy query failed (%d)\n", per_cu); grid_blocks = -1; return; }
        grid_blocks = cus * per_cu;
    }
    if (grid_blocks < 0) return;
    Params p{};
    p.x = (const float*)d_in[0]; p.pos = (const int*)d_in[1]; p.ln1_w = (const float*)d_in[2]; p.w_in = (const float*)d_in[3]; p.q_a_norm_w = (const float*)d_in[4];
    p.w_q_up = (const float*)d_in[5]; p.kv_a_norm_w = (const float*)d_in[6]; p.w_kv_up = (const float*)d_in[7]; p.conv_w = (const float*)d_in[8];
    p.a_log_f = (const float*)d_in[9]; p.dt_bias_f = (const float*)d_in[10]; p.a_log_b = (const float*)d_in[11]; p.dt_bias_b = (const float*)d_in[12];
    p.gdn_norm_w = (const float*)d_in[13]; p.w_out = (const float*)d_in[14]; p.ln2_w = (const float*)d_in[15]; p.peer_wq = (const float*)d_in[16];
    p.sub_keys = (const float*)d_in[17]; p.peer_u = (const float*)d_in[18]; p.peer_v = (const float*)d_in[19]; p.final_w = (const float*)d_in[20];
    p.out = (float*)d_out; p.ws = (unsigned char*)d_ws;
    if (hipMemsetAsync((char*)d_ws + OFF_BAR, 0, 16384, stream) != hipSuccess) { fprintf(stderr, "kernel_launch: memset of barrier words failed\n"); return; }
    void* args[] = {&p};
    hipError_t e = hipLaunchCooperativeKernel((const void*)fwd_megakernel, dim3(grid_blocks), dim3(NT), args, LDS_BYTES, stream);
    if (e != hipSuccess) fprintf(stderr, "cooperative launch failed: %s (grid %d)\n", hipGetErrorString(e), grid_blocks);
}
```

```cpp
#include <hip/hip_runtime.h>
#include <hip/hip_cooperative_groups.h>
#include <cstdio>
#include <cstdint>
namespace cg = cooperative_groups;

#ifndef PROBE_PH
#define PROBE_PH -1
#endif
constexpr int D_MODEL = 1024, BATCH = 2, SEQ = 8192, T = BATCH * SEQ;
constexpr int MLA_H = 4, QRANK = 256, KVRANK = 128, NOPE = 128, ROPE = 64, VDIM = 128, QKD = 192;
constexpr int GH = 4, DK = 128, DV = 128, CHUNK = 64, NCH = SEQ / CHUNK;
constexpr int GDN_QKV = 1536, IN_W = 2512, IN_WP = 2560;
constexpr int C_QKV = 448, C_Z = 1984, C_GATE = 2496;
constexpr int PH = 8, NKEYS = 128, TOPK = 16, NEXP = 16384;
constexpr float EPS = 1e-6f;
constexpr int NT = 512;

typedef unsigned short bf16_t;
typedef float f32x4 __attribute__((ext_vector_type(4)));
typedef unsigned u32x4 __attribute__((ext_vector_type(4)));
typedef unsigned u32x2 __attribute__((ext_vector_type(2)));

__device__ __forceinline__ int opaque_tid() { int t; asm volatile("v_mov_b32 %0, %1" : "=v"(t) : "v"((int)threadIdx.x)); return t; }
__device__ __forceinline__ float bf2f(bf16_t v) { return __uint_as_float((unsigned)v << 16); }
__device__ __forceinline__ bf16_t f2bf(float f) { unsigned u = __float_as_uint(f); u += 0x7fffu + ((u >> 16) & 1u); return (bf16_t)(u >> 16); }
__device__ __forceinline__ float bflo(unsigned w) { return __uint_as_float(w << 16); }
__device__ __forceinline__ float bfhi(unsigned w) { return __uint_as_float(w & 0xffff0000u); }
__device__ __forceinline__ unsigned pk2(float lo, float hi) { return (unsigned)f2bf(lo) | ((unsigned)f2bf(hi) << 16); }
__device__ __forceinline__ float wave_sum(float v) {
#pragma unroll
    for (int o = 1; o < 64; o <<= 1) v += __shfl_xor(v, o);
    return v;
}
__device__ __forceinline__ float sigmoidf_(float x) { return 1.f / (1.f + __expf(-x)); }
__device__ __forceinline__ float siluf_(float x) { return x * sigmoidf_(x); }
__device__ __forceinline__ float softplusf_(float x) { return x > 20.f ? x : log1pf(expf(x)); }
__device__ __forceinline__ float gelu_erf(float x) { return 0.5f * x * (1.f + erff(x * 0.70710678118654752f)); }

namespace pg8 {
#define PG8_LAS __attribute__((address_space(3)))
typedef unsigned short bf16_t;
typedef short bf16x8 __attribute__((ext_vector_type(8)));
typedef float f32x4 __attribute__((ext_vector_type(4)));
typedef unsigned u32x4 __attribute__((ext_vector_type(4)));
constexpr int BM = 256, BK = 64, HALF = 128, HTB = HALF * BK * 2  , STAGE_BYTES = 8 * HTB, NXCD = 8, WGM = 8;

__host__ __device__ __forceinline__ int lds_byte(int r, int c) { const int st = (r >> 4) * 2 + (c >> 5), rr = r & 15, cc = c & 31, ob = rr * 64 + cc * 2; return st * 1024 + (ob ^ (((ob >> 9) & 1) << 5)); }
__host__ __device__ __forceinline__ void stage_rc(int b, int& R, int& C) { const int st = b / 1024, sb = b % 1024, swz = sb ^ (((sb >> 9) & 1) << 5); R = (st >> 1) * 16 + swz / 64; C = (st & 1) * 32 + (swz % 64) / 2; }
__host__ __device__ __forceinline__ int perm32(int rho) { const int n = rho >> 4, i = rho & 15; return 8 * (i >> 2) + 4 * n + (i & 3); }

struct Unit { int pm, pn; };
struct Gemm { const bf16_t* A; const bf16_t* Bt; int M, N, K, lda, ldb; };

struct StaticOrder {
    int nM, nN, nwg, G, c;
    __host__ __device__ void init(int M, int N, int G_, int c_) { nM = M / BM; nN = N / BM; nwg = nM * nN; G = G_; c = c_; }
    __host__ __device__ bool next(int i, Unit& u) const {
        const long L = (long)i * G + c; if (L >= nwg) return false;
        int wgid = (int)L; { const int q = nwg / NXCD, r = nwg % NXCD, xcd = wgid % NXCD, off = wgid / NXCD; wgid = (xcd < r ? xcd * (q + 1) : r * (q + 1) + (xcd - r) * q) + off; }
        const int nig = WGM * nN, gid = wgid / nig, fm = gid * WGM, gsz = (nM - fm) < WGM ? (nM - fm) : WGM;
        u.pm = fm + ((wgid % nig) % gsz); u.pn = (wgid % nig) / gsz; return true;
    }
    __device__ __forceinline__ void a_ready(const Unit&) const {}
    __device__ __forceinline__ void done(const Unit&) const {}
};
__device__ __forceinline__ unsigned cvt_pk_bf16(float lo, float hi) { unsigned r; asm volatile("v_cvt_pk_bf16_f32 %0, %1, %2" : "=v"(r) : "v"(lo), "v"(hi)); return r; }
typedef float f32x2 __attribute__((ext_vector_type(2)));
template <class Epi, class Sched, bool ALIGN_EPI = false, bool SP2 = false>
__device__ __forceinline__ void gemm_phase(PG8_LAS unsigned char* lds, const Gemm g, const Sched& S, const Epi& E) {
    const int tid = opaque_tid(), wid = __builtin_amdgcn_readfirstlane(tid >> 6), lane = tid & 63, wr = wid >> 2, wc = wid & 3, fr = lane & 15, fq = lane >> 4;
    const int K = g.K, nt = K / BK;
    unsigned voffA[2], voffB[2];
#pragma unroll
    for (int i = 0; i < 2; ++i) { int R, C; stage_rc(tid * 16 + i * 8192, R, C); const int Rb = Epi::PERM ? ((R & ~31) + perm32(R & 31)) : R;
        voffA[i] = (unsigned)(R * g.lda + C) * 2u; voffB[i] = (unsigned)(Rb * g.ldb + C) * 2u; }
    const size_t kstep = (size_t)(BK * 2);
    const size_t hstepA = (size_t)HALF * g.lda * 2, hstepB = (size_t)HALF * g.ldb * 2;
    const size_t tstepA = 2 * hstepA, tstepB = 2 * hstepB;
    const unsigned ldsw = (unsigned)wid * 1024u;
    const int aoff = lds_byte(wr * 64 + fr, fq * 8), boff = lds_byte(wc * 32 + fr, fq * 8);
#define PG8_SA(b, h) (((b) * 2 + (h)) * HTB)
#define PG8_SB(b, h) ((4 + (b) * 2 + (h)) * HTB)
#define PG8_STAGE(bufoff, gbase, voff) do { _Pragma("unroll") for (int _i = 0; _i < 2; ++_i) \
        __builtin_amdgcn_global_load_lds((const unsigned*)((const char*)(gbase) + (voff)[_i]), (PG8_LAS unsigned*)(lds + (bufoff) + ldsw + _i * 8192), 16, 0, 0); } while (0)
#define PG8_LDA(dst, b, h) do { _Pragma("unroll") for (int m = 0; m < 4; ++m) _Pragma("unroll") for (int k = 0; k < 2; ++k) dst[m][k] = *(const PG8_LAS bf16x8*)(lds + PG8_SA(b, h) + aoff + m * 2048 + k * 1024); } while (0)
#define PG8_LDB(dst, b, h) do { _Pragma("unroll") for (int n = 0; n < 2; ++n) _Pragma("unroll") for (int k = 0; k < 2; ++k) dst[n][k] = *(const PG8_LAS bf16x8*)(lds + PG8_SB(b, h) + boff + n * 2048 + k * 1024); } while (0)
#define PG8_MMA(ai, bj, At, Bt) do { __builtin_amdgcn_s_setprio(1); _Pragma("unroll") for (int m = 0; m < 4; ++m) _Pragma("unroll") for (int n = 0; n < 2; ++n) _Pragma("unroll") for (int k = 0; k < 2; ++k) \
        acc[ai][bj][m][n] = __builtin_amdgcn_mfma_f32_16x16x32_bf16(Bt[n][k], At[m][k], acc[ai][bj][m][n], 0, 0, 0); __builtin_amdgcn_s_setprio(0); } while (0)
#define PG8_WAIT_V(n) asm volatile("s_waitcnt vmcnt(" #n ")" ::: "memory")
#define PG8_WAIT_L(n) asm volatile("s_waitcnt lgkmcnt(" #n ")" ::: "memory")
#define PG8_BAR __builtin_amdgcn_s_barrier()
#define PG8_SCHED __builtin_amdgcn_sched_barrier(0)
    Unit cur, nxt; int ui = 0;
    if (!S.next(0, cur)) return;
    f32x4 acc[2][2][4][2];
#pragma unroll
    for (int a = 0; a < 2; ++a)
#pragma unroll
        for (int b = 0; b < 2; ++b)
#pragma unroll
            for (int m = 0; m < 4; ++m)
#pragma unroll
                for (int n = 0; n < 2; ++n) acc[a][b][m][n] = (f32x4){0.f, 0.f, 0.f, 0.f};
    bf16x8 At[4][2], B0[2][2], B1[2][2];
    const char* cA = (const char*)g.A + (size_t)cur.pm * tstepA; const char* cB = (const char*)g.Bt + (size_t)cur.pn * tstepB;
    S.a_ready(cur);
    if constexpr (SP2) {
        PG8_STAGE(PG8_SB(0, 0), cB, voffB); PG8_STAGE(PG8_SB(0, 1), cB + hstepB, voffB); PG8_STAGE(PG8_SA(0, 0), cA, voffA); PG8_STAGE(PG8_SA(0, 1), cA + hstepA, voffA);
        if (wr == 1) PG8_BAR;
        PG8_WAIT_V(2); PG8_BAR;
        PG8_STAGE(PG8_SB(1, 0), cB + kstep, voffB); PG8_STAGE(PG8_SA(1, 0), cA + kstep, voffA); PG8_STAGE(PG8_SB(1, 1), cB + hstepB + kstep, voffB);
        PG8_WAIT_V(6); PG8_BAR;
    } else {
        PG8_STAGE(PG8_SB(0, 0), cB, voffB); PG8_STAGE(PG8_SA(0, 0), cA, voffA); PG8_STAGE(PG8_SB(0, 1), cB + hstepB, voffB); PG8_STAGE(PG8_SA(0, 1), cA + hstepA, voffA);
        if (wr == 1) PG8_BAR;
        PG8_WAIT_V(4); PG8_BAR;
        PG8_STAGE(PG8_SB(1, 0), cB + kstep, voffB); PG8_STAGE(PG8_SA(1, 0), cA + kstep, voffA); PG8_STAGE(PG8_SB(1, 1), cB + hstepB + kstep, voffB);
        PG8_WAIT_V(6); PG8_BAR;
    }
    for (;;) {
        const bool has_next = S.next(ui + 1, nxt);
        const char* nA = has_next ? (const char*)g.A + (size_t)nxt.pm * tstepA : cA; const char* nB = has_next ? (const char*)g.Bt + (size_t)nxt.pn * tstepB : cB;
        for (int t = 0; t < nt; t += 2) {
            const bool last = (t == nt - 2);
            const char* a1 = cA + (size_t)(t + 1) * kstep;
            const char* a2 = last ? nA : cA + (size_t)(t + 2) * kstep; const char* b2 = last ? nB : cB + (size_t)(t + 2) * kstep;
            const char* a3 = a2 + kstep; const char* b3 = b2 + kstep;
            if (last && has_next) S.a_ready(nxt);
            if constexpr (SP2) {
            PG8_LDB(B0, 0, 0); PG8_LDB(B1, 0, 1); PG8_SCHED; PG8_LDA(At, 0, 0); PG8_STAGE(PG8_SA(1, 1), a1 + hstepA, voffA);
            PG8_WAIT_V(8); PG8_WAIT_L(0); PG8_BAR; PG8_MMA(0, 0, At, B0); PG8_MMA(0, 1, At, B1); PG8_BAR; PG8_SCHED;
            PG8_LDA(At, 0, 1); PG8_STAGE(PG8_SB(0, 0), b2, voffB); PG8_STAGE(PG8_SB(0, 1), b2 + hstepB, voffB); PG8_STAGE(PG8_SA(0, 0), a2, voffA);
            PG8_WAIT_V(8); PG8_WAIT_L(0); PG8_BAR; PG8_MMA(1, 0, At, B0); PG8_MMA(1, 1, At, B1); PG8_BAR; PG8_SCHED;
            PG8_LDB(B0, 1, 0); PG8_LDB(B1, 1, 1); PG8_SCHED; PG8_LDA(At, 1, 0); PG8_STAGE(PG8_SA(0, 1), a2 + hstepA, voffA);
            PG8_WAIT_V(8); PG8_WAIT_L(0); PG8_BAR; PG8_MMA(0, 0, At, B0); PG8_MMA(0, 1, At, B1); PG8_BAR; PG8_SCHED;
            PG8_LDA(At, 1, 1); PG8_STAGE(PG8_SB(1, 0), b3, voffB); PG8_STAGE(PG8_SB(1, 1), b3 + hstepB, voffB); PG8_STAGE(PG8_SA(1, 0), a3, voffA);
            PG8_WAIT_V(8); PG8_WAIT_L(0); PG8_BAR; PG8_MMA(1, 0, At, B0); PG8_MMA(1, 1, At, B1); PG8_BAR; PG8_SCHED;
            } else {
            PG8_LDB(B0, 0, 0); PG8_SCHED; PG8_LDA(At, 0, 0); PG8_STAGE(PG8_SA(1, 1), a1 + hstepA, voffA);
            PG8_WAIT_L(8); PG8_BAR; PG8_WAIT_L(0); PG8_MMA(0, 0, At, B0); PG8_BAR; PG8_SCHED;
            PG8_LDB(B1, 0, 1); PG8_STAGE(PG8_SB(0, 0), b2, voffB);
            PG8_BAR; PG8_WAIT_L(0); PG8_MMA(0, 1, At, B1); PG8_BAR;
            PG8_LDA(At, 0, 1); PG8_STAGE(PG8_SA(0, 0), a2, voffA);
            PG8_BAR; PG8_WAIT_L(0); PG8_MMA(1, 0, At, B0); PG8_BAR; PG8_SCHED;
            PG8_STAGE(PG8_SB(0, 1), b2 + hstepB, voffB);
            PG8_WAIT_V(6); PG8_BAR; PG8_MMA(1, 1, At, B1); PG8_BAR;
            PG8_LDB(B0, 1, 0); PG8_SCHED; PG8_LDA(At, 1, 0); PG8_STAGE(PG8_SA(0, 1), a2 + hstepA, voffA);
            PG8_WAIT_L(8); PG8_BAR; PG8_WAIT_L(0); PG8_MMA(0, 0, At, B0); PG8_BAR; PG8_SCHED;
            PG8_LDB(B1, 1, 1); PG8_STAGE(PG8_SB(1, 0), b3, voffB);
            PG8_BAR; PG8_WAIT_L(0); PG8_MMA(0, 1, At, B1); PG8_BAR;
            PG8_LDA(At, 1, 1); PG8_STAGE(PG8_SA(1, 0), a3, voffA);
            PG8_BAR; PG8_WAIT_L(0); PG8_MMA(1, 0, At, B0); PG8_BAR; PG8_SCHED;
            PG8_STAGE(PG8_SB(1, 1), b3 + hstepB, voffB);
            PG8_WAIT_V(6); PG8_BAR; PG8_MMA(1, 1, At, B1); PG8_BAR;
            }
        }
        if constexpr (ALIGN_EPI) { if (wr == 0) PG8_BAR; }
        if constexpr (!Epi::AFTER_DRAIN) { E(acc, cur, wr, wc, fr, fq); S.done(cur); }
        if (!has_next) break;
#pragma unroll
        for (int a = 0; a < 2; ++a)
#pragma unroll
            for (int b = 0; b < 2; ++b)
#pragma unroll
                for (int m = 0; m < 4; ++m)
#pragma unroll
                    for (int n = 0; n < 2; ++n) acc[a][b][m][n] = (f32x4){0.f, 0.f, 0.f, 0.f};
        cur = nxt; cA = nA; cB = nB; ++ui;
        if constexpr (ALIGN_EPI) { if (wr == 1) PG8_BAR; }
    }
    PG8_WAIT_V(0);
    if constexpr (!ALIGN_EPI) { if (wr == 0) PG8_BAR; }
    PG8_BAR;
    if constexpr (Epi::AFTER_DRAIN) { E.fused(acc, cur, wr, wc, fr, fq, lds, wid, lane); S.done(cur); }
#undef PG8_SA
#undef PG8_SB
#undef PG8_STAGE
#undef PG8_LDA
#undef PG8_LDB
#undef PG8_MMA
#undef PG8_WAIT_V
#undef PG8_WAIT_L
#undef PG8_BAR
#undef PG8_SCHED
}

struct EpiScaleBf16 {
    static constexpr bool PERM = true, AFTER_DRAIN = false;
    bf16_t* O; int ldc; const float* rs;
    __device__ __forceinline__ void operator()(const f32x4 (&acc)[2][2][4][2], const Unit& u, int wr, int wc, int fr, int fq) const {
        const int row0 = u.pm * BM + wr * 64 + fr, col0 = u.pn * BM + wc * 32 + 8 * fq;
#pragma unroll
        for (int ai = 0; ai < 2; ++ai)
#pragma unroll
            for (int m = 0; m < 4; ++m) { const int r = row0 + ai * HALF + m * 16; const float sc = rs ? rs[r] : 1.f; bf16_t* rowp = O + (size_t)r * ldc + col0;
#pragma unroll
                for (int bj = 0; bj < 2; ++bj) { const f32x4 v0 = acc[ai][bj][m][0] * sc, v1 = acc[ai][bj][m][1] * sc;
                    u32x4 w; w.x = cvt_pk_bf16(v0[0], v0[1]); w.y = cvt_pk_bf16(v0[2], v0[3]); w.z = cvt_pk_bf16(v1[0], v1[1]); w.w = cvt_pk_bf16(v1[2], v1[3]);
                    *(u32x4*)(rowp + bj * HALF) = w; } }
    }
};
struct EpiResF32 {
    static constexpr bool PERM = false, AFTER_DRAIN = false;
    const float* base; float* out; int ldc;
    __device__ __forceinline__ void operator()(const f32x4 (&acc)[2][2][4][2], const Unit& u, int wr, int wc, int fr, int fq) const {
        const int row0 = u.pm * BM + wr * 64 + fr, col0 = u.pn * BM + wc * 32 + 4 * fq;
#pragma unroll
        for (int ai = 0; ai < 2; ++ai)
#pragma unroll
            for (int m = 0; m < 4; ++m) { const size_t off = (size_t)(row0 + ai * HALF + m * 16) * ldc + col0;
#pragma unroll
                for (int bj = 0; bj < 2; ++bj)
#pragma unroll
                    for (int n = 0; n < 2; ++n) { const f32x4 b = *(const f32x4*)(base + off + bj * HALF + n * 16); *(f32x4*)(out + off + bj * HALF + n * 16) = b + acc[ai][bj][m][n]; } }
    }
};
struct EpiResF32Hb {
    static constexpr bool PERM = false, AFTER_DRAIN = false;
    const float* base; float* out; bf16_t* hb; float* sumsq; int ldc;
    __device__ __forceinline__ void operator()(const f32x4 (&acc)[2][2][4][2], const Unit& u, int wr, int wc, int fr, int fq) const {
        const int row0 = u.pm * BM + wr * 64 + fr, col0 = u.pn * BM + wc * 32 + 4 * fq;
#pragma unroll
        for (int ai = 0; ai < 2; ++ai)
#pragma unroll
            for (int m = 0; m < 4; ++m) { const int r = row0 + ai * HALF + m * 16; const size_t off = (size_t)r * ldc + col0; float ss = 0.f;
#pragma unroll
                for (int bj = 0; bj < 2; ++bj)
#pragma unroll
                    for (int n = 0; n < 2; ++n) { const f32x4 o = *(const f32x4*)(base + off + bj * HALF + n * 16) + acc[ai][bj][m][n];
                        ss += o[0] * o[0] + o[1] * o[1] + o[2] * o[2] + o[3] * o[3];
                        typedef unsigned u32x2v __attribute__((ext_vector_type(2))); u32x2v w; w.x = cvt_pk_bf16(o[0], o[1]); w.y = cvt_pk_bf16(o[2], o[3]);
                        *(u32x2v*)(hb + off + bj * HALF + n * 16) = w; }
                ss += __shfl_xor(ss, 16); ss += __shfl_xor(ss, 32);
                if (fq == 0) unsafeAtomicAdd(sumsq + r, ss); }
    }
};
struct EpiMlaQ {
    static constexpr bool PERM = true, AFTER_DRAIN = false;
    bf16_t* Q; const float* rq; const float* cst;
    __device__ __forceinline__ void operator()(const f32x4 (&acc)[2][2][4][2], const Unit& u, int wr, int wc, int fr, int fq) const {
        typedef unsigned u32x2v __attribute__((ext_vector_type(2)));
        const int row0 = u.pm * BM + wr * 64 + fr;
        const int c80 = u.pn * BM + wc * 32 + 8 * fq, c81 = c80 + HALF;
        const int h0 = c80 / 192, w0 = c80 % 192, h1 = c81 / 192, w1 = c81 % 192;
#pragma unroll
        for (int ai = 0; ai < 2; ++ai)
#pragma unroll
            for (int m = 0; m < 4; ++m) { const int t = row0 + ai * HALF + m * 16, b = t >> 13, s = t & (SEQ - 1); const float sc = rq[t];
                static_assert(SEQ == 8192, "token -> (batch, position) uses shifts");
#pragma unroll
                for (int bj = 0; bj < 2; ++bj) { const int hh = bj ? h1 : h0, w = bj ? w1 : w0;
                    bf16_t* dst = Q + ((size_t)(b * 4 + hh) * SEQ + s) * 192; const f32x4 v0 = acc[ai][bj][m][0] * sc, v1 = acc[ai][bj][m][1] * sc;
                    if (w < 128) { u32x4 o; o.x = cvt_pk_bf16(v0[0], v0[1]); o.y = cvt_pk_bf16(v0[2], v0[3]); o.z = cvt_pk_bf16(v1[0], v1[1]); o.w = cvt_pk_bf16(v1[2], v1[3]); *(u32x4*)(dst + w) = o; }
                    else { const int j = (w - 128) >> 1; const f32x4 cs = *(const f32x4*)(cst + (size_t)t * 64 + j), sn = *(const f32x4*)(cst + (size_t)t * 64 + 32 + j);
                        u32x2v o1, o2;
                        o1.x = cvt_pk_bf16(v0[0] * cs[0] - v0[1] * sn[0], v0[2] * cs[1] - v0[3] * sn[1]); o1.y = cvt_pk_bf16(v1[0] * cs[2] - v1[1] * sn[2], v1[2] * cs[3] - v1[3] * sn[3]);
                        o2.x = cvt_pk_bf16(v0[1] * cs[0] + v0[0] * sn[0], v0[3] * cs[1] + v0[2] * sn[1]); o2.y = cvt_pk_bf16(v1[1] * cs[2] + v1[0] * sn[2], v1[3] * cs[3] + v1[2] * sn[3]);
                        *(u32x2v*)(dst + 128 + j) = o1; *(u32x2v*)(dst + 160 + j) = o2; } }
                asm volatile("" ::: "memory"); }
    }
};
struct EpiMlaKV {
    static constexpr bool PERM = true, AFTER_DRAIN = false;
    bf16_t* K; bf16_t* V; const float* rkv;
    __device__ __forceinline__ void operator()(const f32x4 (&acc)[2][2][4][2], const Unit& u, int wr, int wc, int fr, int fq) const {
        const int row0 = u.pm * BM + wr * 64 + fr, hh = u.pn, wc8 = wc * 32 + 8 * fq;
#pragma unroll
        for (int ai = 0; ai < 2; ++ai)
#pragma unroll
            for (int m = 0; m < 4; ++m) { const int t = row0 + ai * HALF + m * 16, b = t >> 13, s = t & (SEQ - 1); const float sc = rkv[t]; const size_t rb = (size_t)(b * 4 + hh) * SEQ + s;
#pragma unroll
                for (int bj = 0; bj < 2; ++bj) { const f32x4 v0 = acc[ai][bj][m][0] * sc, v1 = acc[ai][bj][m][1] * sc;
                    u32x4 o; o.x = cvt_pk_bf16(v0[0], v0[1]); o.y = cvt_pk_bf16(v0[2], v0[3]); o.z = cvt_pk_bf16(v1[0], v1[1]); o.w = cvt_pk_bf16(v1[2], v1[3]);
                    *(u32x4*)((bj == 0 ? K + rb * 192 : V + rb * 128) + wc8) = o; }
                asm volatile("" ::: "memory"); }
    }
};
}

#define XB_TMO      128
#define XB_XCNT(j)  (256  + 64 * (j))
#define XB_XSUB(j)  (1280 + 64 * (j))
#define XB_XGEN(j)  (2304 + 64 * (j))
#define XB_TOP      3328
#define XB_TOPGEN   3392
#define XCD_BAR_WORDS 3456
#define XB_SPIN_CAP (1u << 18)
#define LAS __attribute__((address_space(3)))

__device__ __forceinline__ unsigned xb_ld(unsigned* p)              { return __hip_atomic_load(p, __ATOMIC_RELAXED, __HIP_MEMORY_SCOPE_AGENT); }
__device__ __forceinline__ unsigned xb_add(unsigned* p, unsigned v) { return __hip_atomic_fetch_add(p, v, __ATOMIC_RELAXED, __HIP_MEMORY_SCOPE_AGENT); }
__device__ __forceinline__ unsigned xb_xcc_id() { return (unsigned)__builtin_amdgcn_s_getreg((3 << 11) | 20) & 0xFu; }
#define XB_SPIN(cond, bar) do { unsigned _sp = 0; while (cond) { __builtin_amdgcn_s_sleep(1); \
    if ((++_sp & 255u) == 0u) { if (xb_ld(&(bar)[XB_TMO])) break; if (_sp > XB_SPIN_CAP) { atomicAdd(&(bar)[XB_TMO], 1u); break; } } } } while (0)

struct XcdBarrier {
    unsigned* bar; unsigned x;
    volatile LAS unsigned* st;
};

__device__ __forceinline__ XcdBarrier xcd_barrier_post(unsigned* bar, volatile LAS unsigned* st) {
    XcdBarrier b; b.bar = bar; b.x = xb_xcc_id(); b.st = st;
    if (threadIdx.x == 0) (void)xb_add(&bar[XB_XCNT(b.x)], 1u);
    return b;
}
__device__ __forceinline__ void xcd_barrier_complete(unsigned* bar, unsigned x, unsigned& nloc, unsigned& nx) {
    const unsigned G = gridDim.x * gridDim.y * gridDim.z;
    unsigned sum, cnt, mine, sp = 0u;
    for (;;) {
        sum = 0u; cnt = 0u; mine = 0u;
#pragma unroll
        for (unsigned j = 0; j < 16; ++j) { const unsigned c = xb_ld(&bar[XB_XCNT(j)]); sum += c; cnt += (c > 0u) ? 1u : 0u; mine = (j == x) ? c : mine; }
        if (sum == G) break;
        __builtin_amdgcn_s_sleep(1);
        if ((++sp & 255u) == 0u) { if (xb_ld(&bar[XB_TMO])) break; if (sp > XB_SPIN_CAP) { atomicAdd(&bar[XB_TMO], 1u); break; } }
    }
    nloc = mine > 0u ? mine : 1u; nx = cnt > 0u ? cnt : 1u;
}

__device__ __forceinline__ void xcd_barrier(const XcdBarrier& b) {
    asm volatile("s_waitcnt vmcnt(0)" ::: "memory");
    __syncthreads();
    if (threadIdx.x == 0) {
        unsigned* bar = b.bar;
        __builtin_amdgcn_s_waitcnt(0);
        unsigned nloc = b.st[0], nx = b.st[1];
        if (nloc == 0u) { xcd_barrier_complete(bar, b.x, nloc, nx); b.st[0] = nloc; b.st[1] = nx; }
        const unsigned old = xb_add(&bar[XB_XSUB(b.x)], 1u);
        const unsigned gen = old / nloc;
        if (old + 1u == (gen + 1u) * nloc) {
            __builtin_amdgcn_fence(__ATOMIC_RELEASE, "agent");
            asm volatile("s_waitcnt vmcnt(0)" ::: "memory");
            const unsigned og = xb_add(&bar[XB_TOP], 1u);
            const unsigned tg = og / nx;
            if (og + 1u == (tg + 1u) * nx) xb_add(&bar[XB_TOPGEN], 1u);
            else XB_SPIN(xb_ld(&bar[XB_TOPGEN]) == tg, bar);
            __builtin_amdgcn_fence(__ATOMIC_ACQUIRE, "agent");
            xb_add(&bar[XB_XGEN(b.x)], 1u);
            asm volatile("s_waitcnt vmcnt(0)" ::: "memory");
        } else {
            XB_SPIN(xb_ld(&bar[XB_XGEN(b.x)]) == gen, bar);
            __builtin_amdgcn_fence(__ATOMIC_ACQUIRE, "agent");
            asm volatile("s_waitcnt vmcnt(0)" ::: "memory");
        }
    }
    __syncthreads();
}

constexpr size_t MB = 1u << 20;
constexpr size_t OFF_WIN = 0;
constexpr size_t OFF_WQUP = 5 * MB;
constexpr size_t OFF_WKVUP = 5 * MB + 512 * 1024;
constexpr size_t OFF_WOUT = 6 * MB;
constexpr size_t OFF_WPQ = 8 * MB;
constexpr size_t OFF_SUBK = 12 * MB;
constexpr size_t OFF_VEC = 12 * MB + 512 * 1024;
constexpr size_t OFF_SU = OFF_VEC + 4 * (size_t)T * 4, OFF_SV = OFF_SU + (size_t)NEXP * 4, OFF_SH = OFF_SV + (size_t)NEXP * 4;
constexpr size_t OFF_GATE = 13 * MB;
constexpr size_t OFF_BAR = 15 * MB;
constexpr size_t OFF_R1 = 16 * MB;
constexpr size_t OFF_R2 = 96 * MB;
constexpr size_t OFF_R3 = 160 * MB;
constexpr size_t OFF_R4 = 192 * MB;
constexpr size_t OFF_R5 = 208 * MB;
constexpr size_t OFF_LAT = OFF_R5;
constexpr size_t OFF_CS = OFF_R5 + 16 * MB;
constexpr size_t WS_END = 256 * MB;

struct Params {
    const float* x; const int* pos; const float *ln1_w, *w_in, *q_a_norm_w, *w_q_up, *kv_a_norm_w, *w_kv_up, *conv_w, *a_log_f, *dt_bias_f, *a_log_b,
        *dt_bias_b, *gdn_norm_w, *w_out, *ln2_w, *peer_wq, *sub_keys, *peer_u, *peer_v, *final_w;
    float* out; unsigned char* ws;
};

struct Ctx {
    int tid, lane, wave, bid, nb, gw, ngw;
    float* lds;
};

#define LDS3 ((PG8_LAS unsigned char*)c.lds)
__device__ __forceinline__ void gemm_scale_bf16(const Ctx& c, const bf16_t* A, int lda, const bf16_t* Bt, int ldb, int N, int K, bf16_t* O, int ldc, const float* rs) {
    pg8::Gemm g{A, Bt, T, N, K, lda, ldb}; pg8::StaticOrder S; S.init(T, N, c.nb, c.bid);
    pg8::EpiScaleBf16 E{O, ldc, rs};
    pg8::gemm_phase<pg8::EpiScaleBf16, pg8::StaticOrder, true, true>(LDS3, g, S, E);
}
__device__ __forceinline__ void ph1_mfma(const Ctx& c, const Params& p) {
    gemm_scale_bf16(c, (const bf16_t*)(p.ws + OFF_R2), 1024, (const bf16_t*)(p.ws + OFF_WIN), 1024, IN_WP, 1024, (bf16_t*)(p.ws + OFF_R1), IN_WP, nullptr);
}
__device__ __forceinline__ void ph2a2_v2(const Ctx& c, const Params& p) {
    const bf16_t* proj = (const bf16_t*)(p.ws + OFF_R1);
    gemm_scale_bf16(c, proj, IN_WP, (const bf16_t*)(p.ws + OFF_WQUP), 256, 768, 256, (bf16_t*)(p.ws + OFF_R5), 768, nullptr);
    gemm_scale_bf16(c, proj + 256, IN_WP, (const bf16_t*)(p.ws + OFF_WKVUP), 256, 1024, 256, (bf16_t*)(p.ws + OFF_R3), 1024, nullptr);
}
__device__ __forceinline__ void ph2a2_v3(const Ctx& c, const Params& p) {
    const bf16_t* lat = (const bf16_t*)(p.ws + OFF_LAT); const float* rq = (const float*)(p.ws + OFF_VEC) + T; const float* rkv = rq + T;
    bf16_t* Q = (bf16_t*)p.out; bf16_t* Kk = Q + (size_t)T * MLA_H * QKD; bf16_t* V = Kk + (size_t)T * MLA_H * QKD;
    { pg8::Gemm g{lat, (const bf16_t*)(p.ws + OFF_WQUP), T, 768, 256, 512, 256}; pg8::StaticOrder S; S.init(T, 768, c.nb, c.bid);
      pg8::EpiMlaQ E{Q, rq, (const float*)(p.ws + OFF_CS)};
      pg8::gemm_phase<pg8::EpiMlaQ, pg8::StaticOrder, true, true>(LDS3, g, S, E); }
    { pg8::Gemm g{lat + 256, (const bf16_t*)(p.ws + OFF_WKVUP), T, 1024, 256, 512, 256}; pg8::StaticOrder S; S.init(T, 1024, c.nb, c.bid);
      pg8::EpiMlaKV E{Kk, V, rkv};
      pg8::gemm_phase<pg8::EpiMlaKV, pg8::StaticOrder, true, true>(LDS3, g, S, E); }
}
__device__ __forceinline__ void ph4b_v2(const Ctx& c, const Params& p) {
    pg8::Gemm g{(const bf16_t*)(p.ws + OFF_R1), (const bf16_t*)(p.ws + OFF_WOUT), T, 1024, 1024, 1024, 1024}; pg8::StaticOrder S; S.init(T, 1024, c.nb, c.bid);
    pg8::EpiResF32Hb E{p.x, p.out, (bf16_t*)(p.ws + OFF_R3), (float*)(p.ws + OFF_SH), 1024};
    pg8::gemm_phase<pg8::EpiResF32Hb, pg8::StaticOrder, true, true>(LDS3, g, S, E);
}
__device__ __forceinline__ void ph5_v2(const Ctx& c, const Params& p) {
    gemm_scale_bf16(c, (const bf16_t*)(p.ws + OFF_R3), 1024, (const bf16_t*)(p.ws + OFF_WPQ), 1024, 2048, 1024, (bf16_t*)(p.ws + OFF_R2), 2048, nullptr);
}

namespace attn {
constexpr int SDEPTH = 1;
constexpr int NW = 8, QBLK = 32, KVBLK = 64, LDQ = 192, LDK = 192, LDV = 128, LDO = 512;
constexpr float SCALE = 0.07216878364870322f;
constexpr float THR = 8.f;
constexpr size_t SHM_V = KVBLK * 128 * 2, SHM_K = KVBLK * 192 * 2, SHM_ATTN = 2 * SHM_V + 2 * SHM_K + NW * 64 * 4 + NW * 6144;
constexpr int QREG = 6;
using bf16 = unsigned short;
using bf16x8 = __attribute__((ext_vector_type(8))) short;
using s16x4  = __attribute__((ext_vector_type(4))) short;
using f32x16 = __attribute__((ext_vector_type(16))) float;
using f32x8  = __attribute__((ext_vector_type(8))) float;
using u32x4a = __attribute__((ext_vector_type(4))) unsigned;
#define KSWZ(row, colB) ((row) * 384 + ((colB) ^ ((((row) >> 1) & 7) << 4)))
#define SBAR() __builtin_amdgcn_sched_barrier(0)
__device__ __forceinline__ int crow(int r, int hi) { return (r & 3) + 8 * (r >> 2) + 4 * hi; }
__device__ __forceinline__ unsigned cvtpk(float lo, float hi) {
  unsigned r; asm volatile("v_cvt_pk_bf16_f32 %0, %1, %2" : "=v"(r) : "v"(lo), "v"(hi)); return r;
}
__device__ __forceinline__ void partialSM(f32x16& p0, f32x16& p1, float& m_reg, float& mn, float& alpha) {
  constexpr float C = SCALE * 1.4426950408889634f;
  float pmax = p0[0]; for (int r = 1; r < 16; ++r) pmax = fmaxf(pmax, p0[r]); for (int r = 0; r < 16; ++r) pmax = fmaxf(pmax, p1[r]);
  { auto rr = __builtin_amdgcn_permlane32_swap(__float_as_uint(pmax), __float_as_uint(pmax), false, false);
    pmax = fmaxf(__uint_as_float(rr[0]), __uint_as_float(rr[1])); }
  if (__builtin_expect(__all(pmax - m_reg <= THR / SCALE), 1)) { mn = m_reg; alpha = 1.f; }
  else { mn = fmaxf(m_reg, pmax); alpha = __builtin_amdgcn_exp2f((m_reg - mn) * C); m_reg = mn; }
  float mnC = -mn * C;
  for (int r = 0; r < 16; ++r) p0[r] = fmaf(p0[r], C, mnC); for (int r = 0; r < 16; ++r) p1[r] = fmaf(p1[r], C, mnC);
  for (int r = 0; r < 16; ++r) p0[r] = __builtin_amdgcn_exp2f(p0[r]);
}
__device__ __forceinline__ void finishSM(f32x16& p0, f32x16& p1, float alpha, float& l_reg, bf16x8& pa0, bf16x8& pa1, bf16x8& pa2, bf16x8& pa3) {
  for (int r = 0; r < 16; ++r) p1[r] = __builtin_amdgcn_exp2f(p1[r]);
  float ps = 0; for (int r = 0; r < 16; ++r) ps += p0[r]; for (int r = 0; r < 16; ++r) ps += p1[r];
  { auto rr = __builtin_amdgcn_permlane32_swap(__float_as_uint(ps), __float_as_uint(ps), false, false);
    ps = __uint_as_float(rr[0]) + __uint_as_float(rr[1]); }
  l_reg = l_reg * alpha + ps;
#define PK4(P, BASE, OUT) do { unsigned a0 = cvtpk(P[BASE + 0], P[BASE + 1]), a1 = cvtpk(P[BASE + 2], P[BASE + 3]);   \
    unsigned b0 = cvtpk(P[BASE + 4], P[BASE + 5]), b1 = cvtpk(P[BASE + 6], P[BASE + 7]);                              \
    auto r0 = __builtin_amdgcn_permlane32_swap(a0, b0, false, false); auto r1 = __builtin_amdgcn_permlane32_swap(a1, b1, false, false); \
    u32x4a w = {r0[0], r1[0], r0[1], r1[1]}; OUT = *reinterpret_cast<bf16x8*>(&w); } while (0)
  PK4(p0, 0, pa0); PK4(p0, 8, pa1); PK4(p1, 0, pa2); PK4(p1, 8, pa3);
#undef PK4
}
__device__ __forceinline__ void qkt(f32x16& p0, f32x16& p1, const bf16* Ks, const bf16x8* qr, const bf16x8* qro, int r32, int hi) {
  p0 = f32x16{}; p1 = f32x16{};
  for (int d0 = 0; d0 < 12; ++d0) { int cb = (d0 * 16 + hi * 8) * 2;
    bf16x8 b0 = *reinterpret_cast<const bf16x8*>((const char*)Ks + KSWZ(r32, cb));
    bf16x8 b1 = *reinterpret_cast<const bf16x8*>((const char*)Ks + KSWZ(32 + r32, cb));
    const bf16x8 qf = d0 < QREG ? qr[d0 < QREG ? d0 : 0] : qro[(d0 - QREG) * 64];
    p0 = __builtin_amdgcn_mfma_f32_32x32x16_bf16(b0, qf, p0, 0, 0, 0);
    p1 = __builtin_amdgcn_mfma_f32_32x32x16_bf16(b1, qf, p1, 0, 0, 0); }
}
__device__ __forceinline__ int v_st(int k, int c) { const int kk = (k & ~0xC) | ((k & 4) << 1) | ((k & 8) >> 1); return ((kk >> 3) * 4 + (c >> 5)) * 512 + ((kk & 7) * 32 + (c & 31)) * 2; }
__device__ __forceinline__ int v_rd_base(int lane) { return ((lane & 3) << 3) | (((lane >> 2) & 3) << 6) | (((lane >> 4) & 1) << 5) | (((lane >> 5) & 1) << 8); }
constexpr int v_rd_off(int d0, int ks, int half) { return d0 * 512 + ks * 4096 + half * 2048; }
template <int OFF> __device__ __forceinline__ s16x4 tr_read(int vb) {
  s16x4 r; asm volatile("ds_read_b64_tr_b16 %0, %1 offset:%2" : "=&v"(r) : "v"(vb), "i"(OFF) : "memory"); return r;
}
template <int D0> __device__ __forceinline__ void pv_one(f32x16& od, int vb, bf16x8 pa0, bf16x8 pa1, bf16x8 pa2, bf16x8 pa3) {
  const s16x4 l0 = tr_read<v_rd_off(D0, 0, 0)>(vb), h0 = tr_read<v_rd_off(D0, 0, 1)>(vb), l1 = tr_read<v_rd_off(D0, 1, 0)>(vb), h1 = tr_read<v_rd_off(D0, 1, 1)>(vb);
  const s16x4 l2 = tr_read<v_rd_off(D0, 2, 0)>(vb), h2 = tr_read<v_rd_off(D0, 2, 1)>(vb), l3 = tr_read<v_rd_off(D0, 3, 0)>(vb), h3 = tr_read<v_rd_off(D0, 3, 1)>(vb);
  asm volatile("s_waitcnt lgkmcnt(0)" ::: "memory"); SBAR();
#define PK(L, H) (bf16x8){L[0], L[1], L[2], L[3], H[0], H[1], H[2], H[3]}
  od = __builtin_amdgcn_mfma_f32_32x32x16_bf16(pa0, PK(l0, h0), od, 0, 0, 0);
  od = __builtin_amdgcn_mfma_f32_32x32x16_bf16(pa1, PK(l1, h1), od, 0, 0, 0);
  od = __builtin_amdgcn_mfma_f32_32x32x16_bf16(pa2, PK(l2, h2), od, 0, 0, 0);
  od = __builtin_amdgcn_mfma_f32_32x32x16_bf16(pa3, PK(l3, h3), od, 0, 0, 0);
#undef PK
}
__device__ __forceinline__ void pv_d0(f32x16* o, int vb, bf16x8 pa0, bf16x8 pa1, bf16x8 pa2, bf16x8 pa3) {
  pv_one<0>(o[0], vb, pa0, pa1, pa2, pa3); pv_one<1>(o[1], vb, pa0, pa1, pa2, pa3); pv_one<2>(o[2], vb, pa0, pa1, pa2, pa3); pv_one<3>(o[3], vb, pa0, pa1, pa2, pa3);
}


template <bool PARTIAL>
__device__ __forceinline__ void attn_dense_body(const bf16* __restrict__ Qb, const bf16* __restrict__ Kh, const bf16* __restrict__ Vh,
                                                bf16* __restrict__ Ob, int seq, char* lds, float* __restrict__ ML = nullptr) {
  const int tid = opaque_tid(), wid = __builtin_amdgcn_readfirstlane(tid >> 6), lane = tid & 63, r32 = lane & 31, hi = lane >> 5;
  bf16* V_lds = (bf16*)lds; bf16* K_lds = (bf16*)(lds + 2 * SHM_V);
  float* ws = (float*)(lds + 2 * SHM_V + 2 * SHM_K) + wid * 64; float* li_l = ws; float* al_l = ws + 32;
  float m_reg = -1e30f, l_reg = 0; f32x16 o[4] = {}; bf16x8 qr[QREG];
  const bf16* Qw = Qb + (long)(wid * QBLK + r32) * LDQ + hi * 8;
#pragma unroll
  for (int d0 = 0; d0 < QREG; ++d0) qr[d0] = *reinterpret_cast<const bf16x8*>(Qw + d0 * 16);
  bf16x8* qro = (bf16x8*)(lds + 2 * SHM_V + 2 * SHM_K + NW * 64 * 4) + wid * 384 + lane;
#pragma unroll
  for (int d0 = QREG; d0 < 12; ++d0) qro[(d0 - QREG) * 64] = *reinterpret_cast<const bf16x8*>(Qw + d0 * 16);
  const int sr = tid >> 4, sc = (tid & 15) * 8, vst0 = v_st(sr, sc), vst1 = v_st(32 + sr, sc);
  const int vb0 = (int)(uintptr_t)V_lds + v_rd_base(lane);
  const int kr0 = tid / 24, kc0 = (tid % 24) * 16, kr1 = (tid + 512) / 24, kc1 = ((tid + 512) % 24) * 16, kr2 = (tid + 1024) / 24, kc2 = ((tid + 1024) % 24) * 16;
  const int kst0 = KSWZ(kr0, kc0), kst1 = KSWZ(kr1, kc1), kst2 = KSWZ(kr2, kc2);
  struct { bf16x8 vs0, vs1, ks0, ks1, ks2; } sr_[SDEPTH];
#define SLOAD(i, k0) do { sr_[i].vs0 = *(const bf16x8*)(&Vh[(long)((k0) + sr) * LDV + sc]); sr_[i].vs1 = *(const bf16x8*)(&Vh[(long)((k0) + 32 + sr) * LDV + sc]); \
    const bf16* kt_ = Kh + (long)(k0) * LDK + tid * 8; sr_[i].ks0 = *(const bf16x8*)(kt_); sr_[i].ks1 = *(const bf16x8*)(kt_ + 4096); sr_[i].ks2 = *(const bf16x8*)(kt_ + 8192); } while (0)
#define SWRITE(b, i) do { *(bf16x8*)((char*)V_lds + (b) * SHM_V + vst0) = sr_[i].vs0;          \
    *(bf16x8*)((char*)V_lds + (b) * SHM_V + vst1) = sr_[i].vs1;                                 \
    *(bf16x8*)((char*)K_lds + (b) * SHM_K + kst0) = sr_[i].ks0;                                 \
    *(bf16x8*)((char*)K_lds + (b) * SHM_K + kst1) = sr_[i].ks1;                                 \
    *(bf16x8*)((char*)K_lds + (b) * SHM_K + kst2) = sr_[i].ks2; } while (0)
#define SWAIT() do { if constexpr (SDEPTH == 2) asm volatile("s_waitcnt vmcnt(5)" ::: "memory"); else asm volatile("s_waitcnt vmcnt(0)" ::: "memory"); } while (0)
#define RESC(a) do { if (__any((a) < 1.f)) { if (hi == 0) al_l[r32] = (a); asm volatile("s_waitcnt lgkmcnt(0)" ::: "memory"); \
    for (int d = 0; d < 4; ++d) for (int r = 0; r < 16; ++r) o[d][r] *= al_l[crow(r, hi)]; } } while (0)
  f32x16 pA0, pA1, pB0, pB1; float mnA, mnB, alA, alB; bf16x8 pa0, pa1, pa2, pa3; const int NT = seq / KVBLK;
  constexpr int SE = 0, SO = SDEPTH - 1;
  SLOAD(SE, 0); asm volatile("s_waitcnt vmcnt(0)" ::: "memory"); SWRITE(0, SE); __syncthreads();
  qkt(pA0, pA1, K_lds, qr, qro, r32, hi); partialSM(pA0, pA1, m_reg, mnA, alA);
  SLOAD(SO, KVBLK); if constexpr (SDEPTH == 2) { if (2 < NT) SLOAD(SE, 2 * KVBLK); }
  SWAIT(); SWRITE(1, SO); __syncthreads();
  for (int j = 1; j + 1 < NT; j += 2) {
    SBAR(); qkt(pB0, pB1, (bf16*)((char*)K_lds + SHM_K), qr, qro, r32, hi);
    finishSM(pA0, pA1, alA, l_reg, pa0, pa1, pa2, pa3); SBAR();
    SLOAD(SO, (j + SDEPTH) * KVBLK); SBAR();
    pv_d0(o, vb0, pa0, pa1, pa2, pa3); partialSM(pB0, pB1, m_reg, mnB, alB);
    __syncthreads(); SWAIT(); SWRITE(0, SE);
    RESC(alB); __syncthreads();
    SBAR(); qkt(pA0, pA1, K_lds, qr, qro, r32, hi);
    finishSM(pB0, pB1, alB, l_reg, pa0, pa1, pa2, pa3); SBAR();
    if (SDEPTH == 1 || j + 3 < NT) SLOAD(SE, (j + 1 + SDEPTH) * KVBLK); SBAR();
    pv_d0(o, vb0 + (int)SHM_V, pa0, pa1, pa2, pa3); partialSM(pA0, pA1, m_reg, mnA, alA);
    __syncthreads(); SWAIT(); SWRITE(1, SO);
    RESC(alA); __syncthreads();
  }
  SBAR(); qkt(pB0, pB1, (bf16*)((char*)K_lds + SHM_K), qr, qro, r32, hi);
  finishSM(pA0, pA1, alA, l_reg, pa0, pa1, pa2, pa3); SBAR();
  pv_d0(o, vb0, pa0, pa1, pa2, pa3); partialSM(pB0, pB1, m_reg, mnB, alB);
  __syncthreads(); RESC(alB);
  finishSM(pB0, pB1, alB, l_reg, pa0, pa1, pa2, pa3); SBAR();
  pv_d0(o, vb0 + (int)SHM_V, pa0, pa1, pa2, pa3);
  if constexpr (PARTIAL) {
    if (hi == 0) { ML[(wid * QBLK + r32) * 2] = m_reg; ML[(wid * QBLK + r32) * 2 + 1] = l_reg; }
    bf16* Ow = Ob + (long)(wid * QBLK) * 128;
#pragma unroll
    for (int r = 0; r < 16; ++r) { int orow = crow(r, hi);
      for (int d0 = 0; d0 < 4; ++d0) Ow[(long)orow * 128 + d0 * 32 + r32] = (bf16)(cvtpk(o[d0][r], 0.f) & 0xffffu); }
  } else {
  if (hi == 0) li_l[r32] = l_reg; asm volatile("s_waitcnt lgkmcnt(0)" ::: "memory");
  float rli[16];
#pragma unroll
  for (int r = 0; r < 16; ++r) rli[r] = __builtin_amdgcn_rcpf(li_l[crow(r, hi)]);
  bf16* Ow = Ob + (long)(wid * QBLK) * LDO;
#pragma unroll
  for (int r = 0; r < 16; ++r) { int orow = crow(r, hi);
    for (int d0 = 0; d0 < 4; ++d0) Ow[(long)orow * LDO + d0 * 32 + r32] = (bf16)(cvtpk(o[d0][r] * rli[r], 0.f) & 0xffffu); }
  }
  __syncthreads();
#undef SLOAD
#undef SWRITE
#undef SWAIT
#undef RESC
}

}

__device__ __forceinline__ void ph3a_mfma(const Ctx& c, const Params& p) {
    const bf16_t* Q = (const bf16_t*)p.out; const bf16_t* Kk = Q + (size_t)T * MLA_H * QKD; const bf16_t* V = Kk + (size_t)T * MLA_H * QKD;
    bf16_t* omla = (bf16_t*)(p.ws + OFF_R4);
    for (int unit = c.bid; unit < BATCH * MLA_H * (SEQ / 256); unit += c.nb) {
        const int bh = unit & 7, qb = unit >> 3, b = bh >> 2, h = bh & 3;
        const size_t base = (size_t)bh * SEQ;
        attn::attn_dense_body<false>(Q + (base + qb * 256) * QKD, Kk + base * QKD, V + base * VDIM, omla + (size_t)(b * SEQ + qb * 256) * 512 + h * 128, SEQ, (char*)c.lds);
    }
}
constexpr size_t OFF_PART = 240 * MB, OFF_PARTML = 255 * MB;
__device__ __forceinline__ void ph3a_split(const Ctx& c, const Params& p) {
    const bf16_t* Q = (const bf16_t*)p.out; const bf16_t* Kk = Q + (size_t)T * MLA_H * QKD; const bf16_t* V = Kk + (size_t)T * MLA_H * QKD;
    bf16_t* omla = (bf16_t*)(p.ws + OFF_R4);
    const int j = c.bid - 32, bh = j & 7, b = bh >> 2, h = bh & 3; const size_t base = (size_t)bh * SEQ;
    { const int qb = j >> 3;
      attn::attn_dense_body<false>(Q + (base + qb * 256) * QKD, Kk + base * QKD, V + base * VDIM, omla + (size_t)(b * SEQ + qb * 256) * 512 + h * 128, SEQ, (char*)c.lds); }
    { const int r = j >> 3, qb = 28 + r / 7, part = r % 7, k0 = part * 18 * 64, nk = (part == 6 ? 20 : 18) * 64, lu = (qb - 28) * 8 + bh;
      attn::attn_dense_body<true>(Q + (base + qb * 256) * QKD, Kk + (base + k0) * QKD, V + (base + k0) * VDIM, (bf16_t*)(p.ws + OFF_PART) + ((size_t)(lu * 7 + part) * 256) * 128, nk,
                                  (char*)c.lds, (float*)(p.ws + OFF_PARTML) + (size_t)(lu * 7 + part) * 512); }
}


namespace pk {
typedef float f32x16 __attribute__((ext_vector_type(16)));
typedef short bf16x8 __attribute__((ext_vector_type(8)));
__device__ __forceinline__ int f2ord(float f) { const int b = __float_as_int(f); return b ^ ((b >> 31) & 0x7fffffff); }
__device__ __forceinline__ float ord2f(int k) { return __int_as_float(k ^ ((k >> 31) & 0x7fffffff)); }
__device__ __forceinline__ void ce(int& a, int& b) { const int mx = max(a, b), mn = min(a, b); a = mx; b = mn; }
__device__ __forceinline__ void sort16(int (&v)[16]) {
#pragma unroll
    for (int k = 2; k <= 16; k <<= 1)
#pragma unroll
        for (int j = k >> 1; j > 0; j >>= 1)
#pragma unroll
            for (int i = 0; i < 16; ++i) { const int l = i ^ j; if (l > i) { if ((i & k) == 0) ce(v[i], v[l]); else ce(v[l], v[i]); } }
}
__device__ __forceinline__ void merge16(int (&v)[16]) {
#pragma unroll
    for (int j = 8; j > 0; j >>= 1)
#pragma unroll
        for (int i = 0; i < 16; ++i) { const int l = i ^ j; if (l > i) ce(v[i], v[l]); }
}
__device__ __forceinline__ void top_merge(int (&best)[16], int (&g)[16]) {
#pragma unroll
    for (int i = 0; i < 16; ++i) best[i] = max(best[i], g[15 - i]);
    merge16(best);
}
__device__ __forceinline__ int lookup16(unsigned long long lo, unsigned long long hi8, int i) {
    const unsigned long long s = (i & 8) ? hi8 : lo;
    return (int)((s >> ((i & 7) * 8)) & 0xffull);
}
}
__device__ __forceinline__ void ph6_fast(const Ctx& c, const Params& p) {
    using namespace pk;
    const int tid = opaque_tid(), wid = __builtin_amdgcn_readfirstlane(tid >> 6), lane = tid & 63, r32 = lane & 31, hi = lane >> 5;
    const bf16_t* qp = (const bf16_t*)(p.ws + OFF_R2); const bf16_t* subk = (const bf16_t*)(p.ws + OFF_SUBK);
    int* experts = (int*)(p.ws + OFF_R4); float* gates = (float*)(p.ws + OFF_R4 + 8 * MB);
    char* lds = (char*)c.lds;
    constexpr int NU = PH * (T / 256);
    const int per = (NU + c.nb - 1) / c.nb;
    int cur_h = -1;
    for (int ui = 0; ui < per; ++ui) {
        const int u = c.bid * per + ui; if (u >= NU) break;
        const int h = u / (T / 256), t0 = (u % (T / 256)) * 256;
        if (h != cur_h) {
            __syncthreads();
            for (int ch = tid; ch < 4096; ch += NT) { const int row = ch >> 4, cb = (ch & 15) * 16;
                const u32x4 v = *(const u32x4*)(subk + (size_t)h * 32768 + (size_t)row * 128 + (cb >> 1));
                *(u32x4*)(lds + row * 256 + (cb ^ ((row & 7) << 4))) = v; }
            __syncthreads(); cur_h = h;
        }
        const int t = t0 + wid * 32 + r32;
        int A[2][16];
#pragma unroll
        for (int pp = 0; pp < 2; ++pp) {
            bf16x8 bq[8];
#pragma unroll
            for (int ks = 0; ks < 8; ++ks) bq[ks] = *(const bf16x8*)(qp + (size_t)t * 2048 + h * 256 + pp * 128 + ks * 16 + hi * 8);
            f32x16 acc[4];
#pragma unroll
            for (int kt = 0; kt < 4; ++kt) acc[kt] = f32x16{};
#pragma unroll
            for (int ks = 0; ks < 8; ++ks)
#pragma unroll
                for (int kt = 0; kt < 4; ++kt) { const int row = pp * 128 + kt * 32 + r32, cb = (ks * 16 + hi * 8) * 2;
                    const bf16x8 a = *(const bf16x8*)(lds + row * 256 + (cb ^ ((row & 7) << 4)));
                    acc[kt] = __builtin_amdgcn_mfma_f32_32x32x16_bf16(a, bq[ks], acc[kt], 0, 0, 0); }
            int best[16], g[16];
#pragma unroll
            for (int kt = 0; kt < 4; ++kt) {
#pragma unroll
                for (int r = 0; r < 16; ++r) { const int idx = kt * 32 + (r & 3) + 8 * (r >> 2) + 4 * hi; const int k = (f2ord(acc[kt][r]) & ~127) | idx; if (kt == 0) best[r] = k; else g[r] = k; }
                if (kt == 0) sort16(best); else { sort16(g); top_merge(best, g); }
            }
#pragma unroll
            for (int i = 0; i < 16; ++i) g[i] = __shfl_xor(best[i], 32);
            top_merge(best, g);
#pragma unroll
            for (int i = 0; i < 16; ++i) A[pp][i] = best[i];
        }
        constexpr int CI[50] = {0,0,0,0,0,0,0,0,0,0,0,0,0,0,0,0,1,1,1,1,1,1,1,1,2,2,2,2,2,3,3,3,3,4,4,4,5,5,6,6,7,7,8,9,10,11,12,13,14,15};
        constexpr int CJ[50] = {0,1,2,3,4,5,6,7,8,9,10,11,12,13,14,15,0,1,2,3,4,5,6,7,0,1,2,3,4,0,1,2,3,0,1,2,0,1,0,1,0,1,0,0,0,0,0,0,0,0};
        float fa[16], fb[16]; unsigned long long wa0 = 0, wa1 = 0, wb0 = 0, wb1 = 0;
#pragma unroll
        for (int i = 0; i < 16; ++i) { fa[i] = ord2f(A[0][i] & ~127); fb[i] = ord2f(A[1][i] & ~127);
            if (i < 8) { wa0 |= (unsigned long long)(A[0][i] & 127) << (i * 8); wb0 |= (unsigned long long)(A[1][i] & 127) << (i * 8); }
            else { wa1 |= (unsigned long long)(A[0][i] & 127) << ((i - 8) * 8); wb1 |= (unsigned long long)(A[1][i] & 127) << ((i - 8) * 8); } }
        int best[16], g[16];
#pragma unroll
        for (int gi = 0; gi < 4; ++gi) {
#pragma unroll
            for (int r = 0; r < 16; ++r) { const int n = gi * 16 + r; int k = (int)0x80000000;
                if (n < 50) k = (f2ord(fa[CI[n < 50 ? n : 0]] + fb[CJ[n < 50 ? n : 0]]) & ~255) | (CI[n < 50 ? n : 0] << 4) | CJ[n < 50 ? n : 0];
                if (gi == 0) best[r] = k; else g[r] = k; }
            if (gi == 0) sort16(best); else { sort16(g); top_merge(best, g); }
        }
        float fs[16]; int fe[16]; float sum = 0.f; const float s0 = ord2f(best[0] & ~255);
        const float rs2 = rsqrtf(((const float*)(p.ws + OFF_SH))[t] * (1.f / 1024.f) + EPS);
#pragma unroll
        for (int k = 0; k < 16; ++k) { const int code = best[k] & 255; fe[k] = lookup16(wa0, wa1, code >> 4) * NKEYS + lookup16(wb0, wb1, code & 15);
            fs[k] = __expf((ord2f(best[k] & ~255) - s0) * rs2); sum += fs[k]; }
        const float inv = 1.f / sum;
        if (hi == 0) { int* eo = experts + (size_t)t * 128 + h * 16;
#pragma unroll
            for (int k = 0; k < 16; k += 4) *(u32x4*)(eo + k) = u32x4{(unsigned)fe[k], (unsigned)fe[k + 1], (unsigned)fe[k + 2], (unsigned)fe[k + 3]}; }
        else { float* go = gates + (size_t)t * 128 + h * 16;
#pragma unroll
            for (int k = 0; k < 16; k += 4) *(f32x4*)(go + k) = f32x4{fs[k] * inv, fs[k + 1] * inv, fs[k + 2] * inv, fs[k + 3] * inv}; }
    }
    __syncthreads();
}


__device__ __forceinline__ float wave_max(float v) {
#pragma unroll
    for (int o = 1; o < 64; o <<= 1) v = fmaxf(v, __shfl_xor(v, o));
    return v;
}
__device__ __forceinline__ unsigned q4(float a, float b, float cc, float d, float inv, int off) {
    const int x = (int)rintf(a * inv) + off, y = (int)rintf(b * inv) + off, z = (int)rintf(cc * inv) + off, w = (int)rintf(d * inv) + off;
    return (unsigned)(x & 255) | ((unsigned)(y & 255) << 8) | ((unsigned)(z & 255) << 16) | ((unsigned)(w & 255) << 24);
}
__device__ __forceinline__ void quant_row(const float* row, const float* mul, int lane, unsigned char* dst, float* scale_out, int off) {
    f32x4 v[4]; float mx = 0.f;
#pragma unroll
    for (int j = 0; j < 4; ++j) { v[j] = *(const f32x4*)(row + 16 * lane + 4 * j); if (mul) v[j] = v[j] * *(const f32x4*)(mul + 16 * lane + 4 * j);
        mx = fmaxf(mx, fmaxf(fmaxf(fabsf(v[j].x), fabsf(v[j].y)), fmaxf(fabsf(v[j].z), fabsf(v[j].w)))); }
    mx = fmaxf(wave_max(mx), 1e-30f);
    const float inv = 127.f / mx;
    u32x4 o; o.x = q4(v[0].x, v[0].y, v[0].z, v[0].w, inv, off); o.y = q4(v[1].x, v[1].y, v[1].z, v[1].w, inv, off);
    o.z = q4(v[2].x, v[2].y, v[2].z, v[2].w, inv, off); o.w = q4(v[3].x, v[3].y, v[3].z, v[3].w, inv, off);
    *(u32x4*)(dst + 16 * lane) = o;
    if (lane == 0) *scale_out = mx * (1.f / 127.f);
}
__device__ __forceinline__ void fp8_row(const float* row, int lane, unsigned char* dst) {
    u32x4 o;
#pragma unroll
    for (int j = 0; j < 4; ++j) { const f32x4 v = *(const f32x4*)(row + 16 * lane + 4 * j);
        int w = __builtin_amdgcn_cvt_pk_fp8_f32(v.x, v.y, 0, false); w = __builtin_amdgcn_cvt_pk_fp8_f32(v.z, v.w, w, true); o[j] = (unsigned)w; }
    *(u32x4*)(dst + (size_t)(lane >> 3) * ((size_t)NEXP * 128) + (lane & 7) * 16) = o;
}
__device__ __forceinline__ void ph4a_tables_q8(const Ctx& c, const Params& p, int gw, int ngw, int r_lo, int r_hi) {
    unsigned char* u8 = p.ws + OFF_R5; unsigned char* v8 = u8 + (size_t)NEXP * 1024;
    float* su = (float*)(p.ws + OFF_SU); float* sv = (float*)(p.ws + OFF_SV);
    for (int r = r_lo + gw; r < r_hi; r += ngw) {
        if (r < NEXP) quant_row(p.peer_u + (size_t)r * 1024, p.ln2_w, c.lane, u8 + (size_t)r * 1024, su + r, 0);
        else { const int e = r - NEXP; fp8_row(p.peer_v + (size_t)e * 1024, c.lane, v8 + (size_t)e * 128); }
    }
}


namespace gdn {
typedef short bf16x8 __attribute__((ext_vector_type(8)));
typedef short s16x4 __attribute__((ext_vector_type(4)));
typedef float f32x4v __attribute__((ext_vector_type(4)));
typedef float f32x2c __attribute__((ext_vector_type(2))); typedef __bf16 bf16x2c __attribute__((ext_vector_type(2)));
__device__ __forceinline__ unsigned cvtpk(float lo, float hi) { const f32x2c v = {lo, hi}; const bf16x2c r = __builtin_convertvector(v, bf16x2c); return *(const unsigned*)&r; }
__device__ __forceinline__ int wperm(int d) { const int x = d & 31; return (d & ~31) | (8 * ((x >> 2) & 3) + 4 * (x >> 4) + (x & 3)); }
}
__device__ __forceinline__ void unpack8(const u32x4 w, float (&f)[8]) {
    f[0] = bflo(w.x); f[1] = bfhi(w.x); f[2] = bflo(w.y); f[3] = bfhi(w.y); f[4] = bflo(w.z); f[5] = bfhi(w.z); f[6] = bflo(w.w); f[7] = bfhi(w.w); }
__device__ __forceinline__ u32x4 pack8(const float (&f)[8]) { u32x4 w; w.x = gdn::cvtpk(f[0], f[1]); w.y = gdn::cvtpk(f[2], f[3]); w.z = gdn::cvtpk(f[4], f[5]); w.w = gdn::cvtpk(f[6], f[7]); return w; }


template <int VAR>
__device__ __forceinline__ void ph2b_v4(const Ctx& c, const Params& p) {
    using namespace gdn;
    const int tid = opaque_tid(), wid = __builtin_amdgcn_readfirstlane(tid >> 6), lane = tid & 63, li = lane & 15, lq = lane >> 4;
    const bf16_t* gq = (const bf16_t*)(p.ws + OFF_R2); const bf16_t* gk = gq + (size_t)T * 512; const bf16_t* gv = gk + (size_t)T * 512;
    const float* Gg = (const float*)(p.ws + OFF_GATE); const float* Gb = Gg + 2 * T * GH; float* Gcs = (float*)(p.ws + OFF_GATE) + 4 * T * GH;
    bf16_t* U = (bf16_t*)(p.ws + OFF_R1); bf16_t* W = U + (size_t)2 * T * 512; bf16_t* AT = W + (size_t)2 * T * 512;
    char* lds = (char*)c.lds;
    char* kL = lds; char* qL = lds + 16384;
    float (*Gm)[68] = (float (*)[68])(lds + 32768); float (*QKm)[68] = Gm + 64;
    float (*Lm)[64][68] = (float (*)[64][68])(lds + 32768 + 2 * 64 * 68 * 4);
    float* gcsL = (float*)(lds + 32768 + 4 * 64 * 68 * 4); float* betaL = gcsL + 128; float* gL = betaL + 128;
    for (int unit = c.bid; unit < BATCH * GH * NCH; unit += c.nb) {
        const int nt = unit % NCH, h = (unit / NCH) % GH, b = unit / (NCH * GH);
        const int p0 = nt * CHUNK; const size_t bh = (size_t)(b * GH + h) * SEQ;
        __syncthreads();
#pragma unroll
        for (int i = 0; i < 2; ++i) { const int ch = tid + i * NT, row = ch >> 4, a = ch & 15; const int off = row * 256 + ((a * 16) ^ ((row & 15) << 4));
            *(u32x4*)(kL + off) = *(const u32x4*)(gk + (bh + p0 + row) * 128 + a * 8); *(u32x4*)(qL + off) = *(const u32x4*)(gq + (bh + p0 + row) * 128 + a * 8); }
        if (tid < 128) { const int d = tid >> 6, i = tid & 63; gL[tid] = Gg[(size_t)d * T * GH + bh + p0 + i]; betaL[tid] = Gb[(size_t)d * T * GH + bh + p0 + i]; }
        __syncthreads();
        if (wid < 2) { float v = gL[wid * 64 + (wid ? 63 - lane : lane)];
#pragma unroll
            for (int o = 1; o < 64; o <<= 1) { const float t_ = __shfl_up(v, o); if (lane >= o) v += t_; }
            gcsL[wid * 64 + lane] = v; }
        { const int mt = wid & 3; const char* Asrc = wid < 4 ? kL : qL; f32x4v acc[4];
#pragma unroll
          for (int n = 0; n < 4; ++n) acc[n] = f32x4v{0.f, 0.f, 0.f, 0.f};
#pragma unroll
          for (int s = 0; s < 4; ++s) { const int cb = 64 * s + 16 * lq;
              const bf16x8 af = *(const bf16x8*)(Asrc + (16 * mt + li) * 256 + (cb ^ (li << 4)));
#pragma unroll
              for (int n = 0; n < 4; ++n) { const bf16x8 bfr = *(const bf16x8*)(kL + (16 * n + li) * 256 + (cb ^ (li << 4)));
                  acc[n] = __builtin_amdgcn_mfma_f32_16x16x32_bf16(af, bfr, acc[n], 0, 0, 0); } }
          float (*dst)[68] = wid < 4 ? Gm : QKm;
#pragma unroll
          for (int n = 0; n < 4; ++n)
#pragma unroll
              for (int r = 0; r < 4; ++r) dst[16 * mt + 4 * lq + r][16 * n + li] = acc[n][r];
        }
        __syncthreads();
        if (tid < 128) { const int d = tid >> 6, i = tid & 63; const int nv = d ? NCH - 1 - nt : nt; Gcs[(size_t)d * T * GH + bh + nv * CHUNK + i] = gcsL[tid]; }
        const int tid2 = opaque_tid();
#pragma unroll 2
        for (int idx = tid2; idx < (VAR == 2 ? 0 : 2 * 4096); idx += NT) { const int d = idx >> 12, i = (idx >> 6) & 63, j = idx & 63; const int ti = d ? 63 - i : i, tj = d ? 63 - j : j;
            const float dec = __expf(gcsL[d * 64 + i] - gcsL[d * 64 + j]);
            Lm[d][j][i] = i > j ? betaL[d * 64 + ti] * Gm[ti][tj] * dec : 0.f;
            const int nv = d ? NCH - 1 - nt : nt;
            AT[((size_t)(d * BATCH * GH + b * GH + h) * NCH + nv) * 4096 + i * 64 + wperm(j)] = f2bf(i >= j ? QKm[ti][tj] * dec : 0.f); }
        __syncthreads();
        if (VAR == 1) continue;
        char* RL = lds;
        char* Dv = lds + 32768 + 4 * 64 * 68 * 4 + 1536;
        char* Lb = Dv + 4096;
        for (int ch = tid; ch < 4096; ch += NT) { const int d = ch >> 11, j = (ch >> 5) & 63, cc = ch & 31, tj = d ? 63 - j : j, col0 = cc * 8;
            const bf16_t* sp = (col0 < 128 ? gv + (bh + p0 + tj) * 128 + col0 : gk + (bh + p0 + tj) * 128 + (col0 - 128));
            float f[8]; unpack8(*(const u32x4*)sp, f);
            const float sc = betaL[d * 64 + tj] * (col0 < 128 ? 1.f : __expf(gcsL[d * 64 + j]));
#pragma unroll
            for (int e = 0; e < 8; ++e) f[e] *= sc;
            *(u32x4*)(RL + d * 33792 + (j >> 2) * 2112 + (cc >> 1) * 128 + (j & 3) * 32 + (cc & 1) * 16) = pack8(f); }
        if (tid < 128) {
            const int d = tid >> 6, bb = (tid >> 4) & 3, cc = tid & 15; float x[16];
#pragma unroll
            for (int i = 0; i < 16; ++i) x[i] = (i == cc) ? 1.f : 0.f;
#pragma unroll
            for (int j = 0; j < 15; ++j) { const float xj = x[j];
#pragma unroll
                for (int i = j + 1; i < 16; ++i) x[i] -= Lm[d][16 * bb + j][16 * bb + i] * xj; }
#pragma unroll
            for (int i = 0; i < 16; ++i) *(bf16_t*)(Dv + ((d * 4 + bb) * 16 + i) * 32 + cc * 2) = f2bf(x[i]);
        } else {
            for (int e = tid - 128; e < 2 * 6 * 256; e += NT - 128) { const int d = e / 1536, r = e % 1536, pi = r >> 8, i = (r >> 4) & 15, k = r & 15;
                const int bb = pi == 0 ? 1 : (pi < 3 ? 2 : 3), aa = pi - bb * (bb - 1) / 2;
                *(bf16_t*)(Lb + ((d * 6 + pi) * 16 + i) * 32 + k * 2) = f2bf(-Lm[d][16 * aa + k][16 * bb + i]); }
        }
        __syncthreads();
        { typedef short s16x4v __attribute__((ext_vector_type(4)));
          const int d = wid >> 2, nv = d ? NCH - 1 - nt : nt; const size_t rowbase = ((size_t)d * T * GH + bh + nv * CHUNK) * 128;
          const char* RLd = RL + d * 33792; const char* Dvd = Dv + d * 2048; const char* Lbd = Lb + d * 3072;
#pragma unroll
          for (int tp = 0; tp < 2; ++tp) {
              f32x4v acc[2][4]; s16x4v xb[2][4];
#pragma unroll
              for (int u = 0; u < 2; ++u) { const int ntile = 4 * (wid & 3) + 2 * tp + u;
#pragma unroll
                  for (int bb = 0; bb < 4; ++bb)
#pragma unroll
                      for (int r = 0; r < 4; ++r) acc[u][bb][r] = bf2f(*(const bf16_t*)(RLd + (4 * bb + lq) * 2112 + ntile * 128 + r * 32 + li * 2)); }
#pragma unroll
              for (int bb = 0; bb < 4; ++bb) {
#pragma unroll
                  for (int aa = 0; aa < bb; ++aa) { const s16x4v lf = *(const s16x4v*)(Lbd + ((bb * (bb - 1) / 2 + aa) * 16 + li) * 32 + lq * 8);
#pragma unroll
                      for (int u = 0; u < 2; ++u) acc[u][bb] = __builtin_amdgcn_mfma_f32_16x16x16bf16_1k(lf, xb[u][aa], acc[u][bb], 0, 0, 0); }
                  const s16x4v df = *(const s16x4v*)(Dvd + (bb * 16 + li) * 32 + lq * 8);
#pragma unroll
                  for (int u = 0; u < 2; ++u) { u32x2 w; w.x = cvtpk(acc[u][bb][0], acc[u][bb][1]); w.y = cvtpk(acc[u][bb][2], acc[u][bb][3]);
                      const s16x4v rb = *(s16x4v*)&w; acc[u][bb] = __builtin_amdgcn_mfma_f32_16x16x16bf16_1k(df, rb, f32x4v{0.f, 0.f, 0.f, 0.f}, 0, 0, 0);
                      u32x2 w2; w2.x = cvtpk(acc[u][bb][0], acc[u][bb][1]); w2.y = cvtpk(acc[u][bb][2], acc[u][bb][3]); xb[u][bb] = *(s16x4v*)&w2; }
              }
#pragma unroll
              for (int u = 0; u < 2; ++u) { const int col = 16 * (4 * (wid & 3) + 2 * tp + u) + li; bf16_t* dst = (col < 128 ? U + rowbase + col : W + rowbase + wperm(col - 128));
#pragma unroll
                  for (int bb = 0; bb < 4; ++bb)
#pragma unroll
                      for (int r = 0; r < 4; ++r) dst[(size_t)(16 * bb + 4 * lq + r) * 128] = (bf16_t)((unsigned short)xb[u][bb][r]); }
          }
        }
    }
    __syncthreads();
}

template <int VAR>
__device__ __forceinline__ void ph3b_mfma(const Ctx& c, const Params& p) {
    using namespace gdn;
    constexpr int W_OFF = 0, QD_OFF = 16384, KD_OFF = 32768, AT_OFF = 51200, U_OFF = 59392, MISC_OFF = 68608, BUF = 69632;
    const int tid = opaque_tid(), wid = __builtin_amdgcn_readfirstlane(tid >> 6), lane = tid & 63, li = lane & 15, lq = lane >> 4;
    const bf16_t* gq = (const bf16_t*)(p.ws + OFF_R2); const bf16_t* gk = gq + (size_t)T * 512;
    const float* Gcs = (const float*)(p.ws + OFF_GATE) + 4 * T * GH;
    const bf16_t* Ug = (const bf16_t*)(p.ws + OFF_R1); const bf16_t* Wg = Ug + (size_t)2 * T * 512; const bf16_t* ATg = Wg + (size_t)2 * T * 512;
    bf16_t* Od = (bf16_t*)(p.ws + OFF_R3);
    char* lds = (char*)c.lds;
    for (int unit = c.bid; unit < 2 * BATCH * GH * 2; unit += c.nb) {
        const int chain = (unit & 7) | ((unit >> 4) << 3), vh = (unit >> 3) & 1, h = chain & 3, b = (chain >> 2) & 1, dir = chain >> 3;
        const size_t bh = (size_t)(b * GH + h) * SEQ; const size_t dbh = (size_t)dir * T * GH + bh; const int c0 = vh * 64;
        __syncthreads();
        if (wid >= 4) {
            const int lt = tid - 256;
            struct LSet { u32x4 rw[4], rq[4], rk[4], ra[2], ru[2]; float gc[4], gl; };
            LSet sA, sB;
            const int r0 = lt >> 4, a0 = lt & 15;
            const unsigned offW = (unsigned)(r0 * 256 + a0 * 16);
            const unsigned offQ = (unsigned)((dir ? 63 - r0 : r0) * 256 + a0 * 16);
            const int r1 = lt >> 3, a1 = lt & 7;
            const unsigned offA = (unsigned)(r1 * 128 + a1 * 16), offU = (unsigned)(r1 * 256 + a1 * 16), offG = (unsigned)(r0 * 4);
            const int qstep = dir ? -4096 : 4096;
            const unsigned swW = (unsigned)((r0 & 15) << 4);
            const unsigned ldsW = (unsigned)(r0 * 256) + (((unsigned)a0 * 16u) ^ swW);
            const int s_ = a0 >> 2, a2 = a0 & 3; const int pos0 = ((2 * a2) & 3) * 2 + (a2 >> 1), pos1 = ((2 * a2 + 1) & 3) * 2 + (a2 >> 1);
            const unsigned ldsQ0 = (unsigned)(r0 * 256) + (((unsigned)(64 * s_ + 8 * pos0)) ^ swW), ldsQ1 = (unsigned)(r0 * 256) + (((unsigned)(64 * s_ + 8 * pos1)) ^ swW);
            const unsigned ldsK = (unsigned)((r0 >> 2) * 1152 + (a0 >> 1) * 128 + (r0 & 3) * 32 + (a0 & 1) * 16);
            const unsigned ldsA = (unsigned)(r1 * 128) + (((unsigned)a1 * 16u) ^ (unsigned)(((r1 >> 1) & 7) << 4)), ldsU = (unsigned)(r1 * 144 + a1 * 16);
            const char* Wb = (const char*)(Wg + dbh * 128); const char* Ub = (const char*)(Ug + dbh * 128 + c0);
            const char* Qb = (const char*)(gq + (bh + (dir ? SEQ - 64 : 0)) * 128); const char* Kb = (const char*)(gk + (bh + (dir ? SEQ - 64 : 0)) * 128);
            const char* Ab = (const char*)(ATg + (size_t)(dir * BATCH * GH + b * GH + h) * NCH * 4096); const char* Gb_ = (const char*)(Gcs + dbh);
#define GDN_LOAD(S_, nreal_) do { const int n_ = VAR == 1 ? 0 : (nreal_); const long cw_ = (long)(n_) * 16384, cq_ = dir ? -(long)(n_) * 16384 : (long)(n_) * 16384; \
    _Pragma("unroll") for (int i = 0; i < 4; ++i) { \
        S_.rw[i] = *(const u32x4*)(Wb + cw_ + i * 4096 + offW); S_.rq[i] = *(const u32x4*)(Qb + cq_ + i * qstep + offQ); S_.rk[i] = *(const u32x4*)(Kb + cq_ + i * qstep + offQ); \
        S_.gc[i] = *(const float*)(Gb_ + (long)(n_) * 256 + i * 64 + offG); } \
    _Pragma("unroll") for (int i = 0; i < 2; ++i) { \
        S_.ra[i] = *(const u32x4*)(Ab + (long)(n_) * 8192 + i * 4096 + offA); S_.ru[i] = *(const u32x4*)(Ub + cw_ + i * 8192 + offU); } \
    S_.gl = *(const float*)(Gb_ + (long)(n_) * 256 + 252); } while (0)
#define GDN_SCALE2(w_, f_) cvtpk(bflo(w_) * (f_), bfhi(w_) * (f_))
#define GDN_WRITE(S_, buf_) do { char* B_ = lds + (buf_) * BUF; \
    _Pragma("unroll") for (int i = 0; i < 4; ++i) { \
        *(u32x4*)(B_ + W_OFF + i * 4096 + ldsW) = S_.rw[i]; \
        const float fq_ = __expf(S_.gc[i]), fk_ = __expf(S_.gl - S_.gc[i]); \
        u32x2 q0, q1; q0.x = GDN_SCALE2(S_.rq[i].x, fq_); q0.y = GDN_SCALE2(S_.rq[i].y, fq_); q1.x = GDN_SCALE2(S_.rq[i].z, fq_); q1.y = GDN_SCALE2(S_.rq[i].w, fq_); \
        *(u32x2*)(B_ + QD_OFF + i * 4096 + ldsQ0) = q0; *(u32x2*)(B_ + QD_OFF + i * 4096 + ldsQ1) = q1; \
        u32x4 k_; k_.x = GDN_SCALE2(S_.rk[i].x, fk_); k_.y = GDN_SCALE2(S_.rk[i].y, fk_); k_.z = GDN_SCALE2(S_.rk[i].z, fk_); k_.w = GDN_SCALE2(S_.rk[i].w, fk_); \
        *(u32x4*)(B_ + KD_OFF + i * 4608 + ldsK) = k_; } \
    _Pragma("unroll") for (int i = 0; i < 2; ++i) { \
        *(u32x4*)(B_ + AT_OFF + i * 4096 + ldsA) = S_.ra[i]; *(u32x4*)(B_ + U_OFF + i * 4608 + ldsU) = S_.ru[i]; } \
    if (lt == 0) *(float*)(B_ + MISC_OFF) = __expf(S_.gl); } while (0)
            GDN_LOAD(sA, 0); GDN_WRITE(sA, 0); GDN_LOAD(sB, 1); GDN_LOAD(sA, 2);
            for (int n = 0; n < NCH; n += 2) {
                __syncthreads();
                GDN_WRITE(sB, 1);
                { const int nn = n + 3 < NCH ? n + 3 : NCH - 1; GDN_LOAD(sB, nn); }
                __syncthreads();
                GDN_WRITE(sA, 0);
                { const int nn = n + 4 < NCH ? n + 4 : NCH - 1; GDN_LOAD(sA, nn); }
            }
#undef GDN_LOAD
#undef GDN_WRITE
#undef GDN_SCALE2
        } else {
            f32x4v S[8];
#pragma unroll
            for (int m = 0; m < 8; ++m) S[m] = f32x4v{0.f, 0.f, 0.f, 0.f};
            const int cw = 16 * wid;
            for (int n = 0; n < NCH; ++n) {
                __syncthreads();
                if (VAR == 2) continue;
                const char* B = lds + (n & 1) * BUF; const int p0 = n * CHUNK;
                const float egl = *(const float*)(B + MISC_OFF);
                bf16x8 Sb[4];
#pragma unroll
                for (int s = 0; s < 4; ++s) { u32x4 w; w.x = cvtpk(S[2 * s][0], S[2 * s][1]); w.y = cvtpk(S[2 * s][2], S[2 * s][3]); w.z = cvtpk(S[2 * s + 1][0], S[2 * s + 1][1]); w.w = cvtpk(S[2 * s + 1][2], S[2 * s + 1][3]); Sb[s] = *(bf16x8*)&w; }
                f32x4v av[4], ao[4];
#pragma unroll
                for (int m = 0; m < 4; ++m) { av[m] = f32x4v{0.f, 0.f, 0.f, 0.f}; ao[m] = f32x4v{0.f, 0.f, 0.f, 0.f}; }
#pragma unroll
                for (int s = 0; s < 4; ++s)
#pragma unroll
                    for (int m = 0; m < 4; ++m) { const int off = (16 * m + li) * 256 + ((64 * s + 16 * lq) ^ (li << 4));
                        av[m] = __builtin_amdgcn_mfma_f32_16x16x32_bf16(*(const bf16x8*)(B + W_OFF + off), Sb[s], av[m], 0, 0, 0);
                        ao[m] = __builtin_amdgcn_mfma_f32_16x16x32_bf16(*(const bf16x8*)(B + QD_OFF + off), Sb[s], ao[m], 0, 0, 0); }
#pragma unroll
                for (int m = 0; m < 4; ++m)
#pragma unroll
                    for (int r = 0; r < 4; ++r) av[m][r] = bf2f(*(const bf16_t*)(B + U_OFF + (16 * m + 4 * lq + r) * 144 + (cw + li) * 2)) - av[m][r];
                bf16x8 Vb[2];
#pragma unroll
                for (int s = 0; s < 2; ++s) { u32x4 w; w.x = cvtpk(av[2 * s][0], av[2 * s][1]); w.y = cvtpk(av[2 * s][2], av[2 * s][3]); w.z = cvtpk(av[2 * s + 1][0], av[2 * s + 1][1]); w.w = cvtpk(av[2 * s + 1][2], av[2 * s + 1][3]); Vb[s] = *(bf16x8*)&w; }
#pragma unroll
                for (int s = 0; s < 2; ++s)
#pragma unroll
                    for (int m = 0; m < 4; ++m) { const int row = 16 * m + li;
                        ao[m] = __builtin_amdgcn_mfma_f32_16x16x32_bf16(*(const bf16x8*)(B + AT_OFF + row * 128 + ((64 * s + 16 * lq) ^ (((row >> 1) & 7) << 4))), Vb[s], ao[m], 0, 0, 0); }
#pragma unroll
                for (int m = 0; m < 8; ++m) S[m] = S[m] * egl;
                { s16x4 tr[8][4]; const int base = (int)(uintptr_t)(B + KD_OFF) + lq * 1152 + 8 * li;
#define GDN_TR(m_) do { asm volatile("ds_read_b64_tr_b16 %0, %1 offset:%2" : "=&v"(tr[m_][0]) : "v"(base), "i"((m_) * 128) : "memory"); \
    asm volatile("ds_read_b64_tr_b16 %0, %1 offset:%2" : "=&v"(tr[m_][1]) : "v"(base), "i"((m_) * 128 + 4608) : "memory"); \
    asm volatile("ds_read_b64_tr_b16 %0, %1 offset:%2" : "=&v"(tr[m_][2]) : "v"(base), "i"((m_) * 128 + 9216) : "memory"); \
    asm volatile("ds_read_b64_tr_b16 %0, %1 offset:%2" : "=&v"(tr[m_][3]) : "v"(base), "i"((m_) * 128 + 13824) : "memory"); } while (0)
#define GDN_SUP(m_) do { const bf16x8 k0 = bf16x8{tr[m_][0][0], tr[m_][0][1], tr[m_][0][2], tr[m_][0][3], tr[m_][1][0], tr[m_][1][1], tr[m_][1][2], tr[m_][1][3]}, \
        k1 = bf16x8{tr[m_][2][0], tr[m_][2][1], tr[m_][2][2], tr[m_][2][3], tr[m_][3][0], tr[m_][3][1], tr[m_][3][2], tr[m_][3][3]}; \
    S[m_] = __builtin_amdgcn_mfma_f32_16x16x32_bf16(k0, Vb[0], S[m_], 0, 0, 0); S[m_] = __builtin_amdgcn_mfma_f32_16x16x32_bf16(k1, Vb[1], S[m_], 0, 0, 0); } while (0)
                  GDN_TR(0); GDN_TR(1); GDN_TR(2); GDN_TR(3);
                  asm volatile("s_waitcnt lgkmcnt(0)" ::: "memory"); __builtin_amdgcn_sched_barrier(0);
                  GDN_TR(4); GDN_TR(5); GDN_TR(6); GDN_TR(7);
                  GDN_SUP(0); GDN_SUP(1); GDN_SUP(2); GDN_SUP(3);
                  asm volatile("s_waitcnt lgkmcnt(0)" ::: "memory"); __builtin_amdgcn_sched_barrier(0);
                  GDN_SUP(4); GDN_SUP(5); GDN_SUP(6); GDN_SUP(7);
#undef GDN_TR
#undef GDN_SUP
                }
#pragma unroll
                for (int m = 0; m < 4; ++m)
#pragma unroll
                    for (int r = 0; r < 4; ++r) { const int pv = p0 + 16 * m + 4 * lq + r; const int tk = dir ? SEQ - 1 - pv : pv;
                        Od[((size_t)dir * T + b * SEQ + tk) * 512 + h * 128 + c0 + cw + li] = f2bf(ao[m][r]); }
            }
        }
    }
    __syncthreads();
}


constexpr size_t OFF_SUMSQ = OFF_SH;
constexpr size_t OFF_KPE = OFF_R4;
template <bool QROPE = false>
__device__ __forceinline__ void cvt_tile(const float* src, int K, int N, const float* scale, bf16_t* dst, int Kpad, int tk, int tn, float* tile, int tid) {
    const int k0 = tk * 64, n0 = tn * 64;
#pragma unroll
    for (int i = 0; i < 2; ++i) { const int r = (tid >> 4) + 32 * i, k = k0 + r, n = n0 + (tid & 15) * 4; f32x4 v = {0.f, 0.f, 0.f, 0.f};
        if (k < K) { const float sc = scale ? scale[k] : 1.f;
            if (n + 3 < N) v = *(const f32x4*)(src + (size_t)k * N + n) * sc;
            else { for (int e = 0; e < 4; ++e) if (n + e < N) v[e] = src[(size_t)k * N + n + e] * sc; } }
#pragma unroll
        for (int e = 0; e < 4; ++e) tile[r * 65 + (tid & 15) * 4 + e] = v[e]; }
    __syncthreads();
    { const int nl = tid >> 3, kc = (tid & 7) * 8; float f[8];
#pragma unroll
      for (int j = 0; j < 8; ++j) f[j] = tile[(kc + j) * 65 + nl];
      int nd = n0 + nl;
      if (QROPE) { const int hh = nd / 192, w = nd % 192; if (w >= 128) { const int i = w - 128; nd = hh * 192 + 128 + (i < 32 ? 2 * i : 2 * (i - 32) + 1); } }
      *(u32x4*)(dst + (size_t)nd * Kpad + k0 + kc) = pack8(f); }
    __syncthreads();
}
__device__ __forceinline__ void ph0_v2(const Ctx& c, const Params& p) {
    unsigned char* ws = p.ws;
    constexpr int T0 = 16 * 40, T1 = T0 + 4 * 12, T2 = T1 + 4 * 16, T3 = T2 + 16 * 16, T4 = T3 + 16 * 32;
    for (int tile = c.bid; tile < T4; tile += c.nb) {
        if (tile < T0) cvt_tile(p.w_in, 1024, IN_W, p.ln1_w, (bf16_t*)(ws + OFF_WIN), 1024, tile % 16, tile / 16, c.lds, c.tid);
        else if (tile < T1) { const int r = tile - T0; cvt_tile<true>(p.w_q_up, QRANK, 768, p.q_a_norm_w, (bf16_t*)(ws + OFF_WQUP), 256, r % 4, r / 4, c.lds, c.tid); }
        else if (tile < T2) { const int r = tile - T1; cvt_tile(p.w_kv_up, KVRANK, 1024, p.kv_a_norm_w, (bf16_t*)(ws + OFF_WKVUP), 256, r % 4, r / 4, c.lds, c.tid); }
        else if (tile < T3) { const int r = tile - T2; cvt_tile(p.w_out, 1024, 1024, nullptr, (bf16_t*)(ws + OFF_WOUT), 1024, r % 16, r / 16, c.lds, c.tid); }
        else { const int r = tile - T3; cvt_tile(p.peer_wq, 1024, 2048, p.ln2_w, (bf16_t*)(ws + OFF_WPQ), 1024, r % 16, r / 16, c.lds, c.tid); }
    }
    { bf16_t* d = (bf16_t*)(ws + OFF_SUBK); const int total4 = PH * 2 * NKEYS * 128 / 4;
      for (int i = c.bid * NT + c.tid; i < total4; i += c.nb * NT) { const f32x4 v = ((const f32x4*)p.sub_keys)[i]; u32x2 o; o.x = gdn::cvtpk(v.x, v.y); o.y = gdn::cvtpk(v.z, v.w); ((u32x2*)d)[i] = o; } }
    { float* sq = (float*)(ws + OFF_SUMSQ); for (int i = c.bid * NT + c.tid; i < T; i += c.nb * NT) sq[i] = 0.f; }
    bf16_t* xb = (bf16_t*)(ws + OFF_R2); float* rstd1 = (float*)(ws + OFF_VEC);
    for (int m = c.gw; m < T; m += c.ngw) {
        const f32x4* xr = (const f32x4*)(p.x + (size_t)m * D_MODEL) + c.lane;
        f32x4 v[4]; float s = 0.f;
#pragma unroll
        for (int j = 0; j < 4; ++j) { v[j] = xr[64 * j]; s += v[j].x * v[j].x + v[j].y * v[j].y + v[j].z * v[j].z + v[j].w * v[j].w; }
        s = wave_sum(s);
        const float rs = rsqrtf(s * (1.f / D_MODEL) + EPS);
        if (c.lane == 0) rstd1[m] = rs;
        u32x2* o = (u32x2*)(xb + (size_t)m * D_MODEL) + c.lane;
#pragma unroll
        for (int j = 0; j < 4; ++j) { u32x2 w; w.x = gdn::cvtpk(v[j].x * rs, v[j].y * rs); w.y = gdn::cvtpk(v[j].z * rs, v[j].w * rs); o[64 * j] = w; }
    }
}

__device__ __forceinline__ void ph2a1_v2(const Ctx& c, const Params& p) {
    const int lane = opaque_tid() & 63;
    const bf16_t* proj = (const bf16_t*)(p.ws + OFF_R1);
    bf16_t* gq = (bf16_t*)(p.ws + OFF_R2); bf16_t* gk = gq + (size_t)T * 512; bf16_t* gv = gk + (size_t)T * 512; bf16_t* zs = gv + (size_t)T * 512;
    const int part = c.gw & 3;
    float cw[5][8];
#pragma unroll
    for (int j = 0; j < 5; ++j)
#pragma unroll
        for (int e = 0; e < 8; ++e) cw[j][e] = part < 3 ? p.conv_w[j * GDN_QKV + part * 512 + 8 * lane + e] : 0.f;
    for (int run = c.gw >> 2; run < T / 16; run += c.ngw >> 2) {
        const int t0 = run * 16, b = t0 / SEQ, s0 = t0 % SEQ;
        if (part == 3) {
#pragma unroll 4
            for (int i = 0; i < 16; ++i) { float f[8]; unpack8(*(const u32x4*)(proj + (size_t)(t0 + i) * IN_WP + C_Z + 8 * lane), f);
#pragma unroll
                for (int e = 0; e < 8; ++e) f[e] = siluf_(f[e]);
                *(u32x4*)(zs + (size_t)(t0 + i) * 512 + 8 * lane) = pack8(f); }
        } else {
            const bf16_t* base = proj + (size_t)t0 * IN_WP + C_QKV + part * 512 + 8 * lane;
            const u32x4 zero = {0u, 0u, 0u, 0u};
            u32x4 xw[5];
            xw[0] = s0 >= 2 ? *(const u32x4*)(base - 2 * IN_WP) : zero; xw[1] = s0 >= 1 ? *(const u32x4*)(base - IN_WP) : zero;
            xw[2] = *(const u32x4*)(base); xw[3] = *(const u32x4*)(base + IN_WP);
            bf16_t* dst = (part == 0 ? gq : part == 1 ? gk : gv) + ((size_t)(b * GH + (lane >> 4)) * SEQ + s0) * 128 + (lane & 15) * 8;
#pragma unroll
            for (int i = 0; i < 16; ++i) {
                xw[4] = (s0 + i + 2 < SEQ) ? *(const u32x4*)(base + (size_t)(i + 2) * IN_WP) : zero;
                float y[8];
#pragma unroll
                for (int e = 0; e < 8; ++e) y[e] = 0.f;
#pragma unroll
                for (int j = 0; j < 5; ++j) { float f[8]; unpack8(xw[j], f);
#pragma unroll
                    for (int e = 0; e < 8; ++e) y[e] += cw[j][e] * f[e]; }
                float ss = 0.f;
#pragma unroll
                for (int e = 0; e < 8; ++e) { y[e] = siluf_(y[e]); ss += y[e] * y[e]; }
                if (part < 2) { ss += __shfl_xor(ss, 1); ss += __shfl_xor(ss, 2); ss += __shfl_xor(ss, 4); ss += __shfl_xor(ss, 8);
                    const float rs = rsqrtf(ss + EPS) * (part == 0 ? 0.08838834764831845f : 1.f);
#pragma unroll
                    for (int e = 0; e < 8; ++e) y[e] *= rs; }
                *(u32x4*)(dst + (size_t)i * 128) = pack8(y);
                xw[0] = xw[1]; xw[1] = xw[2]; xw[2] = xw[3]; xw[3] = xw[4];
            }
        }
    }
    { float* Gg = (float*)(p.ws + OFF_GATE); float* Gb = Gg + 2 * T * GH;
      for (int t = c.bid * NT + c.tid; t < T; t += c.nb * NT) { const int b = t / SEQ, s = t % SEQ; float f0[8], f1[8];
          unpack8(*(const u32x4*)(proj + (size_t)t * IN_WP + C_GATE), f0); unpack8(*(const u32x4*)(proj + (size_t)t * IN_WP + C_GATE + 8), f1);
#pragma unroll
          for (int h = 0; h < 4; ++h) { const size_t gi = (size_t)(b * GH + h) * SEQ + s;
              Gg[gi] = -expf(p.a_log_f[h]) * softplusf_(f0[h] + p.dt_bias_f[h]); Gb[gi] = sigmoidf_(f0[4 + h]);
              Gg[(size_t)T * GH + gi] = -expf(p.a_log_b[h]) * softplusf_(f1[h] + p.dt_bias_b[h]); Gb[(size_t)T * GH + gi] = sigmoidf_(f1[4 + h]); } } }
    { float* rq = (float*)(p.ws + OFF_VEC) + T; float* rkv = rq + T; bf16_t* lat = (bf16_t*)(p.ws + OFF_LAT); float* cst = (float*)(p.ws + OFF_CS);
      bf16_t* Kk = (bf16_t*)p.out + (size_t)T * MLA_H * QKD;
      const int jl = (lane & 3) * 8;
      float inv8[8];
#pragma unroll
      for (int e = 0; e < 8; ++e) inv8[e] = expf(-(float)(jl + e) * (9.210340371976184f / 32.f));
      for (int t = c.gw; t < T; t += c.ngw) { u32x4 v = {0u, 0u, 0u, 0u}; if (lane < 56) v = *(const u32x4*)(proj + (size_t)t * IN_WP + 8 * lane);
          float f[8]; unpack8(v, f); float ss = 0.f;
#pragma unroll
          for (int e = 0; e < 8; ++e) ss += f[e] * f[e];
          const float sq = wave_sum(lane < 32 ? ss : 0.f), sk = wave_sum((lane >= 32 && lane < 48) ? ss : 0.f);
          if (lane == 0) { rq[t] = rsqrtf(sq * (1.f / QRANK) + EPS); rkv[t] = rsqrtf(sk * (1.f / KVRANK) + EPS); }
          *(u32x4*)(lat + (size_t)t * 512 + 8 * lane) = lane < 48 ? v : u32x4{0u, 0u, 0u, 0u};
          u32x4 vp; vp.x = __shfl_xor(v.x, 4); vp.y = __shfl_xor(v.y, 4); vp.z = __shfl_xor(v.z, 4); vp.w = __shfl_xor(v.w, 4);
          if (lane >= 48 && lane < 56) { float g[8]; unpack8(vp, g); const float pos = (float)p.pos[t]; const bool first = lane < 52; float o[8], cs8[8], sn8[8];
#pragma unroll
              for (int e = 0; e < 8; ++e) { sincosf(pos * inv8[e], &sn8[e], &cs8[e]); o[e] = first ? f[e] * cs8[e] - g[e] * sn8[e] : f[e] * cs8[e] + g[e] * sn8[e]; }
              const u32x4 ow = pack8(o); const int b = t / SEQ, s = t % SEQ;
#pragma unroll
              for (int h = 0; h < MLA_H; ++h) *(u32x4*)(Kk + ((size_t)(b * MLA_H + h) * SEQ + s) * QKD + (first ? 128 : 160) + jl) = ow;
              float* cd = cst + (size_t)t * 64 + (first ? 0 : 32) + jl;
              *(f32x4*)cd = first ? f32x4{cs8[0], cs8[1], cs8[2], cs8[3]} : f32x4{sn8[0], sn8[1], sn8[2], sn8[3]};
              *(f32x4*)(cd + 4) = first ? f32x4{cs8[4], cs8[5], cs8[6], cs8[7]} : f32x4{sn8[4], sn8[5], sn8[6], sn8[7]}; } } }
}

__device__ __forceinline__ void ph2a3_v2(const Ctx& c, const Params& p) {
    const int lane = opaque_tid() & 63;
    const bf16_t* qraw = (const bf16_t*)(p.ws + OFF_R5); const bf16_t* kvraw = (const bf16_t*)(p.ws + OFF_R3); const bf16_t* kpe = (const bf16_t*)(p.ws + OFF_KPE);
    const float* rq = (const float*)(p.ws + OFF_VEC) + T; const float* rkv = rq + T;
    bf16_t* Q = (bf16_t*)p.out; bf16_t* Kk = Q + (size_t)T * MLA_H * QKD; bf16_t* V = Kk + (size_t)T * MLA_H * QKD;
    const int h = lane >> 4, cc = lane & 15, hh = (lane >> 2) & 3, pc = lane & 3;
    const float inv = expf(-(float)(lane & 31) * (9.210340371976184f / 32.f));
    for (int t = c.gw; t < T; t += c.ngw) {
        const int b = t / SEQ, s = t % SEQ; const float rqv = rq[t], rkvv = rkv[t];
        float sn, cs; sincosf((float)p.pos[t] * inv, &sn, &cs);
        const size_t qo = ((size_t)(b * MLA_H + h) * SEQ + s) * QKD, vo = ((size_t)(b * MLA_H + h) * SEQ + s) * VDIM;
        { float f[8]; unpack8(*(const u32x4*)(qraw + (size_t)t * 768 + h * 192 + cc * 8), f);
#pragma unroll
          for (int e = 0; e < 8; ++e) f[e] *= rqv;
          *(u32x4*)(Q + qo + cc * 8) = pack8(f);
          unpack8(*(const u32x4*)(kvraw + (size_t)t * 1024 + h * 256 + cc * 8), f);
#pragma unroll
          for (int e = 0; e < 8; ++e) f[e] *= rkvv;
          *(u32x4*)(Kk + qo + cc * 8) = pack8(f);
          unpack8(*(const u32x4*)(kvraw + (size_t)t * 1024 + h * 256 + 128 + cc * 8), f);
#pragma unroll
          for (int e = 0; e < 8; ++e) f[e] *= rkvv;
          *(u32x4*)(V + vo + cc * 8) = pack8(f); }
        float cs8[8], sn8[8];
#pragma unroll
        for (int e = 0; e < 8; ++e) { cs8[e] = __shfl(cs, pc * 8 + e); sn8[e] = __shfl(sn, pc * 8 + e); }
        if (lane < 16) {
            const size_t ro = ((size_t)(b * MLA_H + hh) * SEQ + s) * QKD;
            float a[8], bq[8], o1[8], o2[8];
            unpack8(*(const u32x4*)(qraw + (size_t)t * 768 + hh * 192 + 128 + pc * 8), a); unpack8(*(const u32x4*)(qraw + (size_t)t * 768 + hh * 192 + 160 + pc * 8), bq);
#pragma unroll
            for (int e = 0; e < 8; ++e) { o1[e] = (a[e] * cs8[e] - bq[e] * sn8[e]) * rqv; o2[e] = (bq[e] * cs8[e] + a[e] * sn8[e]) * rqv; }
            *(u32x4*)(Q + ro + 128 + pc * 8) = pack8(o1); *(u32x4*)(Q + ro + 160 + pc * 8) = pack8(o2);
            unpack8(*(const u32x4*)(kpe + (size_t)t * 64 + pc * 8), a); unpack8(*(const u32x4*)(kpe + (size_t)t * 64 + 32 + pc * 8), bq);
#pragma unroll
            for (int e = 0; e < 8; ++e) { o1[e] = a[e] * cs8[e] - bq[e] * sn8[e]; o2[e] = bq[e] * cs8[e] + a[e] * sn8[e]; }
            *(u32x4*)(Kk + ro + 128 + pc * 8) = pack8(o1); *(u32x4*)(Kk + ro + 160 + pc * 8) = pack8(o2);
        }
    }
}

__device__ __forceinline__ void ph4a_v2(const Ctx& c, const Params& p, bool split) {
    const int lane = opaque_tid() & 63;
    const bf16_t* Od = (const bf16_t*)(p.ws + OFF_R3); const bf16_t* omla = (const bf16_t*)(p.ws + OFF_R4);
    const bf16_t* zs = (const bf16_t*)(p.ws + OFF_R2) + (size_t)3 * T * 512; bf16_t* cat = (bf16_t*)(p.ws + OFF_R1);
    float gw8[8];
#pragma unroll
    for (int e = 0; e < 8; ++e) gw8[e] = p.gdn_norm_w[(lane & 15) * 8 + e];
    for (int t = c.gw; t < T; t += c.ngw) {
        float a[8], bb[8], z[8];
        unpack8(*(const u32x4*)(Od + (size_t)t * 512 + lane * 8), a); unpack8(*(const u32x4*)(Od + ((size_t)T + t) * 512 + lane * 8), bb); unpack8(*(const u32x4*)(zs + (size_t)t * 512 + lane * 8), z);
        float ss = 0.f;
#pragma unroll
        for (int e = 0; e < 8; ++e) { a[e] += bb[e]; ss += a[e] * a[e]; }
        ss += __shfl_xor(ss, 1); ss += __shfl_xor(ss, 2); ss += __shfl_xor(ss, 4); ss += __shfl_xor(ss, 8);
        const float r = rsqrtf(ss * (1.f / 128.f) + EPS);
#pragma unroll
        for (int e = 0; e < 8; ++e) a[e] = a[e] * r * gw8[e] * z[e];
        *(u32x4*)(cat + (size_t)t * 1024 + 512 + lane * 8) = pack8(a);
        const int s_ = t % SEQ;
        if (split && s_ >= 28 * 256) {
            const int lu = ((s_ >> 8) - 28) * 8 + (t / SEQ) * 4 + (lane >> 4), row = s_ & 255;
            const float* ml = (const float*)(p.ws + OFF_PARTML) + ((size_t)lu * 7 * 256 + row) * 2; const bf16_t* po = (const bf16_t*)(p.ws + OFF_PART) + ((size_t)lu * 7 * 256 + row) * 128 + (lane & 15) * 8;
            float mp[7], lp[7], M = -3e38f;
#pragma unroll
            for (int q = 0; q < 7; ++q) { mp[q] = ml[q * 512]; lp[q] = ml[q * 512 + 1]; M = fmaxf(M, mp[q]); }
            float o8[8], L = 0.f;
#pragma unroll
            for (int e = 0; e < 8; ++e) o8[e] = 0.f;
#pragma unroll
            for (int q = 0; q < 7; ++q) { const float w = exp2f((mp[q] - M) * (attn::SCALE * 1.4426950408889634f)); L += w * lp[q]; float f[8]; unpack8(*(const u32x4*)(po + (size_t)q * 256 * 128), f);
#pragma unroll
                for (int e = 0; e < 8; ++e) o8[e] += w * f[e]; }
            const float il = 1.f / L;
#pragma unroll
            for (int e = 0; e < 8; ++e) o8[e] *= il;
            *(u32x4*)(cat + (size_t)t * 1024 + lane * 8) = pack8(o8);
        } else
        *(u32x4*)(cat + (size_t)t * 1024 + lane * 8) = *(const u32x4*)(omla + (size_t)t * 512 + lane * 8);
    }
}


constexpr size_t OFF_HQ = OFF_R1;
constexpr size_t OFF_HSC = OFF_VEC + 3 * (size_t)T * 4;
constexpr size_t OFF_CBUF = OFF_R2;
constexpr size_t OFF_SUMSQ2 = OFF_VEC + (size_t)T * 4;
__device__ __forceinline__ float gelu_as(float v) {
    const float av = fabsf(v), t = __builtin_amdgcn_rcpf(av * 0.2316418882f + 1.0f);
    float q = t * 0.5307027145f + (-0.7265760135f); q = q * t + 0.7107068705f; q = q * t + (-0.142248368f); q = q * t + 0.127414796f; q = q * t;
    const float m = v * (q * __builtin_amdgcn_exp2f((v * v) * (-0.72134752044f)));
    return v < 0.f ? m : v - m;
}
__device__ __forceinline__ void peer_hq(const Ctx& c, const Params& p) {
    const int lane = c.lane; unsigned char* hq = p.ws + OFF_HQ; float* hsc = (float*)(p.ws + OFF_HSC);
    for (int t = c.gw; t < T; t += c.ngw) {
        const bf16_t* row = (const bf16_t*)(p.ws + OFF_R3) + (size_t)t * 1024 + 16 * lane; f32x4 hr[4]; float ssq = 0.f, mx = 0.f;
        { float f0[8], f1[8]; unpack8(*(const u32x4*)row, f0); unpack8(*(const u32x4*)(row + 8), f1);
          hr[0] = f32x4{f0[0], f0[1], f0[2], f0[3]}; hr[1] = f32x4{f0[4], f0[5], f0[6], f0[7]}; hr[2] = f32x4{f1[0], f1[1], f1[2], f1[3]}; hr[3] = f32x4{f1[4], f1[5], f1[6], f1[7]}; }
#pragma unroll
        for (int j = 0; j < 4; ++j) {
#pragma unroll
            for (int k = 0; k < 4; ++k) { ssq += hr[j][k] * hr[j][k]; mx = fmaxf(mx, fabsf(hr[j][k])); } }
        ssq = wave_sum(ssq); mx = fmaxf(wave_max(mx), 1e-30f);
        const float qinv = 127.f / mx;
        u32x4 hv; hv.x = q4(hr[0].x, hr[0].y, hr[0].z, hr[0].w, qinv, 0); hv.y = q4(hr[1].x, hr[1].y, hr[1].z, hr[1].w, qinv, 0);
        hv.z = q4(hr[2].x, hr[2].y, hr[2].z, hr[2].w, qinv, 0); hv.w = q4(hr[3].x, hr[3].y, hr[3].z, hr[3].w, qinv, 0);
        *(u32x4*)(hq + (size_t)t * 1024 + 16 * lane) = hv;
        if (lane == 0) hsc[t] = rsqrtf(ssq * (1.f / 1024.f) + EPS) * mx * (1.f / 127.f);
    }
}
template <int VAR>
__device__ __forceinline__ void peer_H3(const Ctx& c, const Params& p) {
    const int tid = opaque_tid(), lane = tid & 63, wid = __builtin_amdgcn_readfirstlane(tid >> 6), grp = lane >> 3, sub = lane & 7;
    const unsigned char* hq = p.ws + OFF_HQ; const float* hsc = (const float*)(p.ws + OFF_HSC);
    const unsigned char* u8 = p.ws + OFF_R5; const float* su = (const float*)(p.ws + OFF_SU);
    const int* experts = (const int*)(p.ws + OFF_R4); const float* gates = (const float*)(p.ws + OFF_R4 + 8 * MB);
    float* cbuf = (float*)(p.ws + OFF_CBUF);
    { float* s2 = (float*)(p.ws + OFF_SUMSQ2); for (int i = c.bid * NT + tid; i < T; i += c.nb * NT) s2[i] = 0.f; }
    const int x = c.bid & 7, nslw = ((c.nb - x + 7) >> 3) * (NT / 64), wx = (c.bid >> 3) * (NT / 64) + wid;
    int* cE = (int*)c.lds + wid * 384; float* cG = (float*)(cE + 128); int* cS = cE + 256;
    int e0n = 0, e1n = 0; float g0n = 0.f, g1n = 0.f, hsn = 0.f; u32x4 hvn[8];
#define PH_FETCH(t_) do { e0n = experts[(size_t)(t_) * 128 + lane]; e1n = experts[(size_t)(t_) * 128 + 64 + lane]; g0n = gates[(size_t)(t_) * 128 + lane]; g1n = gates[(size_t)(t_) * 128 + 64 + lane]; hsn = hsc[t_]; \
    _Pragma("unroll") for (int j_ = 0; j_ < 8; ++j_) hvn[j_] = *(const u32x4*)(hq + (size_t)(t_) * 1024 + sub * 16 + j_ * 128); } while (0)
    if (wx < T) PH_FETCH(wx);
    for (int t = wx; t < T; t += nslw) {
        const int e0 = e0n, e1 = e1n; const float g0 = g0n, g1 = g1n, hs = hsn; u32x4 hv[8];
#pragma unroll
        for (int j = 0; j < 8; ++j) hv[j] = hvn[j];
        { const int tn = t + nslw < T ? t + nslw : t; PH_FETCH(tn); }
        const bool in0 = (e0 >> 11) == x, in1 = (e1 >> 11) == x;
        const unsigned long long m0 = __ballot(in0), m1 = __ballot(in1);
        const int n0 = __popcll(m0), cnt = n0 + __popcll(m1);
        const int r0 = __builtin_amdgcn_mbcnt_hi((unsigned)(m0 >> 32), __builtin_amdgcn_mbcnt_lo((unsigned)m0, 0));
        const int r1 = n0 + __builtin_amdgcn_mbcnt_hi((unsigned)(m1 >> 32), __builtin_amdgcn_mbcnt_lo((unsigned)m1, 0));
        if (in0) { cE[r0] = e0; cG[r0] = g0; cS[r0] = lane; }
        if (in1) { cE[r1] = e1; cG[r1] = g1; cS[r1] = 64 + lane; }
        for (int b0 = 0; b0 < (VAR == 1 ? 0 : cnt); b0 += 24) {
            int me[3]; float mg[3], msu[3]; int ms[3]; u32x4 ur[3][8];
            const bool third = cnt - b0 > 16;
#pragma unroll
            for (int q = 0; q < 3; ++q) { const int ent = min(b0 + 8 * q + grp, cnt - 1); me[q] = cE[ent]; mg[q] = cG[ent]; ms[q] = cS[ent]; }
#pragma unroll
            for (int q = 0; q < 3; ++q) if (q < 2 || third) { msu[q] = su[me[q]]; const unsigned char* pr = u8 + (size_t)me[q] * 1024 + sub * 16;
#pragma unroll
                for (int j = 0; j < 8; ++j) { if (VAR == 3) ur[q][j] = hv[j]; else ur[q][j] = *(const u32x4*)(pr + j * 128); } }
            __builtin_amdgcn_sched_barrier(0);
#pragma unroll
            for (int q = 0; q < 3; ++q) if (q < 2 || third) {
                int s0 = 0, s1 = 0, s2_ = 0, s3 = 0;
                if (VAR == 2) { s0 = (int)(ur[q][0].x ^ ur[q][1].x ^ ur[q][2].x ^ ur[q][3].x ^ ur[q][4].x ^ ur[q][5].x ^ ur[q][6].x ^ ur[q][7].x); }
                else
#pragma unroll
                for (int j = 0; j < 8; ++j) { s0 = __builtin_amdgcn_sdot4((int)hv[j].x, (int)ur[q][j].x, s0, false); s1 = __builtin_amdgcn_sdot4((int)hv[j].y, (int)ur[q][j].y, s1, false);
                    s2_ = __builtin_amdgcn_sdot4((int)hv[j].z, (int)ur[q][j].z, s2_, false); s3 = __builtin_amdgcn_sdot4((int)hv[j].w, (int)ur[q][j].w, s3, false); }
                int s = (s0 + s1) + (s2_ + s3);
                s += __builtin_amdgcn_update_dpp(0, s, 0xB1, 0xf, 0xf, true);
                s += __builtin_amdgcn_update_dpp(0, s, 0x4E, 0xf, 0xf, true);
                s += __builtin_amdgcn_update_dpp(0, s, 0x141, 0xf, 0xf, true);
                const float cc = mg[q] * gelu_as(hs * msu[q] * (float)s);
                if (sub == 0 && b0 + 8 * q + grp < cnt) cbuf[(size_t)t * 128 + ms[q]] = cc;
            }
        }
    }
#undef PH_FETCH
}

__device__ __forceinline__ void peer_H4(const Ctx& c, const Params& p) {
    const int tid = opaque_tid(), lane = tid & 63, wid = __builtin_amdgcn_readfirstlane(tid >> 6), grp = lane >> 3, sub = lane & 7;
    const unsigned char* hq = p.ws + OFF_HQ; const float* hsc = (const float*)(p.ws + OFF_HSC);
    const unsigned char* u8 = p.ws + OFF_R5; const float* su = (const float*)(p.ws + OFF_SU);
    const int* experts = (const int*)(p.ws + OFF_R4); const float* gates = (const float*)(p.ws + OFF_R4 + 8 * MB);
    float* cbuf = (float*)(p.ws + OFF_CBUF);
    { float* s2 = (float*)(p.ws + OFF_SUMSQ2); for (int i = c.bid * NT + tid; i < T; i += c.nb * NT) s2[i] = 0.f; }
    const int x = c.bid & 7, nslw = ((c.nb - x + 7) >> 3) * (NT / 64), wx = (c.bid >> 3) * (NT / 64) + wid;
    int* cE = (int*)c.lds + wid * 768; float* cG = (float*)(cE + 128); int* cS = cE + 256;
    int e0n[2], e1n[2]; float g0n[2], g1n[2];
#define PH_FETCH(u_, t_) do { e0n[u_] = experts[(size_t)(t_) * 128 + lane]; e1n[u_] = experts[(size_t)(t_) * 128 + 64 + lane]; g0n[u_] = gates[(size_t)(t_) * 128 + lane]; g1n[u_] = gates[(size_t)(t_) * 128 + 64 + lane]; } while (0)
#define PH_DOT(S_, HV_, UR_) do { int s0_ = 0, s1_ = 0, s2__ = 0, s3_ = 0; \
    _Pragma("unroll") for (int j_ = 0; j_ < 8; ++j_) { s0_ = __builtin_amdgcn_sdot4((int)HV_[j_].x, (int)UR_[j_].x, s0_, false); s1_ = __builtin_amdgcn_sdot4((int)HV_[j_].y, (int)UR_[j_].y, s1_, false); \
        s2__ = __builtin_amdgcn_sdot4((int)HV_[j_].z, (int)UR_[j_].z, s2__, false); s3_ = __builtin_amdgcn_sdot4((int)HV_[j_].w, (int)UR_[j_].w, s3_, false); } \
    S_ = (s0_ + s1_) + (s2__ + s3_); \
    S_ += __builtin_amdgcn_update_dpp(0, S_, 0xB1, 0xf, 0xf, true); S_ += __builtin_amdgcn_update_dpp(0, S_, 0x4E, 0xf, 0xf, true); S_ += __builtin_amdgcn_update_dpp(0, S_, 0x141, 0xf, 0xf, true); } while (0)
#pragma unroll
    for (int u = 0; u < 2; ++u) { const int tt = wx + u * nslw < T ? wx + u * nslw : 0; PH_FETCH(u, tt); }
    for (int t = wx; t < T; t += 2 * nslw) {
        int cnt[2]; u32x4 hv[2][8]; float hs[2]; int tt[2]; bool val[2];
#pragma unroll
        for (int u = 0; u < 2; ++u) {
            val[u] = t + u * nslw < T; tt[u] = val[u] ? t + u * nslw : 0;
            const int e0 = e0n[u], e1 = e1n[u]; const float g0 = g0n[u], g1 = g1n[u];
#pragma unroll
            for (int j = 0; j < 8; ++j) hv[u][j] = *(const u32x4*)(hq + (size_t)tt[u] * 1024 + sub * 16 + j * 128);
            hs[u] = hsc[tt[u]];
            const bool in0 = (e0 >> 11) == x, in1 = (e1 >> 11) == x;
            const unsigned long long m0 = __ballot(in0), m1 = __ballot(in1);
            const int n0 = __popcll(m0); cnt[u] = n0 + __popcll(m1);
            const int r0 = __builtin_amdgcn_mbcnt_hi((unsigned)(m0 >> 32), __builtin_amdgcn_mbcnt_lo((unsigned)m0, 0));
            const int r1 = n0 + __builtin_amdgcn_mbcnt_hi((unsigned)(m1 >> 32), __builtin_amdgcn_mbcnt_lo((unsigned)m1, 0));
            int* E_ = cE + u * 384; float* G_ = cG + u * 384; int* S_ = cS + u * 384;
            if (in0) { E_[r0] = e0; G_[r0] = g0; S_[r0] = lane; }
            if (in1) { E_[r1] = e1; G_[r1] = g1; S_[r1] = 64 + lane; }
        }
#pragma unroll
        for (int u = 0; u < 2; ++u) { const int tn = t + (2 + u) * nslw; const int t2 = tn < T ? tn : 0; PH_FETCH(u, t2); }
        int me[2][2]; float mg[2][2], msu[2][2]; int ms[2][2]; u32x4 ur[2][2][8];
#pragma unroll
        for (int u = 0; u < 2; ++u)
#pragma unroll
            for (int q = 0; q < 2; ++q) { const int ent = min(8 * q + grp, max(cnt[u] - 1, 0)); me[u][q] = cE[u * 384 + ent]; mg[u][q] = cG[u * 384 + ent]; ms[u][q] = cS[u * 384 + ent];
                if (cnt[u] == 0) me[u][q] = 2048 * x;
                msu[u][q] = su[me[u][q]]; const unsigned char* pr = u8 + (size_t)me[u][q] * 1024 + sub * 16;
#pragma unroll
                for (int j = 0; j < 8; ++j) ur[u][q][j] = *(const u32x4*)(pr + j * 128); }
        __builtin_amdgcn_sched_barrier(0);
#pragma unroll
        for (int u = 0; u < 2; ++u)
#pragma unroll
            for (int q = 0; q < 2; ++q) { int s; PH_DOT(s, hv[u], ur[u][q]);
                const float cc = mg[u][q] * gelu_as(hs[u] * msu[u][q] * (float)s);
                if (sub == 0 && val[u] && 8 * q + grp < cnt[u]) cbuf[(size_t)tt[u] * 128 + ms[u][q]] = cc; }
#pragma unroll
        for (int u = 0; u < 2; ++u)
            for (int b0 = 16; b0 < cnt[u]; b0 += 8) { const int ent = min(b0 + grp, cnt[u] - 1); const int me_ = cE[u * 384 + ent]; const float mg_ = cG[u * 384 + ent]; const int ms_ = cS[u * 384 + ent];
                const float msu_ = su[me_]; const unsigned char* pr = u8 + (size_t)me_ * 1024 + sub * 16; u32x4 ux[8];
#pragma unroll
                for (int j = 0; j < 8; ++j) ux[j] = *(const u32x4*)(pr + j * 128);
                int s; PH_DOT(s, hv[u], ux);
                const float cc = mg_ * gelu_as(hs[u] * msu_ * (float)s);
                if (sub == 0 && val[u] && b0 + grp < cnt[u]) cbuf[(size_t)tt[u] * 128 + ms_] = cc; }
    }
#undef PH_FETCH
#undef PH_DOT
}
template <int DRY>
__device__ __forceinline__ void peer_O2(const Ctx& c, const Params& p) {
    typedef float f32x2 __attribute__((ext_vector_type(2)));
    const int tid = opaque_tid(), lane = tid & 63, wid = __builtin_amdgcn_readfirstlane(tid >> 6);
    const unsigned char* v8 = p.ws + OFF_R5 + (size_t)NEXP * 1024;
    const int* experts = (const int*)(p.ws + OFF_R4); const float* cbuf = (const float*)(p.ws + OFF_CBUF); float* s2 = (float*)(p.ws + OFF_SUMSQ2);
    const int x = c.bid & 7, nslw = ((c.nb - x + 7) >> 3) * (NT / 64), wx = (c.bid >> 3) * (NT / 64) + wid;
    const int grp = lane >> 3, sub = lane & 7, col = 128 * x + 16 * sub;
    const unsigned char* v8x = v8 + (size_t)x * ((size_t)NEXP * 128) + 16 * sub;
    u32x4 En[2][4];
#define PO_FETCH(u_, t_) do { _Pragma("unroll") for (int j_ = 0; j_ < 4; ++j_) En[u_][j_] = *(const u32x4*)(experts + (size_t)(t_) * 128 + grp * 16 + 4 * j_); } while (0)
#pragma unroll
    for (int u = 0; u < 2; ++u) { const int tt = wx + u * nslw < T ? wx + u * nslw : 0; PO_FETCH(u, tt); }
    for (int t = wx; t < T; t += 2 * nslw) {
        u32x4 vr[2][16]; f32x4 cv[2][4]; u32x4 hpre[2][2];
#pragma unroll
        for (int u = 0; u < 2; ++u) { const int tt = t + u * nslw < T ? t + u * nslw : 0;
#pragma unroll
            for (int j = 0; j < 2; ++j) hpre[u][j] = *(const u32x4*)((const bf16_t*)(p.ws + OFF_R3) + (size_t)tt * 1024 + col + 8 * j);
#pragma unroll
            for (int j = 0; j < 4; ++j) { cv[u][j] = *(const f32x4*)(cbuf + (size_t)tt * 128 + grp * 16 + 4 * j);
#pragma unroll
                for (int k = 0; k < 4; ++k) { int e = (int)En[u][j][k]; if (DRY == 2) e &= 7; vr[u][4 * j + k] = *(const u32x4*)(v8x + (size_t)e * 128); } } }
#pragma unroll
        for (int u = 0; u < 2; ++u) { const int tn = t + (2 + u) * nslw; const int tt = tn < T ? tn : 0; PO_FETCH(u, tt); }
        __builtin_amdgcn_sched_barrier(0);
#pragma unroll
        for (int u = 0; u < 2; ++u) {
            f32x2 acc[8];
#pragma unroll
            for (int i = 0; i < 8; ++i) acc[i] = f32x2{0.f, 0.f};
#pragma unroll
            for (int it = 0; it < 16; ++it) { const float cs_ = cv[u][it >> 2][it & 3]; const f32x2 cc = {cs_, cs_};
#pragma unroll
                for (int w = 0; w < 4; ++w) { const int q = (int)vr[u][it][w];
                    acc[2 * w] += __builtin_amdgcn_cvt_pk_f32_fp8(q, false) * cc; acc[2 * w + 1] += __builtin_amdgcn_cvt_pk_f32_fp8(q, true) * cc; } }
            float a16[16];
#pragma unroll
            for (int i = 0; i < 8; ++i) { a16[2 * i] = acc[i].x; a16[2 * i + 1] = acc[i].y; }
#pragma unroll
            for (int i = 0; i < 16; ++i) { float v = a16[i];
                v += __builtin_amdgcn_update_dpp(0.f, v, 0x128, 0xf, 0xf, true);
                { auto r = __builtin_amdgcn_permlane16_swap(__float_as_uint(v), __float_as_uint(v), false, false); v = __uint_as_float(r[0]) + __uint_as_float(r[1]); }
                { auto r = __builtin_amdgcn_permlane32_swap(__float_as_uint(v), __float_as_uint(v), false, false); v = __uint_as_float(r[0]) + __uint_as_float(r[1]); }
                a16[i] = v; }
            const int tt = t + u * nslw; float ss = 0.f;
            if (grp == 0 && tt < T) { bf16_t* hrow = (bf16_t*)(p.ws + OFF_R3) + (size_t)tt * 1024 + col;
#pragma unroll
                for (int j = 0; j < 2; ++j) { float f[8]; unpack8(hpre[u][j], f);
#pragma unroll
                    for (int k = 0; k < 8; ++k) { f[k] += a16[8 * j + k]; ss += f[k] * f[k]; }
                    if (!DRY) *(u32x4*)(hrow + 8 * j) = pack8(f); } }
            ss += __builtin_amdgcn_update_dpp(0.f, ss, 0xB1, 0xf, 0xf, true); ss += __builtin_amdgcn_update_dpp(0.f, ss, 0x4E, 0xf, 0xf, true); ss += __builtin_amdgcn_update_dpp(0.f, ss, 0x141, 0xf, 0xf, true);
            if (DRY) asm volatile("" :: "v"(ss)); else if (lane == 0 && tt < T) unsafeAtomicAdd(s2 + tt, ss);
        }
    }
#undef PO_FETCH
}
__device__ __forceinline__ void peer_N(const Ctx& c, const Params& p) {
    const int lane = c.lane; const float* s2 = (const float*)(p.ws + OFF_SUMSQ2);
    f32x4 fw[4];
#pragma unroll
    for (int j = 0; j < 4; ++j) fw[j] = *(const f32x4*)(p.final_w + 4 * lane + 256 * j);
    for (int t0 = c.gw; t0 < T; t0 += 4 * c.ngw) {
        u32x2 w[4][4]; float ss[4];
#pragma unroll
        for (int u = 0; u < 4; ++u) { const int t = t0 + u * c.ngw < T ? t0 + u * c.ngw : t0; const bf16_t* hrow = (const bf16_t*)(p.ws + OFF_R3) + (size_t)t * 1024 + 4 * lane; ss[u] = s2[t];
#pragma unroll
            for (int j = 0; j < 4; ++j) w[u][j] = *(const u32x2*)(hrow + 256 * j); }
#pragma unroll
        for (int u = 0; u < 4; ++u) { const int t = t0 + u * c.ngw; if (t < T) { float* row = p.out + (size_t)t * 1024 + 4 * lane; const float r = rsqrtf(ss[u] * (1.f / 1024.f) + EPS);
#pragma unroll
            for (int j = 0; j < 4; ++j) { const f32x4 hv = {bflo(w[u][j].x), bfhi(w[u][j].x), bflo(w[u][j].y), bfhi(w[u][j].y)}; *(f32x4*)(row + 256 * j) = hv * r * fw[j]; } } }
    }
}

constexpr int LDS_BYTES = 144 * 1024;
__global__ void __launch_bounds__(NT, 2) fwd_megakernel(Params p_arg) {
    extern __shared__ __attribute__((aligned(16))) unsigned char lds_raw[];
    typedef const Params __attribute__((address_space(4)))* KargP;
    const KargP pk_ = (KargP)__builtin_amdgcn_kernarg_segment_ptr();
#if defined(__HIP_DEVICE_COMPILE__)
#define RELOAD_P() ({ KargP q_ = pk_; asm volatile("" : "+s"(q_)); Params t_; __builtin_memcpy(&t_, q_, sizeof(Params)); t_; })
#else
#define RELOAD_P() (p_arg)
#endif
    Params p = p_arg;
    cg::grid_group grid = cg::this_grid();
#define MKCTX() ({ Ctx c_; c_.tid = opaque_tid(); c_.lane = c_.tid & 63; c_.wave = __builtin_amdgcn_readfirstlane(c_.tid >> 6); c_.bid = blockIdx.x; { int nb_ = (int)gridDim.x; asm volatile("" : "+s"(nb_)); c_.nb = nb_; } \
    c_.gw = c_.bid * (NT / 64) + c_.wave; c_.ngw = c_.nb * (NT / 64); c_.lds = (float*)lds_raw; c_; })
    Ctx c = MKCTX();
    volatile LAS unsigned* xb_st = (volatile LAS unsigned*)(lds_raw + LDS_BYTES - 16);
    if (threadIdx.x < 4) xb_st[threadIdx.x] = 0u;
    __syncthreads();
    const XcdBarrier xbar = xcd_barrier_post((unsigned*)(p.ws + OFF_BAR), xb_st);
#define GSYNC() do { xcd_barrier(xbar); c = MKCTX(); p = RELOAD_P(); } while (0)
#define RP(k, call) for (int r_ = 0; r_ < ((PROBE_PH == (k)) ? 2 : 1); ++r_) { call; }
    if (PROBE_PH == 30 && c.tid == 0) __hip_atomic_store((unsigned*)(p.ws + OFF_BAR + 16384) + c.bid, xb_xcc_id(), __ATOMIC_RELAXED, __HIP_MEMORY_SCOPE_AGENT);
    RP(0, ph0_v2(c, p));
    if (p.ws == nullptr) grid.sync();
    GSYNC();
    RP(1, ph1_mfma(c, p)); GSYNC();
    RP(2, ph2a1_v2(c, p)); GSYNC();
    RP(3, ph2a2_v3(c, p)); if (PROBE_PH == 24) ph2b_v4<1>(c, p);
    if (PROBE_PH == 25) ph2b_v4<2>(c, p);
    RP(5, ph2b_v4<0>(c, p)); GSYNC();
    const bool split = c.nb == 256; constexpr int TAB_SPLIT = NEXP / 2;
    if (split) {
        if (c.bid >= 32) { RP(6, ph3a_split(c, p)); }
        else { RP(7, ph3b_mfma<0>(c, p)); RP(9, ph4a_tables_q8(c, p, c.gw, 32 * (NT / 64), 0, TAB_SPLIT)); }
    } else {
        ph3a_mfma(c, p);
        if (c.bid < 32) ph3b_mfma<0>(c, p); else ph4a_tables_q8(c, p, (c.bid - 32) * (NT / 64) + c.wave, (c.nb - 32) * (NT / 64), 0, TAB_SPLIT);
    }
    GSYNC();
    RP(8, ph4a_v2(c, p, split)); RP(11, ph4a_tables_q8(c, p, c.gw, c.ngw, TAB_SPLIT, 2 * NEXP)); GSYNC();
    RP(10, ph4b_v2(c, p)); GSYNC();
    RP(12, ph5_v2(c, p)); GSYNC();
    RP(13, ph6_fast(c, p));
    if (PROBE_PH == 30 && c.bid == 0 && c.tid == 0) {
        const unsigned* ids = (const unsigned*)(p.ws + OFF_BAR + 16384); bool ok = true;
        for (int b_ = 0; b_ < c.nb; ++b_) ok = ok && (__hip_atomic_load(ids + b_, __ATOMIC_RELAXED, __HIP_MEMORY_SCOPE_AGENT) == __hip_atomic_load(ids + (b_ & 7), __ATOMIC_RELAXED, __HIP_MEMORY_SCOPE_AGENT));
        for (int b_ = 0; b_ < 8; ++b_) for (int c_ = 0; c_ < b_; ++c_) ok = ok && (__hip_atomic_load(ids + b_, __ATOMIC_RELAXED, __HIP_MEMORY_SCOPE_AGENT) != __hip_atomic_load(ids + c_, __ATOMIC_RELAXED, __HIP_MEMORY_SCOPE_AGENT));
        if (!ok) for (int i_ = 0; i_ < 1024 * 64; ++i_) ((float*)p.out)[i_ * 16] = 1e30f; }
    RP(17, peer_hq(c, p)); GSYNC();
    if (PROBE_PH == 26) peer_H3<1>(c, p);
    if (PROBE_PH == 27) peer_H3<2>(c, p);
    if (PROBE_PH == 28) peer_H3<3>(c, p);
    RP(18, peer_H4(c, p)); GSYNC();
    if (PROBE_PH == 19) peer_O2<1>(c, p);
    if (PROBE_PH == 22) peer_O2<2>(c, p);
    peer_O2<0>(c, p); GSYNC();
    peer_N(c, p);
    if (PROBE_PH == 15) { for (int r_ = 0; r_ < 10; ++r_) GSYNC(); }
}

extern "C" void kernel_launch(void* const* d_in, const int* in_sizes, int n_in, void* d_out, int out_size, void* d_ws, size_t ws_size, hipStream_t stream) {
    static int grid_blocks = 0;
    if (grid_blocks == 0) {
        if (n_in != 21 || out_size != T * D_MODEL || ws_size < WS_END) { fprintf(stderr, "kernel_launch: unexpected shapes n_in %d out %d ws %zu\n", n_in, out_size, ws_size); grid_blocks = -1; return; }
        int dev = 0, cus = 0, per_cu = 0;
        hipGetDevice(&dev); hipDeviceGetAttribute(&cus, hipDeviceAttributeMultiprocessorCount, dev);
        if (hipFuncSetAttribute((const void*)fwd_megakernel, hipFuncAttributeMaxDynamicSharedMemorySize, LDS_BYTES) != hipSuccess) { fprintf(stderr, "kernel_launch: hipFuncSetAttribute failed\n"); grid_blocks = -1; return; }
        if (hipOccupancyMaxActiveBlocksPerMultiprocessor(&per_cu, (const void*)fwd_megakernel, NT, LDS_BYTES) != hipSuccess || per_cu < 1) { fprintf(stderr, "kernel_launch: occupancy query failed (%d)\n", per_cu); grid_blocks = -1; return; }
        grid_blocks = cus * per_cu;
    }
    if (grid_blocks < 0) return;
    Params p{};
    p.x = (const float*)d_in[0]; p.pos = (const int*)d_in[1]; p.ln1_w = (const float*)d_in[2]; p.w_in = (const float*)d_in[3]; p.q_a_norm_w = (const float*)d_in[4];
    p.w_q_up = (const float*)d_in[5]; p.kv_a_norm_w = (const float*)d_in[6]; p.w_kv_up = (const float*)d_in[7]; p.conv_w = (const float*)d_in[8];
    p.a_log_f = (const float*)d_in[9]; p.dt_bias_f = (const float*)d_in[10]; p.a_log_b = (const float*)d_in[11]; p.dt_bias_b = (const float*)d_in[12];
    p.gdn_norm_w = (const float*)d_in[13]; p.w_out = (const float*)d_in[14]; p.ln2_w = (const float*)d_in[15]; p.peer_wq = (const float*)d_in[16];
    p.sub_keys = (const float*)d_in[17]; p.peer_u = (const float*)d_in[18]; p.peer_v = (const float*)d_in[19]; p.final_w = (const float*)d_in[20];
    p.out = (float*)d_out; p.ws = (unsigned char*)d_ws;
    if (hipMemsetAsync((char*)d_ws + OFF_BAR, 0, 16384, stream) != hipSuccess) { fprintf(stderr, "kernel_launch: memset of barrier words failed\n"); return; }
    void* args[] = {&p};
    hipError_t e = hipLaunchCooperativeKernel((const void*)fwd_megakernel, dim3(grid_blocks), dim3(NT), args, LDS_BYTES, stream);
    if (e != hipSuccess) fprintf(stderr, "cooperative launch failed: %s (grid %d)\n", hipGetErrorString(e), grid_blocks);
}
```

```cpp
#include <hip/hip_runtime.h>
#include <hip/hip_cooperative_groups.h>
#include <cstdio>
#include <cstdint>
namespace cg = cooperative_groups;

constexpr int D_MODEL = 1024, BATCH = 2, SEQ = 8192, T = BATCH * SEQ;
constexpr int MLA_H = 4, QRANK = 256, KVRANK = 128, NOPE = 128, ROPE = 64, VDIM = 128, QKD = 192;
constexpr int GH = 4, DK = 128, DV = 128, CHUNK = 64, NCH = SEQ / CHUNK;
constexpr int GDN_QKV = 1536, IN_W = 2512, IN_WP = 2560;
constexpr int C_QKV = 448, C_GATE = 1984;
constexpr int PH = 8, NKEYS = 128, TOPK = 16, NEXP = 16384;
constexpr float EPS = 1e-6f;
constexpr int NT = 512;

typedef unsigned short bf16_t;
typedef float f32x4 __attribute__((ext_vector_type(4)));
typedef unsigned u32x4 __attribute__((ext_vector_type(4)));
typedef unsigned u32x2 __attribute__((ext_vector_type(2)));

__device__ __forceinline__ int opaque_tid() { int t; asm volatile("v_mov_b32 %0, %1" : "=v"(t) : "v"((int)threadIdx.x)); return t; }
__device__ __forceinline__ float bf2f(bf16_t v) { return __uint_as_float((unsigned)v << 16); }
__device__ __forceinline__ bf16_t f2bf(float f) { unsigned u = __float_as_uint(f); u += 0x7fffu + ((u >> 16) & 1u); return (bf16_t)(u >> 16); }
__device__ __forceinline__ float bflo(unsigned w) { return __uint_as_float(w << 16); }
__device__ __forceinline__ float bfhi(unsigned w) { return __uint_as_float(w & 0xffff0000u); }
__device__ __forceinline__ unsigned pk2(float lo, float hi) { return (unsigned)f2bf(lo) | ((unsigned)f2bf(hi) << 16); }
__device__ __forceinline__ float wave_sum(float v) {
#pragma unroll
    for (int o = 1; o < 64; o <<= 1) v += __shfl_xor(v, o);
    return v;
}
__device__ __forceinline__ float sigmoidf_(float x) { return __builtin_amdgcn_rcpf(1.f + __expf(-x)); }
__device__ __forceinline__ float siluf_(float x) { return x * sigmoidf_(x); }
__device__ __forceinline__ float softplusf_(float x) { return x > 20.f ? x : log1pf(expf(x)); }
__device__ __forceinline__ float gelu_erf(float x) { return 0.5f * x * (1.f + erff(x * 0.70710678118654752f)); }

namespace pg8 {
#define PG8_LAS __attribute__((address_space(3)))
typedef unsigned short bf16_t;
typedef short bf16x8 __attribute__((ext_vector_type(8)));
typedef float f32x4 __attribute__((ext_vector_type(4)));
typedef unsigned u32x4 __attribute__((ext_vector_type(4)));
constexpr int BM = 256, BK = 64, HALF = 128, HTB = HALF * BK * 2  , STAGE_BYTES = 8 * HTB, NXCD = 8, WGM = 8;

__host__ __device__ __forceinline__ int lds_byte(int r, int c) { const int st = (r >> 4) * 2 + (c >> 5), rr = r & 15, cc = c & 31, ob = rr * 64 + cc * 2; return st * 1024 + (ob ^ (((ob >> 9) & 1) << 5)); }
__host__ __device__ __forceinline__ void stage_rc(int b, int& R, int& C) { const int st = b / 1024, sb = b % 1024, swz = sb ^ (((sb >> 9) & 1) << 5); R = (st >> 1) * 16 + swz / 64; C = (st & 1) * 32 + (swz % 64) / 2; }
__host__ __device__ __forceinline__ int perm32(int rho) { const int n = rho >> 4, i = rho & 15; return 8 * (i >> 2) + 4 * n + (i & 3); }

struct Unit { int pm, pn; };
struct Gemm { const bf16_t* A; const bf16_t* Bt; int M, N, K, lda, ldb; };

struct StaticOrder {
    int nM, nN, nwg, G, c;
    __host__ __device__ void init(int M, int N, int G_, int c_) { nM = M / BM; nN = N / BM; nwg = nM * nN; G = G_; c = c_; }
    __host__ __device__ bool next(int i, Unit& u) const {
        const long L = (long)i * G + c; if (L >= nwg) return false;
        int wgid = (int)L; { const int q = nwg / NXCD, r = nwg % NXCD, xcd = wgid % NXCD, off = wgid / NXCD; wgid = (xcd < r ? xcd * (q + 1) : r * (q + 1) + (xcd - r) * q) + off; }
        const int nig = WGM * nN, gid = wgid / nig, fm = gid * WGM, gsz = (nM - fm) < WGM ? (nM - fm) : WGM;
        u.pm = fm + ((wgid % nig) % gsz); u.pn = (wgid % nig) / gsz; return true;
    }
    __device__ __forceinline__ void a_ready(const Unit&) const {}
    __device__ __forceinline__ void done(const Unit&) const {}
};
__device__ __forceinline__ unsigned cvt_pk_bf16(float lo, float hi) { unsigned r; asm volatile("v_cvt_pk_bf16_f32 %0, %1, %2" : "=v"(r) : "v"(lo), "v"(hi)); return r; }
typedef float f32x2 __attribute__((ext_vector_type(2)));
template <class Epi, class Sched, bool ALIGN_EPI = false, bool SP2 = false>
__device__ __forceinline__ void gemm_phase(PG8_LAS unsigned char* lds, const Gemm g, const Sched& S, const Epi& E) {
    const int tid = opaque_tid(), wid = __builtin_amdgcn_readfirstlane(tid >> 6), lane = tid & 63, wr = wid >> 2, wc = wid & 3, fr = lane & 15, fq = lane >> 4;
    const int K = g.K, nt = K / BK;
    unsigned voffA[2], voffB[2];
#pragma unroll
    for (int i = 0; i < 2; ++i) { int R, C; stage_rc(tid * 16 + i * 8192, R, C); const int Rb = Epi::PERM ? ((R & ~31) + perm32(R & 31)) : R;
        voffA[i] = (unsigned)(R * g.lda + C) * 2u; voffB[i] = (unsigned)(Rb * g.ldb + C) * 2u; }
    const size_t kstep = (size_t)(BK * 2);
    const size_t hstepA = (size_t)HALF * g.lda * 2, hstepB = (size_t)HALF * g.ldb * 2;
    const size_t tstepA = 2 * hstepA, tstepB = 2 * hstepB;
    const unsigned ldsw = (unsigned)wid * 1024u;
    const int aoff = lds_byte(wr * 64 + fr, fq * 8), boff = lds_byte(wc * 32 + fr, fq * 8);
#define PG8_SA(b, h) (((b) * 2 + (h)) * HTB)
#define PG8_SB(b, h) ((4 + (b) * 2 + (h)) * HTB)
#define PG8_STAGE(bufoff, gbase, voff) do { _Pragma("unroll") for (int _i = 0; _i < 2; ++_i) \
        __builtin_amdgcn_global_load_lds((const unsigned*)((const char*)(gbase) + (voff)[_i]), (PG8_LAS unsigned*)(lds + (bufoff) + ldsw + _i * 8192), 16, 0, 0); } while (0)
#define PG8_LDA(dst, b, h) do { _Pragma("unroll") for (int m = 0; m < 4; ++m) _Pragma("unroll") for (int k = 0; k < 2; ++k) dst[m][k] = *(const PG8_LAS bf16x8*)(lds + PG8_SA(b, h) + aoff + m * 2048 + k * 1024); } while (0)
#define PG8_LDB(dst, b, h) do { _Pragma("unroll") for (int n = 0; n < 2; ++n) _Pragma("unroll") for (int k = 0; k < 2; ++k) dst[n][k] = *(const PG8_LAS bf16x8*)(lds + PG8_SB(b, h) + boff + n * 2048 + k * 1024); } while (0)
#define PG8_MMA(ai, bj, At, Bt) do { __builtin_amdgcn_s_setprio(1); _Pragma("unroll") for (int m = 0; m < 4; ++m) _Pragma("unroll") for (int n = 0; n < 2; ++n) _Pragma("unroll") for (int k = 0; k < 2; ++k) \
        acc[ai][bj][m][n] = __builtin_amdgcn_mfma_f32_16x16x32_bf16(Bt[n][k], At[m][k], acc[ai][bj][m][n], 0, 0, 0); __builtin_amdgcn_s_setprio(0); } while (0)
#define PG8_WAIT_V(n) asm volatile("s_waitcnt vmcnt(" #n ")" ::: "memory")
#define PG8_WAIT_L(n) asm volatile("s_waitcnt lgkmcnt(" #n ")" ::: "memory")
#define PG8_BAR __builtin_amdgcn_s_barrier()
#define PG8_SCHED __builtin_amdgcn_sched_barrier(0)
    Unit cur, nxt; int ui = 0;
    if (!S.next(0, cur)) return;
    f32x4 acc[2][2][4][2];
#pragma unroll
    for (int a = 0; a < 2; ++a)
#pragma unroll
        for (int b = 0; b < 2; ++b)
#pragma unroll
            for (int m = 0; m < 4; ++m)
#pragma unroll
                for (int n = 0; n < 2; ++n) acc[a][b][m][n] = (f32x4){0.f, 0.f, 0.f, 0.f};
    bf16x8 At[4][2], B0[2][2], B1[2][2];
    const char* cA = (const char*)g.A + (size_t)cur.pm * tstepA; const char* cB = (const char*)g.Bt + (size_t)cur.pn * tstepB;
    S.a_ready(cur);
    if constexpr (SP2) {
        PG8_STAGE(PG8_SB(0, 0), cB, voffB); PG8_STAGE(PG8_SB(0, 1), cB + hstepB, voffB); PG8_STAGE(PG8_SA(0, 0), cA, voffA); PG8_STAGE(PG8_SA(0, 1), cA + hstepA, voffA);
        if (wr == 1) PG8_BAR;
        PG8_WAIT_V(2); PG8_BAR;
        PG8_STAGE(PG8_SB(1, 0), cB + kstep, voffB); PG8_STAGE(PG8_SA(1, 0), cA + kstep, voffA); PG8_STAGE(PG8_SB(1, 1), cB + hstepB + kstep, voffB);
        PG8_WAIT_V(6); PG8_BAR;
    } else {
        PG8_STAGE(PG8_SB(0, 0), cB, voffB); PG8_STAGE(PG8_SA(0, 0), cA, voffA); PG8_STAGE(PG8_SB(0, 1), cB + hstepB, voffB); PG8_STAGE(PG8_SA(0, 1), cA + hstepA, voffA);
        if (wr == 1) PG8_BAR;
        PG8_WAIT_V(4); PG8_BAR;
        PG8_STAGE(PG8_SB(1, 0), cB + kstep, voffB); PG8_STAGE(PG8_SA(1, 0), cA + kstep, voffA); PG8_STAGE(PG8_SB(1, 1), cB + hstepB + kstep, voffB);
        PG8_WAIT_V(6); PG8_BAR;
    }
    for (;;) {
        const bool has_next = S.next(ui + 1, nxt);
        const char* nA = has_next ? (const char*)g.A + (size_t)nxt.pm * tstepA : cA; const char* nB = has_next ? (const char*)g.Bt + (size_t)nxt.pn * tstepB : cB;
        for (int t = 0; t < nt; t += 2) {
            const bool last = (t == nt - 2);
            const char* a1 = cA + (size_t)(t + 1) * kstep;
            const char* a2 = last ? nA : cA + (size_t)(t + 2) * kstep; const char* b2 = last ? nB : cB + (size_t)(t + 2) * kstep;
            const char* a3 = a2 + kstep; const char* b3 = b2 + kstep;
            if (last && has_next) S.a_ready(nxt);
            if constexpr (SP2) {
            PG8_LDB(B0, 0, 0); PG8_LDB(B1, 0, 1); PG8_SCHED; PG8_LDA(At, 0, 0); PG8_STAGE(PG8_SA(1, 1), a1 + hstepA, voffA);
            PG8_WAIT_V(8); PG8_WAIT_L(0); PG8_BAR; PG8_MMA(0, 0, At, B0); PG8_MMA(0, 1, At, B1); PG8_BAR; PG8_SCHED;
            PG8_LDA(At, 0, 1); PG8_STAGE(PG8_SB(0, 0), b2, voffB); PG8_STAGE(PG8_SB(0, 1), b2 + hstepB, voffB); PG8_STAGE(PG8_SA(0, 0), a2, voffA);
            PG8_WAIT_V(8); PG8_WAIT_L(0); PG8_BAR; PG8_MMA(1, 0, At, B0); PG8_MMA(1, 1, At, B1); PG8_BAR; PG8_SCHED;
            PG8_LDB(B0, 1, 0); PG8_LDB(B1, 1, 1); PG8_SCHED; PG8_LDA(At, 1, 0); PG8_STAGE(PG8_SA(0, 1), a2 + hstepA, voffA);
            PG8_WAIT_V(8); PG8_WAIT_L(0); PG8_BAR; PG8_MMA(0, 0, At, B0); PG8_MMA(0, 1, At, B1); PG8_BAR; PG8_SCHED;
            PG8_LDA(At, 1, 1); PG8_STAGE(PG8_SB(1, 0), b3, voffB); PG8_STAGE(PG8_SB(1, 1), b3 + hstepB, voffB); PG8_STAGE(PG8_SA(1, 0), a3, voffA);
            PG8_WAIT_V(8); PG8_WAIT_L(0); PG8_BAR; PG8_MMA(1, 0, At, B0); PG8_MMA(1, 1, At, B1); PG8_BAR; PG8_SCHED;
            } else {
            PG8_LDB(B0, 0, 0); PG8_SCHED; PG8_LDA(At, 0, 0); PG8_STAGE(PG8_SA(1, 1), a1 + hstepA, voffA);
            PG8_WAIT_L(8); PG8_BAR; PG8_WAIT_L(0); PG8_MMA(0, 0, At, B0); PG8_BAR; PG8_SCHED;
            PG8_LDB(B1, 0, 1); PG8_STAGE(PG8_SB(0, 0), b2, voffB);
            PG8_BAR; PG8_WAIT_L(0); PG8_MMA(0, 1, At, B1); PG8_BAR;
            PG8_LDA(At, 0, 1); PG8_STAGE(PG8_SA(0, 0), a2, voffA);
            PG8_BAR; PG8_WAIT_L(0); PG8_MMA(1, 0, At, B0); PG8_BAR; PG8_SCHED;
            PG8_STAGE(PG8_SB(0, 1), b2 + hstepB, voffB);
            PG8_WAIT_V(6); PG8_BAR; PG8_MMA(1, 1, At, B1); PG8_BAR;
            PG8_LDB(B0, 1, 0); PG8_SCHED; PG8_LDA(At, 1, 0); PG8_STAGE(PG8_SA(0, 1), a2 + hstepA, voffA);
            PG8_WAIT_L(8); PG8_BAR; PG8_WAIT_L(0); PG8_MMA(0, 0, At, B0); PG8_BAR; PG8_SCHED;
            PG8_LDB(B1, 1, 1); PG8_STAGE(PG8_SB(1, 0), b3, voffB);
            PG8_BAR; PG8_WAIT_L(0); PG8_MMA(0, 1, At, B1); PG8_BAR;
            PG8_LDA(At, 1, 1); PG8_STAGE(PG8_SA(1, 0), a3, voffA);
            PG8_BAR; PG8_WAIT_L(0); PG8_MMA(1, 0, At, B0); PG8_BAR; PG8_SCHED;
            PG8_STAGE(PG8_SB(1, 1), b3 + hstepB, voffB);
            PG8_WAIT_V(6); PG8_BAR; PG8_MMA(1, 1, At, B1); PG8_BAR;
            }
        }
        if constexpr (ALIGN_EPI) { if (wr == 0) PG8_BAR; }
        if constexpr (!Epi::AFTER_DRAIN) { E(acc, cur, wr, wc, fr, fq); S.done(cur); }
        if (!has_next) break;
#pragma unroll
        for (int a = 0; a < 2; ++a)
#pragma unroll
            for (int b = 0; b < 2; ++b)
#pragma unroll
                for (int m = 0; m < 4; ++m)
#pragma unroll
                    for (int n = 0; n < 2; ++n) acc[a][b][m][n] = (f32x4){0.f, 0.f, 0.f, 0.f};
        cur = nxt; cA = nA; cB = nB; ++ui;
        if constexpr (ALIGN_EPI) { if (wr == 1) PG8_BAR; }
    }
    PG8_WAIT_V(0);
    if constexpr (!ALIGN_EPI) { if (wr == 0) PG8_BAR; }
    PG8_BAR;
    if constexpr (Epi::AFTER_DRAIN) { E.fused(acc, cur, wr, wc, fr, fq, lds, wid, lane); S.done(cur); }
#undef PG8_SA
#undef PG8_SB
#undef PG8_STAGE
#undef PG8_LDA
#undef PG8_LDB
#undef PG8_MMA
#undef PG8_WAIT_V
#undef PG8_WAIT_L
#undef PG8_BAR
#undef PG8_SCHED
}

struct EpiScaleBf16 {
    static constexpr bool PERM = true, AFTER_DRAIN = false;
    bf16_t* O; int ldc; const float* rs;
    __device__ __forceinline__ void operator()(const f32x4 (&acc)[2][2][4][2], const Unit& u, int wr, int wc, int fr, int fq) const {
        const int row0 = u.pm * BM + wr * 64 + fr, col0 = u.pn * BM + wc * 32 + 8 * fq;
#pragma unroll
        for (int ai = 0; ai < 2; ++ai)
#pragma unroll
            for (int m = 0; m < 4; ++m) { const int r = row0 + ai * HALF + m * 16; const float sc = rs ? rs[r] : 1.f; bf16_t* rowp = O + (size_t)r * ldc + col0;
#pragma unroll
                for (int bj = 0; bj < 2; ++bj) { const f32x4 v0 = acc[ai][bj][m][0] * sc, v1 = acc[ai][bj][m][1] * sc;
                    u32x4 w; w.x = cvt_pk_bf16(v0[0], v0[1]); w.y = cvt_pk_bf16(v0[2], v0[3]); w.z = cvt_pk_bf16(v1[0], v1[1]); w.w = cvt_pk_bf16(v1[2], v1[3]);
                    *(u32x4*)(rowp + bj * HALF) = w; } }
    }
};
struct EpiResF32 {
    static constexpr bool PERM = false, AFTER_DRAIN = false;
    const float* base; float* out; int ldc;
    __device__ __forceinline__ void operator()(const f32x4 (&acc)[2][2][4][2], const Unit& u, int wr, int wc, int fr, int fq) const {
        const int row0 = u.pm * BM + wr * 64 + fr, col0 = u.pn * BM + wc * 32 + 4 * fq;
#pragma unroll
        for (int ai = 0; ai < 2; ++ai)
#pragma unroll
            for (int m = 0; m < 4; ++m) { const size_t off = (size_t)(row0 + ai * HALF + m * 16) * ldc + col0;
#pragma unroll
                for (int bj = 0; bj < 2; ++bj)
#pragma unroll
                    for (int n = 0; n < 2; ++n) { const f32x4 b = *(const f32x4*)(base + off + bj * HALF + n * 16); *(f32x4*)(out + off + bj * HALF + n * 16) = b + acc[ai][bj][m][n]; } }
    }
};
struct EpiResF32Hb {
    static constexpr bool PERM = false, AFTER_DRAIN = false;
    const float* base; float* out; bf16_t* hb; float* sumsq; int ldc;
    __device__ __forceinline__ void operator()(const f32x4 (&acc)[2][2][4][2], const Unit& u, int wr, int wc, int fr, int fq) const {
        const int row0 = u.pm * BM + wr * 64 + fr, col0 = u.pn * BM + wc * 32 + 4 * fq;
#pragma unroll
        for (int ai = 0; ai < 2; ++ai)
#pragma unroll
            for (int m = 0; m < 4; ++m) { const int r = row0 + ai * HALF + m * 16; const size_t off = (size_t)r * ldc + col0; float ss = 0.f;
#pragma unroll
                for (int bj = 0; bj < 2; ++bj)
#pragma unroll
                    for (int n = 0; n < 2; ++n) { const f32x4 o = *(const f32x4*)(base + off + bj * HALF + n * 16) + acc[ai][bj][m][n];
                        ss += o[0] * o[0] + o[1] * o[1] + o[2] * o[2] + o[3] * o[3];
                        typedef unsigned u32x2v __attribute__((ext_vector_type(2))); u32x2v w; w.x = cvt_pk_bf16(o[0], o[1]); w.y = cvt_pk_bf16(o[2], o[3]);
                        *(u32x2v*)(hb + off + bj * HALF + n * 16) = w; }
                ss += __shfl_xor(ss, 16); ss += __shfl_xor(ss, 32);
                if (fq == 0) unsafeAtomicAdd(sumsq + r, ss); }
    }
};
struct EpiSiluBf16 {
    static constexpr bool PERM = true, AFTER_DRAIN = false;
    bf16_t* O; int ldc;
    __device__ __forceinline__ void operator()(const f32x4 (&acc)[2][2][4][2], const Unit& u, int wr, int wc, int fr, int fq) const {
        const int row0 = u.pm * BM + wr * 64 + fr, col0 = u.pn * BM + wc * 32 + 8 * fq;
#pragma unroll
        for (int ai = 0; ai < 2; ++ai)
#pragma unroll
            for (int m = 0; m < 4; ++m) { bf16_t* rowp = O + (size_t)(row0 + ai * HALF + m * 16) * ldc + col0;
#pragma unroll
                for (int bj = 0; bj < 2; ++bj) { const f32x4 v0 = acc[ai][bj][m][0], v1 = acc[ai][bj][m][1];
                    u32x4 w; w.x = cvt_pk_bf16(siluf_(v0[0]), siluf_(v0[1])); w.y = cvt_pk_bf16(siluf_(v0[2]), siluf_(v0[3])); w.z = cvt_pk_bf16(siluf_(v1[0]), siluf_(v1[1])); w.w = cvt_pk_bf16(siluf_(v1[2]), siluf_(v1[3]));
                    *(u32x4*)(rowp + bj * HALF) = w; } }
    }
};
struct EpiMlaQ {
    static constexpr bool PERM = true, AFTER_DRAIN = false;
    bf16_t* Q; const float* rq; const float* cst;
    __device__ __forceinline__ void operator()(const f32x4 (&acc)[2][2][4][2], const Unit& u, int wr, int wc, int fr, int fq) const {
        typedef unsigned u32x2v __attribute__((ext_vector_type(2)));
        const int row0 = u.pm * BM + wr * 64 + fr;
        const int c80 = u.pn * BM + wc * 32 + 8 * fq, c81 = c80 + HALF;
        const int h0 = c80 / 192, w0 = c80 % 192, h1 = c81 / 192, w1 = c81 % 192;
#pragma unroll
        for (int ai = 0; ai < 2; ++ai)
#pragma unroll
            for (int m = 0; m < 4; ++m) { const int t = row0 + ai * HALF + m * 16, b = t >> 13, s = t & (SEQ - 1); const float sc = rq[t];
                static_assert(SEQ == 8192, "token -> (batch, position) uses shifts");
#pragma unroll
                for (int bj = 0; bj < 2; ++bj) { const int hh = bj ? h1 : h0, w = bj ? w1 : w0;
                    bf16_t* dst = Q + ((size_t)(b * 4 + hh) * SEQ + s) * 192; const f32x4 v0 = acc[ai][bj][m][0] * sc, v1 = acc[ai][bj][m][1] * sc;
                    if (w < 128) { u32x4 o; o.x = cvt_pk_bf16(v0[0], v0[1]); o.y = cvt_pk_bf16(v0[2], v0[3]); o.z = cvt_pk_bf16(v1[0], v1[1]); o.w = cvt_pk_bf16(v1[2], v1[3]); *(u32x4*)(dst + w) = o; }
                    else { const int j = (w - 128) >> 1; const f32x4 cs = *(const f32x4*)(cst + (size_t)t * 64 + j), sn = *(const f32x4*)(cst + (size_t)t * 64 + 32 + j);
                        u32x2v o1, o2;
                        o1.x = cvt_pk_bf16(v0[0] * cs[0] - v0[1] * sn[0], v0[2] * cs[1] - v0[3] * sn[1]); o1.y = cvt_pk_bf16(v1[0] * cs[2] - v1[1] * sn[2], v1[2] * cs[3] - v1[3] * sn[3]);
                        o2.x = cvt_pk_bf16(v0[1] * cs[0] + v0[0] * sn[0], v0[3] * cs[1] + v0[2] * sn[1]); o2.y = cvt_pk_bf16(v1[1] * cs[2] + v1[0] * sn[2], v1[3] * cs[3] + v1[2] * sn[3]);
                        *(u32x2v*)(dst + 128 + j) = o1; *(u32x2v*)(dst + 160 + j) = o2; } }
                asm volatile("" ::: "memory"); }
    }
};
struct EpiMlaKV {
    static constexpr bool PERM = true, AFTER_DRAIN = false;
    bf16_t* K; bf16_t* V; const float* rkv;
    __device__ __forceinline__ void operator()(const f32x4 (&acc)[2][2][4][2], const Unit& u, int wr, int wc, int fr, int fq) const {
        const int row0 = u.pm * BM + wr * 64 + fr, hh = u.pn, wc8 = wc * 32 + 8 * fq;
#pragma unroll
        for (int ai = 0; ai < 2; ++ai)
#pragma unroll
            for (int m = 0; m < 4; ++m) { const int t = row0 + ai * HALF + m * 16, b = t >> 13, s = t & (SEQ - 1); const float sc = rkv[t]; const size_t rb = (size_t)(b * 4 + hh) * SEQ + s;
#pragma unroll
                for (int bj = 0; bj < 2; ++bj) { const f32x4 v0 = acc[ai][bj][m][0] * sc, v1 = acc[ai][bj][m][1] * sc;
                    u32x4 o; o.x = cvt_pk_bf16(v0[0], v0[1]); o.y = cvt_pk_bf16(v0[2], v0[3]); o.z = cvt_pk_bf16(v1[0], v1[1]); o.w = cvt_pk_bf16(v1[2], v1[3]);
                    *(u32x4*)((bj == 0 ? K + rb * 192 : V + rb * 128) + wc8) = o; }
                asm volatile("" ::: "memory"); }
    }
};
}

#define XB_TMO      128
#define XB_XCNT(j)  (256  + 64 * (j))
#define XB_XSUB(j)  (1280 + 64 * (j))
#define XB_XGEN(j)  (2304 + 64 * (j))
#define XB_TOP      3328
#define XB_TOPGEN   3392
#define XCD_BAR_WORDS 3456
#define XB_SPIN_CAP (1u << 18)
#define LAS __attribute__((address_space(3)))

__device__ __forceinline__ unsigned xb_ld(unsigned* p)              { return __hip_atomic_load(p, __ATOMIC_RELAXED, __HIP_MEMORY_SCOPE_AGENT); }
__device__ __forceinline__ unsigned xb_add(unsigned* p, unsigned v) { return __hip_atomic_fetch_add(p, v, __ATOMIC_RELAXED, __HIP_MEMORY_SCOPE_AGENT); }
__device__ __forceinline__ unsigned xb_xcc_id() { return (unsigned)__builtin_amdgcn_s_getreg((3 << 11) | 20) & 0xFu; }
#define XB_SPIN(cond, bar) do { unsigned _sp = 0; while (cond) { __builtin_amdgcn_s_sleep(1); \
    if ((++_sp & 255u) == 0u) { if (xb_ld(&(bar)[XB_TMO])) break; if (_sp > XB_SPIN_CAP) { atomicAdd(&(bar)[XB_TMO], 1u); break; } } } } while (0)

struct XcdBarrier {
    unsigned* bar; unsigned x;
    volatile LAS unsigned* st;
};

__device__ __forceinline__ XcdBarrier xcd_barrier_post(unsigned* bar, volatile LAS unsigned* st) {
    XcdBarrier b; b.bar = bar; b.x = xb_xcc_id(); b.st = st;
    if (threadIdx.x == 0) (void)xb_add(&bar[XB_XCNT(b.x)], 1u);
    return b;
}
__device__ __forceinline__ void xcd_barrier_complete(unsigned* bar, unsigned x, unsigned& nloc, unsigned& nx) {
    const unsigned G = gridDim.x * gridDim.y * gridDim.z;
    unsigned sum, cnt, mine, sp = 0u;
    for (;;) {
        sum = 0u; cnt = 0u; mine = 0u;
#pragma unroll
        for (unsigned j = 0; j < 16; ++j) { const unsigned c = xb_ld(&bar[XB_XCNT(j)]); sum += c; cnt += (c > 0u) ? 1u : 0u; mine = (j == x) ? c : mine; }
        if (sum == G) break;
        __builtin_amdgcn_s_sleep(1);
        if ((++sp & 255u) == 0u) { if (xb_ld(&bar[XB_TMO])) break; if (sp > XB_SPIN_CAP) { atomicAdd(&bar[XB_TMO], 1u); break; } }
    }
    nloc = mine > 0u ? mine : 1u; nx = cnt > 0u ? cnt : 1u;
}

__device__ __forceinline__ void xcd_barrier(const XcdBarrier& b) {
    asm volatile("s_waitcnt vmcnt(0)" ::: "memory");
    __syncthreads();
    if (threadIdx.x == 0) {
        unsigned* bar = b.bar;
        __builtin_amdgcn_s_waitcnt(0);
        unsigned nloc = b.st[0], nx = b.st[1];
        if (nloc == 0u) { xcd_barrier_complete(bar, b.x, nloc, nx); b.st[0] = nloc; b.st[1] = nx; }
        const unsigned old = xb_add(&bar[XB_XSUB(b.x)], 1u);
        const unsigned gen = old / nloc;
        if (old + 1u == (gen + 1u) * nloc) {
            __builtin_amdgcn_fence(__ATOMIC_RELEASE, "agent");
            asm volatile("s_waitcnt vmcnt(0)" ::: "memory");
            const unsigned og = xb_add(&bar[XB_TOP], 1u);
            const unsigned tg = og / nx;
            if (og + 1u == (tg + 1u) * nx) xb_add(&bar[XB_TOPGEN], 1u);
            else XB_SPIN(xb_ld(&bar[XB_TOPGEN]) == tg, bar);
            __builtin_amdgcn_fence(__ATOMIC_ACQUIRE, "agent");
            xb_add(&bar[XB_XGEN(b.x)], 1u);
            asm volatile("s_waitcnt vmcnt(0)" ::: "memory");
        } else {
            XB_SPIN(xb_ld(&bar[XB_XGEN(b.x)]) == gen, bar);
            __builtin_amdgcn_fence(__ATOMIC_ACQUIRE, "agent");
            asm volatile("s_waitcnt vmcnt(0)" ::: "memory");
        }
    }
    __syncthreads();
}

constexpr size_t MB = 1u << 20;
constexpr size_t OFF_WIN = 0;
constexpr size_t OFF_WQUP = 5 * MB;
constexpr size_t OFF_WKVUP = 5 * MB + 512 * 1024;
constexpr size_t OFF_WOUT = 6 * MB;
constexpr size_t OFF_WPQ = 8 * MB;
constexpr size_t OFF_SUBK = 12 * MB;
constexpr size_t OFF_VEC = 12 * MB + 512 * 1024;
constexpr size_t OFF_SU = OFF_VEC + 4 * (size_t)T * 4, OFF_SV = OFF_SU + (size_t)NEXP * 4, OFF_SH = OFF_SV + (size_t)NEXP * 4;
constexpr size_t OFF_GATE = 13 * MB;
constexpr size_t OFF_BAR = 15 * MB;
constexpr size_t OFF_R1 = 16 * MB;
constexpr size_t OFF_R2 = 96 * MB;
constexpr size_t OFF_R3 = 160 * MB;
constexpr size_t OFF_R4 = 192 * MB;
constexpr size_t OFF_R5 = 208 * MB;
constexpr size_t OFF_LAT = OFF_R5;
constexpr size_t OFF_CS = OFF_R5 + 16 * MB;
constexpr size_t WS_END = 256 * MB;

struct Params {
    const float* x; const int* pos; const float *ln1_w, *w_in, *q_a_norm_w, *w_q_up, *kv_a_norm_w, *w_kv_up, *conv_w, *a_log_f, *dt_bias_f, *a_log_b,
        *dt_bias_b, *gdn_norm_w, *w_out, *ln2_w, *peer_wq, *sub_keys, *peer_u, *peer_v, *final_w;
    float* out; unsigned char* ws;
};

struct Ctx {
    int tid, lane, wave, bid, nb, gw, ngw;
    float* lds;
};

#define LDS3 ((PG8_LAS unsigned char*)c.lds)
__device__ __forceinline__ void gemm_scale_bf16(const Ctx& c, const bf16_t* A, int lda, const bf16_t* Bt, int ldb, int N, int K, bf16_t* O, int ldc, const float* rs) {
    pg8::Gemm g{A, Bt, T, N, K, lda, ldb}; pg8::StaticOrder S; S.init(T, N, c.nb, c.bid);
    pg8::EpiScaleBf16 E{O, ldc, rs};
    pg8::gemm_phase<pg8::EpiScaleBf16, pg8::StaticOrder, true, true>(LDS3, g, S, E);
}
__device__ __forceinline__ void ph1_mfma(const Ctx& c, const Params& p) {
    gemm_scale_bf16(c, (const bf16_t*)(p.ws + OFF_R3), 1024, (const bf16_t*)(p.ws + OFF_WIN), 1024, 2048, 1024, (bf16_t*)(p.ws + OFF_R1), IN_WP, nullptr);
}
__device__ __forceinline__ void ph1z(const Ctx& c, const Params& p, int G) {
    pg8::Gemm g{(const bf16_t*)(p.ws + OFF_R3), (const bf16_t*)(p.ws + OFF_WIN) + (size_t)2048 * 1024, T, 512, 1024, 1024, 1024}; pg8::StaticOrder S; S.init(T, 512, G, c.bid);
    pg8::EpiSiluBf16 E{(bf16_t*)(p.ws + OFF_R2) + (size_t)3 * T * 512, 512};
    pg8::gemm_phase<pg8::EpiSiluBf16, pg8::StaticOrder, true, true>(LDS3, g, S, E);
}
__device__ __forceinline__ void ph2a2_v3(const Ctx& c, const Params& p) {
    const bf16_t* lat = (const bf16_t*)(p.ws + OFF_LAT); const float* rq = (const float*)(p.ws + OFF_VEC) + T; const float* rkv = rq + T;
    bf16_t* Q = (bf16_t*)p.out; bf16_t* Kk = Q + (size_t)T * MLA_H * QKD; bf16_t* V = Kk + (size_t)T * MLA_H * QKD;
    { pg8::Gemm g{lat, (const bf16_t*)(p.ws + OFF_WQUP), T, 768, 256, 512, 256}; pg8::StaticOrder S; S.init(T, 768, c.nb, c.bid);
      pg8::EpiMlaQ E{Q, rq, (const float*)(p.ws + OFF_CS)};
      pg8::gemm_phase<pg8::EpiMlaQ, pg8::StaticOrder, true, true>(LDS3, g, S, E); }
    { pg8::Gemm g{lat + 256, (const bf16_t*)(p.ws + OFF_WKVUP), T, 1024, 256, 512, 256}; pg8::StaticOrder S; S.init(T, 1024, c.nb, c.bid);
      pg8::EpiMlaKV E{Kk, V, rkv};
      pg8::gemm_phase<pg8::EpiMlaKV, pg8::StaticOrder, true, true>(LDS3, g, S, E); }
}
__device__ __forceinline__ void ph4b_v2(const Ctx& c, const Params& p) {
    pg8::Gemm g{(const bf16_t*)(p.ws + OFF_R1), (const bf16_t*)(p.ws + OFF_WOUT), T, 1024, 1024, 1024, 1024}; pg8::StaticOrder S; S.init(T, 1024, c.nb, c.bid);
    pg8::EpiResF32Hb E{p.x, p.out, (bf16_t*)(p.ws + OFF_R3), (float*)(p.ws + OFF_SH), 1024};
    pg8::gemm_phase<pg8::EpiResF32Hb, pg8::StaticOrder, true, true>(LDS3, g, S, E);
}
__device__ __forceinline__ void ph5_v2(const Ctx& c, const Params& p) {
    gemm_scale_bf16(c, (const bf16_t*)(p.ws + OFF_R3), 1024, (const bf16_t*)(p.ws + OFF_WPQ), 1024, 2048, 1024, (bf16_t*)(p.ws + OFF_R2), 2048, nullptr);
}

namespace attn {
constexpr int SDEPTH = 1;
constexpr int NW = 8, QBLK = 32, KVBLK = 64, LDQ = 192, LDK = 192, LDV = 128, LDO = 512;
constexpr float SCALE = 0.07216878364870322f;
constexpr float THR = 8.f;
constexpr size_t SHM_V = KVBLK * 128 * 2, SHM_K = KVBLK * 192 * 2, SHM_ATTN = 2 * SHM_V + 2 * SHM_K + NW * 64 * 4 + NW * 6144;
constexpr int QREG = 6;
using bf16 = unsigned short;
using bf16x8 = __attribute__((ext_vector_type(8))) short;
using s16x4  = __attribute__((ext_vector_type(4))) short;
using f32x16 = __attribute__((ext_vector_type(16))) float;
using f32x8  = __attribute__((ext_vector_type(8))) float;
using u32x4a = __attribute__((ext_vector_type(4))) unsigned;
#define KSWZ(row, colB) ((row) * 384 + ((colB) ^ ((((row) >> 1) & 7) << 4)))
#define SBAR() __builtin_amdgcn_sched_barrier(0)
__device__ __forceinline__ int crow(int r, int hi) { return (r & 3) + 8 * (r >> 2) + 4 * hi; }
__device__ __forceinline__ unsigned cvtpk(float lo, float hi) {
  unsigned r; asm volatile("v_cvt_pk_bf16_f32 %0, %1, %2" : "=v"(r) : "v"(lo), "v"(hi)); return r;
}
__device__ __forceinline__ void partialSM(f32x16& p0, f32x16& p1, float& m_reg, float& mn, float& alpha) {
  constexpr float C = SCALE * 1.4426950408889634f;
  float pmax = p0[0]; for (int r = 1; r < 16; ++r) pmax = fmaxf(pmax, p0[r]); for (int r = 0; r < 16; ++r) pmax = fmaxf(pmax, p1[r]);
  { auto rr = __builtin_amdgcn_permlane32_swap(__float_as_uint(pmax), __float_as_uint(pmax), false, false);
    pmax = fmaxf(__uint_as_float(rr[0]), __uint_as_float(rr[1])); }
  if (__builtin_expect(__all(pmax - m_reg <= THR / SCALE), 1)) { mn = m_reg; alpha = 1.f; }
  else { mn = fmaxf(m_reg, pmax); alpha = __builtin_amdgcn_exp2f((m_reg - mn) * C); m_reg = mn; }
  float mnC = -mn * C;
  for (int r = 0; r < 16; ++r) p0[r] = fmaf(p0[r], C, mnC); for (int r = 0; r < 16; ++r) p1[r] = fmaf(p1[r], C, mnC);
  for (int r = 0; r < 16; ++r) p0[r] = __builtin_amdgcn_exp2f(p0[r]);
}
__device__ __forceinline__ void finishSM(f32x16& p0, f32x16& p1, float alpha, float& l_reg, bf16x8& pa0, bf16x8& pa1, bf16x8& pa2, bf16x8& pa3) {
  for (int r = 0; r < 16; ++r) p1[r] = __builtin_amdgcn_exp2f(p1[r]);
  float ps = 0; for (int r = 0; r < 16; ++r) ps += p0[r]; for (int r = 0; r < 16; ++r) ps += p1[r];
  { auto rr = __builtin_amdgcn_permlane32_swap(__float_as_uint(ps), __float_as_uint(ps), false, false);
    ps = __uint_as_float(rr[0]) + __uint_as_float(rr[1]); }
  l_reg = l_reg * alpha + ps;
#define PK4(P, BASE, OUT) do { unsigned a0 = cvtpk(P[BASE + 0], P[BASE + 1]), a1 = cvtpk(P[BASE + 2], P[BASE + 3]);   \
    unsigned b0 = cvtpk(P[BASE + 4], P[BASE + 5]), b1 = cvtpk(P[BASE + 6], P[BASE + 7]);                              \
    auto r0 = __builtin_amdgcn_permlane32_swap(a0, b0, false, false); auto r1 = __builtin_amdgcn_permlane32_swap(a1, b1, false, false); \
    u32x4a w = {r0[0], r1[0], r0[1], r1[1]}; OUT = *reinterpret_cast<bf16x8*>(&w); } while (0)
  PK4(p0, 0, pa0); PK4(p0, 8, pa1); PK4(p1, 0, pa2); PK4(p1, 8, pa3);
#undef PK4
}
__device__ __forceinline__ void qkt(f32x16& p0, f32x16& p1, const bf16* Ks, const bf16x8* qr, const bf16x8* qro, int r32, int hi) {
  p0 = f32x16{}; p1 = f32x16{};
  for (int d0 = 0; d0 < 12; ++d0) { int cb = (d0 * 16 + hi * 8) * 2;
    bf16x8 b0 = *reinterpret_cast<const bf16x8*>((const char*)Ks + KSWZ(r32, cb));
    bf16x8 b1 = *reinterpret_cast<const bf16x8*>((const char*)Ks + KSWZ(32 + r32, cb));
    const bf16x8 qf = d0 < QREG ? qr[d0 < QREG ? d0 : 0] : qro[(d0 - QREG) * 64];
    p0 = __builtin_amdgcn_mfma_f32_32x32x16_bf16(b0, qf, p0, 0, 0, 0);
    p1 = __builtin_amdgcn_mfma_f32_32x32x16_bf16(b1, qf, p1, 0, 0, 0); }
}
__device__ __forceinline__ int v_st(int k, int c) { const int kk = (k & ~0xC) | ((k & 4) << 1) | ((k & 8) >> 1); return ((kk >> 3) * 4 + (c >> 5)) * 512 + ((kk & 7) * 32 + (c & 31)) * 2; }
__device__ __forceinline__ int v_rd_base(int lane) { return ((lane & 3) << 3) | (((lane >> 2) & 3) << 6) | (((lane >> 4) & 1) << 5) | (((lane >> 5) & 1) << 8); }
constexpr int v_rd_off(int d0, int ks, int half) { return d0 * 512 + ks * 4096 + half * 2048; }
template <int OFF> __device__ __forceinline__ s16x4 tr_read(int vb) {
  s16x4 r; asm volatile("ds_read_b64_tr_b16 %0, %1 offset:%2" : "=&v"(r) : "v"(vb), "i"(OFF) : "memory"); return r;
}
template <int D0> __device__ __forceinline__ void pv_one(f32x16& od, int vb, bf16x8 pa0, bf16x8 pa1, bf16x8 pa2, bf16x8 pa3) {
  const s16x4 l0 = tr_read<v_rd_off(D0, 0, 0)>(vb), h0 = tr_read<v_rd_off(D0, 0, 1)>(vb), l1 = tr_read<v_rd_off(D0, 1, 0)>(vb), h1 = tr_read<v_rd_off(D0, 1, 1)>(vb);
  const s16x4 l2 = tr_read<v_rd_off(D0, 2, 0)>(vb), h2 = tr_read<v_rd_off(D0, 2, 1)>(vb), l3 = tr_read<v_rd_off(D0, 3, 0)>(vb), h3 = tr_read<v_rd_off(D0, 3, 1)>(vb);
  asm volatile("s_waitcnt lgkmcnt(0)" ::: "memory"); SBAR();
#define PK(L, H) (bf16x8){L[0], L[1], L[2], L[3], H[0], H[1], H[2], H[3]}
  od = __builtin_amdgcn_mfma_f32_32x32x16_bf16(pa0, PK(l0, h0), od, 0, 0, 0);
  od = __builtin_amdgcn_mfma_f32_32x32x16_bf16(pa1, PK(l1, h1), od, 0, 0, 0);
  od = __builtin_amdgcn_mfma_f32_32x32x16_bf16(pa2, PK(l2, h2), od, 0, 0, 0);
  od = __builtin_amdgcn_mfma_f32_32x32x16_bf16(pa3, PK(l3, h3), od, 0, 0, 0);
#undef PK
}
__device__ __forceinline__ void pv_d0(f32x16* o, int vb, bf16x8 pa0, bf16x8 pa1, bf16x8 pa2, bf16x8 pa3) {
  pv_one<0>(o[0], vb, pa0, pa1, pa2, pa3); pv_one<1>(o[1], vb, pa0, pa1, pa2, pa3); pv_one<2>(o[2], vb, pa0, pa1, pa2, pa3); pv_one<3>(o[3], vb, pa0, pa1, pa2, pa3);
}


template <bool PARTIAL>
__device__ __forceinline__ void attn_dense_body(const bf16* __restrict__ Qb, const bf16* __restrict__ Kh, const bf16* __restrict__ Vh,
                                                bf16* __restrict__ Ob, int seq, char* lds, float* __restrict__ ML = nullptr) {
  const int tid = opaque_tid(), wid = __builtin_amdgcn_readfirstlane(tid >> 6), lane = tid & 63, r32 = lane & 31, hi = lane >> 5;
  bf16* V_lds = (bf16*)lds; bf16* K_lds = (bf16*)(lds + 2 * SHM_V);
  float* ws = (float*)(lds + 2 * SHM_V + 2 * SHM_K) + wid * 64; float* li_l = ws; float* al_l = ws + 32;
  float m_reg = -1e30f, l_reg = 0; f32x16 o[4] = {}; bf16x8 qr[QREG];
  const bf16* Qw = Qb + (long)(wid * QBLK + r32) * LDQ + hi * 8;
#pragma unroll
  for (int d0 = 0; d0 < QREG; ++d0) qr[d0] = *reinterpret_cast<const bf16x8*>(Qw + d0 * 16);
  bf16x8* qro = (bf16x8*)(lds + 2 * SHM_V + 2 * SHM_K + NW * 64 * 4) + wid * 384 + lane;
#pragma unroll
  for (int d0 = QREG; d0 < 12; ++d0) qro[(d0 - QREG) * 64] = *reinterpret_cast<const bf16x8*>(Qw + d0 * 16);
  const int sr = tid >> 4, sc = (tid & 15) * 8, vst0 = v_st(sr, sc), vst1 = v_st(32 + sr, sc);
  const int vb0 = (int)(uintptr_t)V_lds + v_rd_base(lane);
  const int kr0 = tid / 24, kc0 = (tid % 24) * 16, kr1 = (tid + 512) / 24, kc1 = ((tid + 512) % 24) * 16, kr2 = (tid + 1024) / 24, kc2 = ((tid + 1024) % 24) * 16;
  const int kst0 = KSWZ(kr0, kc0), kst1 = KSWZ(kr1, kc1), kst2 = KSWZ(kr2, kc2);
  struct { bf16x8 vs0, vs1, ks0, ks1, ks2; } sr_[SDEPTH];
#define SLOAD(i, k0) do { sr_[i].vs0 = *(const bf16x8*)(&Vh[(long)((k0) + sr) * LDV + sc]); sr_[i].vs1 = *(const bf16x8*)(&Vh[(long)((k0) + 32 + sr) * LDV + sc]); \
    const bf16* kt_ = Kh + (long)(k0) * LDK + tid * 8; sr_[i].ks0 = *(const bf16x8*)(kt_); sr_[i].ks1 = *(const bf16x8*)(kt_ + 4096); sr_[i].ks2 = *(const bf16x8*)(kt_ + 8192); } while (0)
#define SWRITE(b, i) do { *(bf16x8*)((char*)V_lds + (b) * SHM_V + vst0) = sr_[i].vs0;          \
    *(bf16x8*)((char*)V_lds + (b) * SHM_V + vst1) = sr_[i].vs1;                                 \
    *(bf16x8*)((char*)K_lds + (b) * SHM_K + kst0) = sr_[i].ks0;                                 \
    *(bf16x8*)((char*)K_lds + (b) * SHM_K + kst1) = sr_[i].ks1;                                 \
    *(bf16x8*)((char*)K_lds + (b) * SHM_K + kst2) = sr_[i].ks2; } while (0)
#define SWAIT() do { if constexpr (SDEPTH == 2) asm volatile("s_waitcnt vmcnt(5)" ::: "memory"); else asm volatile("s_waitcnt vmcnt(0)" ::: "memory"); } while (0)
#define RESC(a) do { if (__any((a) < 1.f)) { if (hi == 0) al_l[r32] = (a); asm volatile("s_waitcnt lgkmcnt(0)" ::: "memory"); \
    for (int d = 0; d < 4; ++d) for (int r = 0; r < 16; ++r) o[d][r] *= al_l[crow(r, hi)]; } } while (0)
  f32x16 pA0, pA1, pB0, pB1; float mnA, mnB, alA, alB; bf16x8 pa0, pa1, pa2, pa3; const int NT = seq / KVBLK;
  constexpr int SE = 0, SO = SDEPTH - 1;
  SLOAD(SE, 0); asm volatile("s_waitcnt vmcnt(0)" ::: "memory"); SWRITE(0, SE); __syncthreads();
  qkt(pA0, pA1, K_lds, qr, qro, r32, hi); partialSM(pA0, pA1, m_reg, mnA, alA);
  SLOAD(SO, KVBLK); if constexpr (SDEPTH == 2) { if (2 < NT) SLOAD(SE, 2 * KVBLK); }
  SWAIT(); SWRITE(1, SO); __syncthreads();
  for (int j = 1; j + 1 < NT; j += 2) {
    SBAR(); qkt(pB0, pB1, (bf16*)((char*)K_lds + SHM_K), qr, qro, r32, hi);
    finishSM(pA0, pA1, alA, l_reg, pa0, pa1, pa2, pa3); SBAR();
    SLOAD(SO, (j + SDEPTH) * KVBLK); SBAR();
    pv_d0(o, vb0, pa0, pa1, pa2, pa3); partialSM(pB0, pB1, m_reg, mnB, alB);
    __syncthreads(); SWAIT(); SWRITE(0, SE);
    RESC(alB); __syncthreads();
    SBAR(); qkt(pA0, pA1, K_lds, qr, qro, r32, hi);
    finishSM(pB0, pB1, alB, l_reg, pa0, pa1, pa2, pa3); SBAR();
    if (SDEPTH == 1 || j + 3 < NT) SLOAD(SE, (j + 1 + SDEPTH) * KVBLK); SBAR();
    pv_d0(o, vb0 + (int)SHM_V, pa0, pa1, pa2, pa3); partialSM(pA0, pA1, m_reg, mnA, alA);
    __syncthreads(); SWAIT(); SWRITE(1, SO);
    RESC(alA); __syncthreads();
  }
  SBAR(); qkt(pB0, pB1, (bf16*)((char*)K_lds + SHM_K), qr, qro, r32, hi);
  finishSM(pA0, pA1, alA, l_reg, pa0, pa1, pa2, pa3); SBAR();
  pv_d0(o, vb0, pa0, pa1, pa2, pa3); partialSM(pB0, pB1, m_reg, mnB, alB);
  __syncthreads(); RESC(alB);
  finishSM(pB0, pB1, alB, l_reg, pa0, pa1, pa2, pa3); SBAR();
  pv_d0(o, vb0 + (int)SHM_V, pa0, pa1, pa2, pa3);
  if constexpr (PARTIAL) {
    if (hi == 0) { ML[(wid * QBLK + r32) * 2] = m_reg; ML[(wid * QBLK + r32) * 2 + 1] = l_reg; }
    bf16* Ow = Ob + (long)(wid * QBLK) * 128;
#pragma unroll
    for (int r = 0; r < 16; ++r) { int orow = crow(r, hi);
      for (int d0 = 0; d0 < 4; ++d0) Ow[(long)orow * 128 + d0 * 32 + r32] = (bf16)(cvtpk(o[d0][r], 0.f) & 0xffffu); }
  } else {
  if (hi == 0) li_l[r32] = l_reg; asm volatile("s_waitcnt lgkmcnt(0)" ::: "memory");
  float rli[16];
#pragma unroll
  for (int r = 0; r < 16; ++r) rli[r] = __builtin_amdgcn_rcpf(li_l[crow(r, hi)]);
  bf16* Ow = Ob + (long)(wid * QBLK) * LDO;
#pragma unroll
  for (int r = 0; r < 16; ++r) { int orow = crow(r, hi);
    for (int d0 = 0; d0 < 4; ++d0) Ow[(long)orow * LDO + d0 * 32 + r32] = (bf16)(cvtpk(o[d0][r] * rli[r], 0.f) & 0xffffu); }
  }
  __syncthreads();
#undef SLOAD
#undef SWRITE
#undef SWAIT
#undef RESC
}

}

__device__ __forceinline__ void ph3a_mfma(const Ctx& c, const Params& p) {
    const bf16_t* Q = (const bf16_t*)p.out; const bf16_t* Kk = Q + (size_t)T * MLA_H * QKD; const bf16_t* V = Kk + (size_t)T * MLA_H * QKD;
    bf16_t* omla = (bf16_t*)(p.ws + OFF_R4);
    for (int unit = c.bid; unit < BATCH * MLA_H * (SEQ / 256); unit += c.nb) {
        const int bh = unit & 7, qb = unit >> 3, b = bh >> 2, h = bh & 3;
        const size_t base = (size_t)bh * SEQ;
        attn::attn_dense_body<false>(Q + (base + qb * 256) * QKD, Kk + base * QKD, V + base * VDIM, omla + (size_t)(b * SEQ + qb * 256) * 512 + h * 128, SEQ, (char*)c.lds);
    }
}
constexpr size_t OFF_PART = 240 * MB, OFF_PARTML = 255 * MB;
__device__ __forceinline__ void ph3a_split(const Ctx& c, const Params& p) {
    const bf16_t* Q = (const bf16_t*)p.out; const bf16_t* Kk = Q + (size_t)T * MLA_H * QKD; const bf16_t* V = Kk + (size_t)T * MLA_H * QKD;
    bf16_t* omla = (bf16_t*)(p.ws + OFF_R4);
    const int j = c.bid - 32, bh = j & 7, b = bh >> 2, h = bh & 3; const size_t base = (size_t)bh * SEQ;
    { const int qb = j >> 3;
      attn::attn_dense_body<false>(Q + (base + qb * 256) * QKD, Kk + base * QKD, V + base * VDIM, omla + (size_t)(b * SEQ + qb * 256) * 512 + h * 128, SEQ, (char*)c.lds); }
    { const int r = j >> 3, qb = 28 + r / 7, part = r % 7, k0 = part * 18 * 64, nk = (part == 6 ? 20 : 18) * 64, lu = (qb - 28) * 8 + bh;
      attn::attn_dense_body<true>(Q + (base + qb * 256) * QKD, Kk + (base + k0) * QKD, V + (base + k0) * VDIM, (bf16_t*)(p.ws + OFF_PART) + ((size_t)(lu * 7 + part) * 256) * 128, nk,
                                  (char*)c.lds, (float*)(p.ws + OFF_PARTML) + (size_t)(lu * 7 + part) * 512); }
}


namespace pk {
typedef float f32x16 __attribute__((ext_vector_type(16)));
typedef short bf16x8 __attribute__((ext_vector_type(8)));
__device__ __forceinline__ int f2ord(float f) { const int b = __float_as_int(f); return b ^ ((b >> 31) & 0x7fffffff); }
__device__ __forceinline__ float ord2f(int k) { return __int_as_float(k ^ ((k >> 31) & 0x7fffffff)); }
__device__ __forceinline__ void ce(int& a, int& b) { const int mx = max(a, b), mn = min(a, b); a = mx; b = mn; }
__device__ __forceinline__ void sort16(int (&v)[16]) {
    constexpr int NA[60] = {0, 1, 2, 3, 4, 5, 7, 9, 0, 1, 2, 3, 6, 8, 10, 11, 0, 2, 4, 6, 7, 10, 12, 14, 0, 1, 4, 5, 6, 8, 12, 13, 1, 3, 4, 5, 8, 9, 13, 1, 2, 5, 7, 9, 11, 2, 3, 9, 11, 3, 6, 7, 10, 3, 5, 7, 9, 11, 6, 8};
    constexpr int NB[60] = {13, 12, 15, 14, 8, 6, 11, 10, 5, 7, 9, 4, 13, 14, 15, 12, 1, 3, 5, 8, 9, 11, 13, 15, 2, 3, 10, 11, 7, 9, 14, 15, 2, 12, 6, 7, 10, 11, 14, 4, 6, 8, 10, 13, 14, 4, 6, 12, 13, 5, 8, 9, 12, 4, 6, 8, 10, 12, 7, 9};
#pragma unroll
    for (int i = 0; i < 60; ++i) ce(v[NA[i]], v[NB[i]]);
}
__device__ __forceinline__ void merge16(int (&v)[16]) {
#pragma unroll
    for (int j = 8; j > 0; j >>= 1)
#pragma unroll
        for (int i = 0; i < 16; ++i) { const int l = i ^ j; if (l > i) ce(v[i], v[l]); }
}
__device__ __forceinline__ void top_merge(int (&best)[16], int (&g)[16]) {
#pragma unroll
    for (int i = 0; i < 16; ++i) best[i] = max(best[i], g[15 - i]);
    merge16(best);
}
__device__ __forceinline__ int lookup16(unsigned long long lo, unsigned long long hi8, int i) {
    const unsigned long long s = (i & 8) ? hi8 : lo;
    return (int)((s >> ((i & 7) * 8)) & 0xffull);
}
}
__device__ __forceinline__ void ph6_fast(const Ctx& c, const Params& p) {
    using namespace pk;
    const int tid = opaque_tid(), wid = __builtin_amdgcn_readfirstlane(tid >> 6), lane = tid & 63, r32 = lane & 31, hi = lane >> 5;
    const bf16_t* qp = (const bf16_t*)(p.ws + OFF_R2); const bf16_t* subk = (const bf16_t*)(p.ws + OFF_SUBK);
    int* experts = (int*)(p.ws + OFF_R4); float* gates = (float*)(p.ws + OFF_R4 + 8 * MB);
    char* lds = (char*)c.lds;
    constexpr int NU = PH * (T / 256);
    const int per = (NU + c.nb - 1) / c.nb;
    int cur_h = -1;
    for (int ui = 0; ui < per; ++ui) {
        const int u = c.bid * per + ui; if (u >= NU) break;
        const int h = u / (T / 256), t0 = (u % (T / 256)) * 256;
        if (h != cur_h) {
            __syncthreads();
            for (int ch = tid; ch < 4096; ch += NT) { const int row = ch >> 4, cb = (ch & 15) * 16;
                const u32x4 v = *(const u32x4*)(subk + (size_t)h * 32768 + (size_t)row * 128 + (cb >> 1));
                *(u32x4*)(lds + row * 256 + (cb ^ ((row & 7) << 4))) = v; }
            __syncthreads(); cur_h = h;
        }
        const int t = t0 + wid * 32 + r32;
        int A[2][16];
#pragma unroll
        for (int pp = 0; pp < 2; ++pp) {
            bf16x8 bq[8];
#pragma unroll
            for (int ks = 0; ks < 8; ++ks) bq[ks] = *(const bf16x8*)(qp + (size_t)t * 2048 + h * 256 + pp * 128 + ks * 16 + hi * 8);
            f32x16 acc[4];
#pragma unroll
            for (int kt = 0; kt < 4; ++kt) acc[kt] = f32x16{};
#pragma unroll
            for (int ks = 0; ks < 8; ++ks)
#pragma unroll
                for (int kt = 0; kt < 4; ++kt) { const int row = pp * 128 + kt * 32 + r32, cb = (ks * 16 + hi * 8) * 2;
                    const bf16x8 a = *(const bf16x8*)(lds + row * 256 + (cb ^ ((row & 7) << 4)));
                    acc[kt] = __builtin_amdgcn_mfma_f32_32x32x16_bf16(a, bq[ks], acc[kt], 0, 0, 0); }
            int best[16], g[16];
#pragma unroll
            for (int kt = 0; kt < 4; ++kt) {
#pragma unroll
                for (int r = 0; r < 16; ++r) { const int idx = kt * 32 + (r & 3) + 8 * (r >> 2) + 4 * hi; const int k = (f2ord(acc[kt][r]) & ~127) | idx; if (kt == 0) best[r] = k; else g[r] = k; }
                if (kt == 0) sort16(best); else { sort16(g); top_merge(best, g); }
            }
#pragma unroll
            for (int i = 0; i < 16; ++i) { auto rr = __builtin_amdgcn_permlane32_swap((unsigned)best[i], (unsigned)best[i], false, false); g[i] = hi ? (int)rr[0] : (int)rr[1]; }
            top_merge(best, g);
#pragma unroll
            for (int i = 0; i < 16; ++i) A[pp][i] = best[i];
        }
        float fa[16], fb[16]; unsigned long long wa0 = 0, wa1 = 0, wb0 = 0, wb1 = 0;
#pragma unroll
        for (int i = 0; i < 16; ++i) { fa[i] = ord2f(A[0][i] & ~127); fb[i] = ord2f(A[1][i] & ~127);
            if (i < 8) { wa0 |= (unsigned long long)(A[0][i] & 127) << (i * 8); wb0 |= (unsigned long long)(A[1][i] & 127) << (i * 8); }
            else { wa1 |= (unsigned long long)(A[0][i] & 127) << ((i - 8) * 8); wb1 |= (unsigned long long)(A[1][i] & 127) << ((i - 8) * 8); } }
#define PK_KEY(i_, j_) ((f2ord(fa[i_] + fb[j_]) & ~255) | (255 - (((i_) << 4) | (j_))))
        int best[16], g[16];
#pragma unroll
        for (int r = 0; r < 16; ++r) best[r] = PK_KEY(0, r);
#pragma unroll
        for (int r = 0; r < 8; ++r) { g[r] = PK_KEY(1, r); g[8 + r] = PK_KEY(15 - r, 0); }
        merge16(g); top_merge(best, g);
        { constexpr int BI[16] = {2, 2, 2, 2, 2, 3, 3, 3, 3, 4, 4, 4, 5, 5, 6, 6}, BJ[16] = {0, 1, 2, 3, 4, 0, 1, 2, 3, 0, 1, 2, 0, 1, 0, 1};
#pragma unroll
          for (int r = 0; r < 16; ++r) g[r] = PK_KEY(BI[r], BJ[r]); }
        sort16(g); top_merge(best, g);
        best[15] = max(best[15], PK_KEY(7, 0)); best[14] = max(best[14], PK_KEY(7, 1)); merge16(best);
#undef PK_KEY
        float fs[16]; int fe[16]; float sum = 0.f; const float s0 = ord2f(best[0] & ~255);
        const float rs2 = rsqrtf(((const float*)(p.ws + OFF_SH))[t] * (1.f / 1024.f) + EPS);
#pragma unroll
        for (int k = 0; k < 16; ++k) { const int code = 255 - (best[k] & 255); fe[k] = lookup16(wa0, wa1, code >> 4) * NKEYS + lookup16(wb0, wb1, code & 15);
            fs[k] = __expf((ord2f(best[k] & ~255) - s0) * rs2); sum += fs[k]; }
        const float inv = 1.f / sum;
        if (hi == 0) { int* eo = experts + (size_t)t * 128 + h * 16;
#pragma unroll
            for (int k = 0; k < 16; k += 4) *(u32x4*)(eo + k) = u32x4{(unsigned)fe[k], (unsigned)fe[k + 1], (unsigned)fe[k + 2], (unsigned)fe[k + 3]}; }
        else { float* go = gates + (size_t)t * 128 + h * 16;
#pragma unroll
            for (int k = 0; k < 16; k += 4) *(f32x4*)(go + k) = f32x4{fs[k] * inv, fs[k + 1] * inv, fs[k + 2] * inv, fs[k + 3] * inv}; }
    }
    __syncthreads();
}


__device__ __forceinline__ float wave_max(float v) {
#pragma unroll
    for (int o = 1; o < 64; o <<= 1) v = fmaxf(v, __shfl_xor(v, o));
    return v;
}
__device__ __forceinline__ unsigned q4(float a, float b, float cc, float d, float inv, int off) {
    const int x = (int)rintf(a * inv) + off, y = (int)rintf(b * inv) + off, z = (int)rintf(cc * inv) + off, w = (int)rintf(d * inv) + off;
    return (unsigned)(x & 255) | ((unsigned)(y & 255) << 8) | ((unsigned)(z & 255) << 16) | ((unsigned)(w & 255) << 24);
}
__device__ __forceinline__ void quant_row(const float* row, const float* mul, int lane, unsigned char* dst, float* scale_out, int off) {
    f32x4 v[4]; float mx = 0.f;
#pragma unroll
    for (int j = 0; j < 4; ++j) { v[j] = *(const f32x4*)(row + 16 * lane + 4 * j); if (mul) v[j] = v[j] * *(const f32x4*)(mul + 16 * lane + 4 * j);
        mx = fmaxf(mx, fmaxf(fmaxf(fabsf(v[j].x), fabsf(v[j].y)), fmaxf(fabsf(v[j].z), fabsf(v[j].w)))); }
    mx = fmaxf(wave_max(mx), 1e-30f);
    const float inv = 127.f / mx;
    u32x4 o; o.x = q4(v[0].x, v[0].y, v[0].z, v[0].w, inv, off); o.y = q4(v[1].x, v[1].y, v[1].z, v[1].w, inv, off);
    o.z = q4(v[2].x, v[2].y, v[2].z, v[2].w, inv, off); o.w = q4(v[3].x, v[3].y, v[3].z, v[3].w, inv, off);
    *(u32x4*)(dst + 16 * lane) = o;
    if (lane == 0) *scale_out = mx * (1.f / 127.f);
}
__device__ __forceinline__ void ph4a_tables_q8(const Ctx& c, const Params& p, int gw, int ngw, int r_lo, int r_hi) {
    unsigned char* u8 = p.ws + OFF_R5; unsigned char* v8 = u8 + (size_t)NEXP * 1024;
    float* su = (float*)(p.ws + OFF_SU); float* sv = (float*)(p.ws + OFF_SV); const int lane = c.lane;
    f32x4 lw[4];
#pragma unroll
    for (int j = 0; j < 4; ++j) lw[j] = *(const f32x4*)(p.ln2_w + 16 * lane + 4 * j);
    for (int r0 = r_lo + gw; r0 < r_hi; r0 += 4 * ngw) {
        f32x4 v[4][4];
#pragma unroll
        for (int u = 0; u < 4; ++u) { const int r = r0 + u * ngw < r_hi ? r0 + u * ngw : r0; const float* row = (r < NEXP ? p.peer_u + (size_t)r * 1024 : p.peer_v + (size_t)(r - NEXP) * 1024) + 16 * lane;
#pragma unroll
            for (int j = 0; j < 4; ++j) v[u][j] = *(const f32x4*)(row + 4 * j); }
#pragma unroll
        for (int u = 0; u < 4; ++u) { const int r = r0 + u * ngw; if (r >= r_hi) break;
            if (r < NEXP) { float mx = 0.f;
#pragma unroll
                for (int j = 0; j < 4; ++j) { v[u][j] = v[u][j] * lw[j]; mx = fmaxf(mx, fmaxf(fmaxf(fabsf(v[u][j].x), fabsf(v[u][j].y)), fmaxf(fabsf(v[u][j].z), fabsf(v[u][j].w)))); }
                mx = fmaxf(wave_max(mx), 1e-30f); const float inv = 127.f / mx;
                u32x4 o; o.x = q4(v[u][0].x, v[u][0].y, v[u][0].z, v[u][0].w, inv, 0); o.y = q4(v[u][1].x, v[u][1].y, v[u][1].z, v[u][1].w, inv, 0);
                o.z = q4(v[u][2].x, v[u][2].y, v[u][2].z, v[u][2].w, inv, 0); o.w = q4(v[u][3].x, v[u][3].y, v[u][3].z, v[u][3].w, inv, 0);
                *(u32x4*)(u8 + (size_t)r * 1024 + 16 * lane) = o;
                if (lane == 0) su[r] = mx * (1.f / 127.f);
            } else { const int e = r - NEXP; float mx = 0.f;
#pragma unroll
                for (int j = 0; j < 4; ++j) mx = fmaxf(mx, fmaxf(fmaxf(fabsf(v[u][j].x), fabsf(v[u][j].y)), fmaxf(fabsf(v[u][j].z), fabsf(v[u][j].w))));
                mx = fmaxf(wave_max(mx), 1e-30f); const float inv = 127.f / mx;
                u32x4 o; o.x = q4(v[u][0].x, v[u][0].y, v[u][0].z, v[u][0].w, inv, 128); o.y = q4(v[u][1].x, v[u][1].y, v[u][1].z, v[u][1].w, inv, 128);
                o.z = q4(v[u][2].x, v[u][2].y, v[u][2].z, v[u][2].w, inv, 128); o.w = q4(v[u][3].x, v[u][3].y, v[u][3].z, v[u][3].w, inv, 128);
                *(u32x4*)(v8 + (size_t)e * 128 + (size_t)(lane >> 3) * ((size_t)NEXP * 128) + (lane & 7) * 16) = o;
                if (lane == 0) sv[e] = mx * (1.f / 127.f); }
        }
    }
}


constexpr int LDS_SLOT_OFF = 144 * 1024 - 64;
namespace gdn {
typedef short bf16x8 __attribute__((ext_vector_type(8)));
typedef short s16x4 __attribute__((ext_vector_type(4)));
typedef float f32x4v __attribute__((ext_vector_type(4)));
typedef float f32x2c __attribute__((ext_vector_type(2))); typedef __bf16 bf16x2c __attribute__((ext_vector_type(2)));
__device__ __forceinline__ unsigned cvtpk(float lo, float hi) { const f32x2c v = {lo, hi}; const bf16x2c r = __builtin_convertvector(v, bf16x2c); return *(const unsigned*)&r; }
__device__ __forceinline__ int wperm(int d) { const int x = d & 31; return (d & ~31) | (8 * ((x >> 2) & 3) + 4 * (x >> 4) + (x & 3)); }
}
__device__ __forceinline__ void unpack8(const u32x4 w, float (&f)[8]) {
    f[0] = bflo(w.x); f[1] = bfhi(w.x); f[2] = bflo(w.y); f[3] = bfhi(w.y); f[4] = bflo(w.z); f[5] = bfhi(w.z); f[6] = bflo(w.w); f[7] = bfhi(w.w); }
__device__ __forceinline__ u32x4 pack8(const float (&f)[8]) { u32x4 w; w.x = gdn::cvtpk(f[0], f[1]); w.y = gdn::cvtpk(f[2], f[3]); w.z = gdn::cvtpk(f[4], f[5]); w.w = gdn::cvtpk(f[6], f[7]); return w; }


template <int VAR>
__device__ __forceinline__ void ph2b_v4(const Ctx& c, const Params& p) {
    using namespace gdn;
    const int tid = opaque_tid(), wid = __builtin_amdgcn_readfirstlane(tid >> 6), lane = tid & 63, li = lane & 15, lq = lane >> 4;
    const bf16_t* gq = (const bf16_t*)(p.ws + OFF_R2); const bf16_t* gk = gq + (size_t)T * 512; const bf16_t* gv = gk + (size_t)T * 512;
    const float* Gg = (const float*)(p.ws + OFF_GATE); const float* Gb = Gg + 2 * T * GH; float* Gcs = (float*)(p.ws + OFF_GATE) + 4 * T * GH;
    bf16_t* U = (bf16_t*)(p.ws + OFF_R1); bf16_t* W = U + (size_t)2 * T * 512; bf16_t* AT = W + (size_t)2 * T * 512;
    char* lds = (char*)c.lds;
    char* kL = lds; char* qL = lds + 16384;
    float (*Gm)[68] = (float (*)[68])(lds + 32768); float (*QKm)[68] = Gm + 64;
    float (*Lm)[64][68] = (float (*)[64][68])(lds + 32768 + 2 * 64 * 68 * 4);
    float* gcsL = (float*)(lds + 32768 + 4 * 64 * 68 * 4); float* betaL = gcsL + 128; float* gL = betaL + 128;
    u32x4 pk[2], pq[2], prv[8]; float pg = 0.f, pb = 0.f;
#define PB_KQ(un_) do { const int tp_ = opaque_tid(); const int nt_ = (un_) % NCH, h_ = ((un_) / NCH) % GH, b_ = (un_) / (NCH * GH); const size_t r0_ = (size_t)(b_ * GH + h_) * SEQ + nt_ * CHUNK; \
        _Pragma("unroll") for (int i_ = 0; i_ < 2; ++i_) { const int ch_ = tp_ + i_ * NT, row_ = ch_ >> 4, a_ = ch_ & 15; pk[i_] = *(const u32x4*)(gk + (r0_ + row_) * 128 + a_ * 8); pq[i_] = *(const u32x4*)(gq + (r0_ + row_) * 128 + a_ * 8); } \
        if (tp_ < 128) { const int d_ = tp_ >> 6, ii_ = tp_ & 63; pg = Gg[(size_t)d_ * T * GH + r0_ + ii_]; pb = Gb[(size_t)d_ * T * GH + r0_ + ii_]; } } while (0)
#define PB_RV(un_) do { const int tp_ = opaque_tid(); const int nt_ = (un_) % NCH, h_ = ((un_) / NCH) % GH, b_ = (un_) / (NCH * GH); const size_t r0_ = (size_t)(b_ * GH + h_) * SEQ + nt_ * CHUNK; \
        _Pragma("unroll") for (int m_ = 0; m_ < 8; ++m_) { const int ch_ = tp_ + m_ * NT, d_ = ch_ >> 11, j_ = (ch_ >> 5) & 63, cc_ = ch_ & 31, tj_ = d_ ? 63 - j_ : j_, col0_ = cc_ * 8; \
            prv[m_] = *(const u32x4*)(col0_ < 128 ? gv + (r0_ + tj_) * 128 + col0_ : gk + (r0_ + tj_) * 128 + (col0_ - 128)); } } while (0)
    constexpr int NU_ = BATCH * GH * NCH;
    unsigned* qctr = (unsigned*)(p.ws + OFF_BAR) + 64; volatile int* qslot = (volatile int*)(lds + LDS_SLOT_OFF);
    if (c.bid < NU_) { PB_KQ(c.bid); PB_RV(c.bid); }
    for (int unit = c.bid, unx = c.bid + c.nb; unit < NU_; ) {
        const int nt = unit % NCH, h = (unit / NCH) % GH, b = unit / (NCH * GH);
        const int p0 = nt * CHUNK; const size_t bh = (size_t)(b * GH + h) * SEQ;
        const int unext = unx < NU_ ? unx : unit;
        unsigned ticket = 0; if (tid == 0) ticket = xb_add(qctr, 1u);
        __syncthreads();
#pragma unroll
        for (int i = 0; i < 2; ++i) { const int ch = tid + i * NT, row = ch >> 4, a = ch & 15; const int off = row * 256 + ((a * 16) ^ ((row & 15) << 4));
            *(u32x4*)(kL + off) = pk[i]; *(u32x4*)(qL + off) = pq[i]; }
        if (tid < 128) { gL[tid] = pg; betaL[tid] = pb; }
        PB_KQ(unext);
        __syncthreads();
        if (wid < 2) { float v = gL[wid * 64 + (wid ? 63 - lane : lane)];
#pragma unroll
            for (int o = 1; o < 64; o <<= 1) { const float t_ = __shfl_up(v, o); if (lane >= o) v += t_; }
            gcsL[wid * 64 + lane] = v; }
        { const int mt = wid & 3; const char* Asrc = wid < 4 ? kL : qL; f32x4v acc[4];
#pragma unroll
          for (int n = 0; n < 4; ++n) acc[n] = f32x4v{0.f, 0.f, 0.f, 0.f};
#pragma unroll
          for (int s = 0; s < 4; ++s) { const int cb = 64 * s + 16 * lq;
              const bf16x8 af = *(const bf16x8*)(Asrc + (16 * mt + li) * 256 + (cb ^ (li << 4)));
#pragma unroll
              for (int n = 0; n < 4; ++n) { const bf16x8 bfr = *(const bf16x8*)(kL + (16 * n + li) * 256 + (cb ^ (li << 4)));
                  acc[n] = __builtin_amdgcn_mfma_f32_16x16x32_bf16(af, bfr, acc[n], 0, 0, 0); } }
          float (*dst)[68] = wid < 4 ? Gm : QKm;
#pragma unroll
          for (int n = 0; n < 4; ++n)
#pragma unroll
              for (int r = 0; r < 4; ++r) dst[16 * mt + 4 * lq + r][16 * n + li] = acc[n][r];
        }
        __syncthreads();
        if (tid < 128) { const int d = tid >> 6, i = tid & 63; const int nv = d ? NCH - 1 - nt : nt; Gcs[(size_t)d * T * GH + bh + nv * CHUNK + i] = gcsL[tid]; }
        const int tid2 = opaque_tid();
#pragma unroll 2
        for (int idx = tid2; idx < (VAR == 2 ? 0 : 2 * 4096); idx += NT) { const int d = idx >> 12, i = (idx >> 6) & 63, j = idx & 63; const int ti = d ? 63 - i : i, tj = d ? 63 - j : j;
            const float dec = __expf(gcsL[d * 64 + i] - gcsL[d * 64 + j]);
            Lm[d][j][i] = i > j ? betaL[d * 64 + ti] * Gm[ti][tj] * dec : 0.f;
            const int nv = d ? NCH - 1 - nt : nt;
            AT[((size_t)(d * BATCH * GH + b * GH + h) * NCH + nv) * 4096 + i * 64 + wperm(j)] = f2bf(i >= j ? QKm[ti][tj] * dec : 0.f); }
        __syncthreads();
        if (VAR == 1) continue;
        char* RL = lds;
        char* Dv = lds + 32768 + 4 * 64 * 68 * 4 + 1536;
        char* Lb = Dv + 4096;
#pragma unroll
        for (int m = 0; m < 8; ++m) { const int ch = tid + m * NT; const int d = ch >> 11, j = (ch >> 5) & 63, cc = ch & 31, tj = d ? 63 - j : j, col0 = cc * 8;
            float f[8]; unpack8(prv[m], f);
            const float sc = betaL[d * 64 + tj] * (col0 < 128 ? 1.f : __expf(gcsL[d * 64 + j]));
#pragma unroll
            for (int e = 0; e < 8; ++e) f[e] *= sc;
            *(u32x4*)(RL + d * 33792 + (j >> 2) * 2112 + (cc >> 1) * 128 + (j & 3) * 32 + (cc & 1) * 16) = pack8(f); }
        PB_RV(unext);
        if (tid < 128) {
            const int d = tid >> 6, bb = (tid >> 4) & 3, cc = tid & 15; float x[16];
#pragma unroll
            for (int i = 0; i < 16; ++i) x[i] = (i == cc) ? 1.f : 0.f;
#pragma unroll
            for (int j = 0; j < 15; ++j) { const float xj = x[j];
#pragma unroll
                for (int i = j + 1; i < 16; ++i) x[i] -= Lm[d][16 * bb + j][16 * bb + i] * xj; }
#pragma unroll
            for (int i = 0; i < 16; ++i) *(bf16_t*)(Dv + ((d * 4 + bb) * 16 + i) * 32 + cc * 2) = f2bf(x[i]);
        } else {
            for (int e = tid - 128; e < 2 * 6 * 256; e += NT - 128) { const int d = e / 1536, r = e % 1536, pi = r >> 8, i = (r >> 4) & 15, k = r & 15;
                const int bb = pi == 0 ? 1 : (pi < 3 ? 2 : 3), aa = pi - bb * (bb - 1) / 2;
                *(bf16_t*)(Lb + ((d * 6 + pi) * 16 + i) * 32 + k * 2) = f2bf(-Lm[d][16 * aa + k][16 * bb + i]); }
        }
        __syncthreads();
        { typedef short s16x4v __attribute__((ext_vector_type(4)));
          const int d = wid >> 2, nv = d ? NCH - 1 - nt : nt; const size_t rowbase = ((size_t)d * T * GH + bh + nv * CHUNK) * 128;
          const char* RLd = RL + d * 33792; const char* Dvd = Dv + d * 2048; const char* Lbd = Lb + d * 3072;
#pragma unroll
          for (int tp = 0; tp < 2; ++tp) {
              f32x4v acc[2][4]; s16x4v xb[2][4];
#pragma unroll
              for (int u = 0; u < 2; ++u) { const int ntile = 4 * (wid & 3) + 2 * tp + u;
#pragma unroll
                  for (int bb = 0; bb < 4; ++bb)
#pragma unroll
                      for (int r = 0; r < 4; ++r) acc[u][bb][r] = bf2f(*(const bf16_t*)(RLd + (4 * bb + lq) * 2112 + ntile * 128 + r * 32 + li * 2)); }
#pragma unroll
              for (int bb = 0; bb < 4; ++bb) {
#pragma unroll
                  for (int aa = 0; aa < bb; ++aa) { const s16x4v lf = *(const s16x4v*)(Lbd + ((bb * (bb - 1) / 2 + aa) * 16 + li) * 32 + lq * 8);
#pragma unroll
                      for (int u = 0; u < 2; ++u) acc[u][bb] = __builtin_amdgcn_mfma_f32_16x16x16bf16_1k(lf, xb[u][aa], acc[u][bb], 0, 0, 0); }
                  const s16x4v df = *(const s16x4v*)(Dvd + (bb * 16 + li) * 32 + lq * 8);
#pragma unroll
                  for (int u = 0; u < 2; ++u) { u32x2 w; w.x = cvtpk(acc[u][bb][0], acc[u][bb][1]); w.y = cvtpk(acc[u][bb][2], acc[u][bb][3]);
                      const s16x4v rb = *(s16x4v*)&w; acc[u][bb] = __builtin_amdgcn_mfma_f32_16x16x16bf16_1k(df, rb, f32x4v{0.f, 0.f, 0.f, 0.f}, 0, 0, 0);
                      u32x2 w2; w2.x = cvtpk(acc[u][bb][0], acc[u][bb][1]); w2.y = cvtpk(acc[u][bb][2], acc[u][bb][3]); xb[u][bb] = *(s16x4v*)&w2; }
              }
#pragma unroll
              for (int u = 0; u < 2; ++u) { const int col = 16 * (4 * (wid & 3) + 2 * tp + u) + li; bf16_t* dst = (col < 128 ? U + rowbase + col : W + rowbase + wperm(col - 128));
#pragma unroll
                  for (int bb = 0; bb < 4; ++bb)
#pragma unroll
                      for (int r = 0; r < 4; ++r) dst[(size_t)(16 * bb + 4 * lq + r) * 128] = (bf16_t)((unsigned short)xb[u][bb][r]); }
          }
        }
        if (tid == 0) *qslot = 2 * c.nb + (int)ticket;
        __syncthreads();
        unit = unx; unx = *qslot;
    }
    __syncthreads();
#undef PB_KQ
#undef PB_RV
}

template <int VAR>
__device__ __forceinline__ void ph3b_mfma(const Ctx& c, const Params& p) {
    using namespace gdn;
    constexpr int W_OFF = 0, QD_OFF = 16384, KD_OFF = 32768, AT_OFF = 51200, U_OFF = 59392, MISC_OFF = 68608, BUF = 69632;
    const int tid = opaque_tid(), wid = __builtin_amdgcn_readfirstlane(tid >> 6), lane = tid & 63, li = lane & 15, lq = lane >> 4;
    const bf16_t* gq = (const bf16_t*)(p.ws + OFF_R2); const bf16_t* gk = gq + (size_t)T * 512;
    const float* Gcs = (const float*)(p.ws + OFF_GATE) + 4 * T * GH;
    const bf16_t* Ug = (const bf16_t*)(p.ws + OFF_R1); const bf16_t* Wg = Ug + (size_t)2 * T * 512; const bf16_t* ATg = Wg + (size_t)2 * T * 512;
    bf16_t* Od = (bf16_t*)(p.ws + OFF_R3);
    char* lds = (char*)c.lds;
    for (int unit = c.bid; unit < 2 * BATCH * GH * 2; unit += c.nb) {
        const int chain = (unit & 7) | ((unit >> 4) << 3), vh = (unit >> 3) & 1, h = chain & 3, b = (chain >> 2) & 1, dir = chain >> 3;
        const size_t bh = (size_t)(b * GH + h) * SEQ; const size_t dbh = (size_t)dir * T * GH + bh; const int c0 = vh * 64;
        __syncthreads();
        if (wid >= 4) {
            const int lt = tid - 256;
            struct LSet { u32x4 rw[4], rq[4], rk[4], ra[2], ru[2]; float gc[4], gl; };
            LSet sA, sB;
            const int r0 = lt >> 4, a0 = lt & 15;
            const unsigned offW = (unsigned)(r0 * 256 + a0 * 16);
            const unsigned offQ = (unsigned)((dir ? 63 - r0 : r0) * 256 + a0 * 16);
            const int r1 = lt >> 3, a1 = lt & 7;
            const unsigned offA = (unsigned)(r1 * 128 + a1 * 16), offU = (unsigned)(r1 * 256 + a1 * 16), offG = (unsigned)(r0 * 4);
            const int qstep = dir ? -4096 : 4096;
            const unsigned swW = (unsigned)((r0 & 15) << 4);
            const unsigned ldsW = (unsigned)(r0 * 256) + (((unsigned)a0 * 16u) ^ swW);
            const int s_ = a0 >> 2, a2 = a0 & 3; const int pos0 = ((2 * a2) & 3) * 2 + (a2 >> 1), pos1 = ((2 * a2 + 1) & 3) * 2 + (a2 >> 1);
            const unsigned ldsQ0 = (unsigned)(r0 * 256) + (((unsigned)(64 * s_ + 8 * pos0)) ^ swW), ldsQ1 = (unsigned)(r0 * 256) + (((unsigned)(64 * s_ + 8 * pos1)) ^ swW);
            const unsigned ldsK = (unsigned)((r0 >> 2) * 1152 + (a0 >> 1) * 128 + (r0 & 3) * 32 + (a0 & 1) * 16);
            const unsigned ldsA = (unsigned)(r1 * 128) + (((unsigned)a1 * 16u) ^ (unsigned)(((r1 >> 1) & 7) << 4)), ldsU = (unsigned)(r1 * 144 + a1 * 16);
            const char* Wb = (const char*)(Wg + dbh * 128); const char* Ub = (const char*)(Ug + dbh * 128 + c0);
            const char* Qb = (const char*)(gq + (bh + (dir ? SEQ - 64 : 0)) * 128); const char* Kb = (const char*)(gk + (bh + (dir ? SEQ - 64 : 0)) * 128);
            const char* Ab = (const char*)(ATg + (size_t)(dir * BATCH * GH + b * GH + h) * NCH * 4096); const char* Gb_ = (const char*)(Gcs + dbh);
#define GDN_LOAD(S_, nreal_) do { const int n_ = VAR == 1 ? 0 : (nreal_); const long cw_ = (long)(n_) * 16384, cq_ = dir ? -(long)(n_) * 16384 : (long)(n_) * 16384; \
    _Pragma("unroll") for (int i = 0; i < 4; ++i) { \
        S_.rw[i] = *(const u32x4*)(Wb + cw_ + i * 4096 + offW); S_.rq[i] = *(const u32x4*)(Qb + cq_ + i * qstep + offQ); S_.rk[i] = *(const u32x4*)(Kb + cq_ + i * qstep + offQ); \
        S_.gc[i] = *(const float*)(Gb_ + (long)(n_) * 256 + i * 64 + offG); } \
    _Pragma("unroll") for (int i = 0; i < 2; ++i) { \
        S_.ra[i] = *(const u32x4*)(Ab + (long)(n_) * 8192 + i * 4096 + offA); S_.ru[i] = *(const u32x4*)(Ub + cw_ + i * 8192 + offU); } \
    S_.gl = *(const float*)(Gb_ + (long)(n_) * 256 + 252); } while (0)
#define GDN_SCALE2(w_, f_) cvtpk(bflo(w_) * (f_), bfhi(w_) * (f_))
#define GDN_WRITE(S_, buf_) do { char* B_ = lds + (buf_) * BUF; \
    _Pragma("unroll") for (int i = 0; i < 4; ++i) { \
        *(u32x4*)(B_ + W_OFF + i * 4096 + ldsW) = S_.rw[i]; \
        const float fq_ = __expf(S_.gc[i]), fk_ = __expf(S_.gl - S_.gc[i]); \
        u32x2 q0, q1; q0.x = GDN_SCALE2(S_.rq[i].x, fq_); q0.y = GDN_SCALE2(S_.rq[i].y, fq_); q1.x = GDN_SCALE2(S_.rq[i].z, fq_); q1.y = GDN_SCALE2(S_.rq[i].w, fq_); \
        *(u32x2*)(B_ + QD_OFF + i * 4096 + ldsQ0) = q0; *(u32x2*)(B_ + QD_OFF + i * 4096 + ldsQ1) = q1; \
        u32x4 k_; k_.x = GDN_SCALE2(S_.rk[i].x, fk_); k_.y = GDN_SCALE2(S_.rk[i].y, fk_); k_.z = GDN_SCALE2(S_.rk[i].z, fk_); k_.w = GDN_SCALE2(S_.rk[i].w, fk_); \
        *(u32x4*)(B_ + KD_OFF + i * 4608 + ldsK) = k_; } \
    _Pragma("unroll") for (int i = 0; i < 2; ++i) { \
        *(u32x4*)(B_ + AT_OFF + i * 4096 + ldsA) = S_.ra[i]; *(u32x4*)(B_ + U_OFF + i * 4608 + ldsU) = S_.ru[i]; } \
    if (lt == 0) *(float*)(B_ + MISC_OFF) = __expf(S_.gl); } while (0)
            GDN_LOAD(sA, 0); GDN_WRITE(sA, 0); GDN_LOAD(sB, 1); GDN_LOAD(sA, 2);
            for (int n = 0; n < NCH; n += 2) {
                __syncthreads();
                GDN_WRITE(sB, 1);
                { const int nn = n + 3 < NCH ? n + 3 : NCH - 1; GDN_LOAD(sB, nn); }
                __syncthreads();
                GDN_WRITE(sA, 0);
                { const int nn = n + 4 < NCH ? n + 4 : NCH - 1; GDN_LOAD(sA, nn); }
            }
#undef GDN_LOAD
#undef GDN_WRITE
#undef GDN_SCALE2
        } else {
            f32x4v S[8];
#pragma unroll
            for (int m = 0; m < 8; ++m) S[m] = f32x4v{0.f, 0.f, 0.f, 0.f};
            const int cw = 16 * wid;
            for (int n = 0; n < NCH; ++n) {
                __syncthreads();
                if (VAR == 2) continue;
                const char* B = lds + (n & 1) * BUF; const int p0 = n * CHUNK;
                const float egl = *(const float*)(B + MISC_OFF);
                bf16x8 Sb[4];
#pragma unroll
                for (int s = 0; s < 4; ++s) { u32x4 w; w.x = cvtpk(S[2 * s][0], S[2 * s][1]); w.y = cvtpk(S[2 * s][2], S[2 * s][3]); w.z = cvtpk(S[2 * s + 1][0], S[2 * s + 1][1]); w.w = cvtpk(S[2 * s + 1][2], S[2 * s + 1][3]); Sb[s] = *(bf16x8*)&w; }
                f32x4v av[4], ao[4];
#pragma unroll
                for (int m = 0; m < 4; ++m) { av[m] = f32x4v{0.f, 0.f, 0.f, 0.f}; ao[m] = f32x4v{0.f, 0.f, 0.f, 0.f}; }
#pragma unroll
                for (int s = 0; s < 4; ++s)
#pragma unroll
                    for (int m = 0; m < 4; ++m) { const int off = (16 * m + li) * 256 + ((64 * s + 16 * lq) ^ (li << 4));
                        av[m] = __builtin_amdgcn_mfma_f32_16x16x32_bf16(*(const bf16x8*)(B + W_OFF + off), Sb[s], av[m], 0, 0, 0);
                        ao[m] = __builtin_amdgcn_mfma_f32_16x16x32_bf16(*(const bf16x8*)(B + QD_OFF + off), Sb[s], ao[m], 0, 0, 0); }
#pragma unroll
                for (int m = 0; m < 4; ++m)
#pragma unroll
                    for (int r = 0; r < 4; ++r) av[m][r] = bf2f(*(const bf16_t*)(B + U_OFF + (16 * m + 4 * lq + r) * 144 + (cw + li) * 2)) - av[m][r];
                bf16x8 Vb[2];
#pragma unroll
                for (int s = 0; s < 2; ++s) { u32x4 w; w.x = cvtpk(av[2 * s][0], av[2 * s][1]); w.y = cvtpk(av[2 * s][2], av[2 * s][3]); w.z = cvtpk(av[2 * s + 1][0], av[2 * s + 1][1]); w.w = cvtpk(av[2 * s + 1][2], av[2 * s + 1][3]); Vb[s] = *(bf16x8*)&w; }
#pragma unroll
                for (int s = 0; s < 2; ++s)
#pragma unroll
                    for (int m = 0; m < 4; ++m) { const int row = 16 * m + li;
                        ao[m] = __builtin_amdgcn_mfma_f32_16x16x32_bf16(*(const bf16x8*)(B + AT_OFF + row * 128 + ((64 * s + 16 * lq) ^ (((row >> 1) & 7) << 4))), Vb[s], ao[m], 0, 0, 0); }
#pragma unroll
                for (int m = 0; m < 8; ++m) S[m] = S[m] * egl;
                { s16x4 tr[8][4]; const int base = (int)(uintptr_t)(B + KD_OFF) + lq * 1152 + 8 * li;
#define GDN_TR(m_) do { asm volatile("ds_read_b64_tr_b16 %0, %1 offset:%2" : "=&v"(tr[m_][0]) : "v"(base), "i"((m_) * 128) : "memory"); \
    asm volatile("ds_read_b64_tr_b16 %0, %1 offset:%2" : "=&v"(tr[m_][1]) : "v"(base), "i"((m_) * 128 + 4608) : "memory"); \
    asm volatile("ds_read_b64_tr_b16 %0, %1 offset:%2" : "=&v"(tr[m_][2]) : "v"(base), "i"((m_) * 128 + 9216) : "memory"); \
    asm volatile("ds_read_b64_tr_b16 %0, %1 offset:%2" : "=&v"(tr[m_][3]) : "v"(base), "i"((m_) * 128 + 13824) : "memory"); } while (0)
#define GDN_SUP(m_) do { const bf16x8 k0 = bf16x8{tr[m_][0][0], tr[m_][0][1], tr[m_][0][2], tr[m_][0][3], tr[m_][1][0], tr[m_][1][1], tr[m_][1][2], tr[m_][1][3]}, \
        k1 = bf16x8{tr[m_][2][0], tr[m_][2][1], tr[m_][2][2], tr[m_][2][3], tr[m_][3][0], tr[m_][3][1], tr[m_][3][2], tr[m_][3][3]}; \
    S[m_] = __builtin_amdgcn_mfma_f32_16x16x32_bf16(k0, Vb[0], S[m_], 0, 0, 0); S[m_] = __builtin_amdgcn_mfma_f32_16x16x32_bf16(k1, Vb[1], S[m_], 0, 0, 0); } while (0)
                  GDN_TR(0); GDN_TR(1); GDN_TR(2); GDN_TR(3);
                  asm volatile("s_waitcnt lgkmcnt(0)" ::: "memory"); __builtin_amdgcn_sched_barrier(0);
                  GDN_TR(4); GDN_TR(5); GDN_TR(6); GDN_TR(7);
                  GDN_SUP(0); GDN_SUP(1); GDN_SUP(2); GDN_SUP(3);
                  asm volatile("s_waitcnt lgkmcnt(0)" ::: "memory"); __builtin_amdgcn_sched_barrier(0);
                  GDN_SUP(4); GDN_SUP(5); GDN_SUP(6); GDN_SUP(7);
#undef GDN_TR
#undef GDN_SUP
                }
#pragma unroll
                for (int m = 0; m < 4; ++m)
#pragma unroll
                    for (int r = 0; r < 4; ++r) { const int pv = p0 + 16 * m + 4 * lq + r; const int tk = dir ? SEQ - 1 - pv : pv;
                        Od[((size_t)dir * T + b * SEQ + tk) * 512 + h * 128 + c0 + cw + li] = f2bf(ao[m][r]); }
            }
        }
    }
    __syncthreads();
}


constexpr size_t OFF_SUMSQ = OFF_SH;
template <bool QROPE = false, bool WINMAP = false>
__device__ __forceinline__ void cvt_tile(const float* src, int K, int N, const float* scale, bf16_t* dst, int Kpad, int tk, int tn, float* tile, int tid) {
    const int k0 = tk * 64, n0 = tn * 64;
#pragma unroll
    for (int i = 0; i < 2; ++i) { const int r = (tid >> 4) + 32 * i, k = k0 + r, n = n0 + (tid & 15) * 4; f32x4 v = {0.f, 0.f, 0.f, 0.f};
        if (k < K) { const float sc = scale ? scale[k] : 1.f;
            if (n + 3 < N) v = *(const f32x4*)(src + (size_t)k * N + n) * sc;
            else { for (int e = 0; e < 4; ++e) if (n + e < N) v[e] = src[(size_t)k * N + n + e] * sc; } }
#pragma unroll
        for (int e = 0; e < 4; ++e) tile[r * 65 + (tid & 15) * 4 + e] = v[e]; }
    __syncthreads();
    { const int nl = tid >> 3, kc = (tid & 7) * 8; float f[8];
#pragma unroll
      for (int j = 0; j < 8; ++j) f[j] = tile[(kc + j) * 65 + nl];
      int nd = n0 + nl;
      if (WINMAP) nd = nd < 1984 ? nd : (nd < 2496 ? nd + 64 : nd - 512);
      if (QROPE) { const int hh = nd / 192, w = nd % 192; if (w >= 128) { const int i = w - 128; nd = hh * 192 + 128 + (i < 32 ? 2 * i : 2 * (i - 32) + 1); } }
      *(u32x4*)(dst + (size_t)nd * Kpad + k0 + kc) = pack8(f); }
    __syncthreads();
}
__device__ __forceinline__ void ph0_v2(const Ctx& c, const Params& p) {
    unsigned char* ws = p.ws;
    constexpr int T0 = 16 * 40, T1 = T0 + 4 * 12, T2 = T1 + 4 * 16, T3 = T2 + 16 * 16, T4 = T3 + 16 * 32;
    for (int tile = c.bid; tile < T4; tile += c.nb) {
        if (tile < T0) cvt_tile<false, true>(p.w_in, 1024, IN_W, p.ln1_w, (bf16_t*)(ws + OFF_WIN), 1024, tile % 16, tile / 16, c.lds, c.tid);
        else if (tile < T1) { const int r = tile - T0; cvt_tile<true>(p.w_q_up, QRANK, 768, p.q_a_norm_w, (bf16_t*)(ws + OFF_WQUP), 256, r % 4, r / 4, c.lds, c.tid); }
        else if (tile < T2) { const int r = tile - T1; cvt_tile(p.w_kv_up, KVRANK, 1024, p.kv_a_norm_w, (bf16_t*)(ws + OFF_WKVUP), 256, r % 4, r / 4, c.lds, c.tid); }
        else if (tile < T3) { const int r = tile - T2; cvt_tile(p.w_out, 1024, 1024, nullptr, (bf16_t*)(ws + OFF_WOUT), 1024, r % 16, r / 16, c.lds, c.tid); }
        else { const int r = tile - T3; cvt_tile(p.peer_wq, 1024, 2048, p.ln2_w, (bf16_t*)(ws + OFF_WPQ), 1024, r % 16, r / 16, c.lds, c.tid); }
    }
    { bf16_t* d = (bf16_t*)(ws + OFF_SUBK); const int total4 = PH * 2 * NKEYS * 128 / 4;
      for (int i = c.bid * NT + c.tid; i < total4; i += c.nb * NT) { const f32x4 v = ((const f32x4*)p.sub_keys)[i]; u32x2 o; o.x = gdn::cvtpk(v.x, v.y); o.y = gdn::cvtpk(v.z, v.w); ((u32x2*)d)[i] = o; } }
    { float* sq = (float*)(ws + OFF_SUMSQ); for (int i = c.bid * NT + c.tid; i < T; i += c.nb * NT) sq[i] = 0.f; }
    bf16_t* xb = (bf16_t*)(ws + OFF_R3); float* rstd1 = (float*)(ws + OFF_VEC);
    for (int m = c.gw; m < T; m += c.ngw) {
        const f32x4* xr = (const f32x4*)(p.x + (size_t)m * D_MODEL) + c.lane;
        f32x4 v[4]; float s = 0.f;
#pragma unroll
        for (int j = 0; j < 4; ++j) { v[j] = xr[64 * j]; s += v[j].x * v[j].x + v[j].y * v[j].y + v[j].z * v[j].z + v[j].w * v[j].w; }
        s = wave_sum(s);
        const float rs = rsqrtf(s * (1.f / D_MODEL) + EPS);
        if (c.lane == 0) rstd1[m] = rs;
        u32x2* o = (u32x2*)(xb + (size_t)m * D_MODEL) + c.lane;
#pragma unroll
        for (int j = 0; j < 4; ++j) { u32x2 w; w.x = gdn::cvtpk(v[j].x * rs, v[j].y * rs); w.y = gdn::cvtpk(v[j].z * rs, v[j].w * rs); o[64 * j] = w; }
    }
}

__device__ __forceinline__ void ph2a1_v2(const Ctx& c, const Params& p) {
    const int lane = opaque_tid() & 63;
    const bf16_t* proj = (const bf16_t*)(p.ws + OFF_R1);
    bf16_t* gq = (bf16_t*)(p.ws + OFF_R2); bf16_t* gk = gq + (size_t)T * 512; bf16_t* gv = gk + (size_t)T * 512;
    const bool split = c.nb == 256, upper = !split || c.bid >= 128;
    const int wl = split ? (c.bid & 127) * (NT / 64) + c.wave : c.gw, nwl = split ? 128 * (NT / 64) : c.ngw;
    for (int task = split ? (upper ? wl : 2048 + wl) : c.gw; task < (split && upper ? 2048 : 3072); task += nwl) {
        const int part = task >> 10, run = task & 1023;
        float cw[5][8];
#pragma unroll
        for (int j = 0; j < 5; ++j)
#pragma unroll
            for (int e = 0; e < 8; ++e) cw[j][e] = p.conv_w[j * GDN_QKV + part * 512 + 8 * lane + e];
        const int t0 = run * 16, b = t0 / SEQ, s0 = t0 % SEQ;
        {
            const bf16_t* base = proj + (size_t)t0 * IN_WP + C_QKV + part * 512 + 8 * lane;
            const u32x4 zero = {0u, 0u, 0u, 0u};
            u32x4 rows[20];
#pragma unroll
            for (int i = 0; i < 20; ++i) { const bool ok = (i >= 2 || s0 >= 2) && (i < 18 || s0 + 16 < SEQ); rows[i] = *(const u32x4*)(base + (ptrdiff_t)(ok ? i - 2 : 0) * IN_WP); if (!ok) rows[i] = zero; }
            bf16_t* dst = (part == 0 ? gq : part == 1 ? gk : gv) + ((size_t)(b * GH + (lane >> 4)) * SEQ + s0) * 128 + (lane & 15) * 8;
            float fw[5][8];
#pragma unroll
            for (int j = 0; j < 4; ++j) unpack8(rows[j], fw[j]);
#pragma unroll
            for (int i = 0; i < 16; ++i) {
                unpack8(rows[i + 4], fw[(i + 4) % 5]);
                float y[8];
#pragma unroll
                for (int e = 0; e < 8; ++e) y[e] = 0.f;
#pragma unroll
                for (int j = 0; j < 5; ++j) {
#pragma unroll
                    for (int e = 0; e < 8; ++e) y[e] += cw[j][e] * fw[(i + j) % 5][e]; }
                float ss = 0.f;
#pragma unroll
                for (int e = 0; e < 8; ++e) { y[e] = siluf_(y[e]); ss += y[e] * y[e]; }
                if (part < 2) { ss += __shfl_xor(ss, 1); ss += __shfl_xor(ss, 2); ss += __shfl_xor(ss, 4); ss += __shfl_xor(ss, 8);
                    const float rs = rsqrtf(ss + EPS) * (part == 0 ? 0.08838834764831845f : 1.f);
#pragma unroll
                    for (int e = 0; e < 8; ++e) y[e] *= rs; }
                *(u32x4*)(dst + (size_t)i * 128) = pack8(y);
            }
        }
    }
    const int tfirst = split ? (c.bid - 128) * NT + c.tid : c.bid * NT + c.tid, tstride = split ? 128 * NT : c.nb * NT;
    constexpr int T_MLA_UP = 8192;
    const int mla_lo = split ? (upper ? 0 : T_MLA_UP) : 0, mla_hi = split ? (upper ? T_MLA_UP : T) : T;
    if (upper) { float* Gg = (float*)(p.ws + OFF_GATE); float* Gb = Gg + 2 * T * GH;
      for (int i = tfirst; i < T * GH; i += tstride) { const int t = i >> 2, h = i & 3, b = t / SEQ, s = t % SEQ; const bf16_t* g = proj + (size_t)t * IN_WP + C_GATE;
          const size_t gi = (size_t)(b * GH + h) * SEQ + s;
          Gg[gi] = -expf(p.a_log_f[h]) * softplusf_(bf2f(g[h]) + p.dt_bias_f[h]); Gb[gi] = sigmoidf_(bf2f(g[4 + h]));
          Gg[(size_t)T * GH + gi] = -expf(p.a_log_b[h]) * softplusf_(bf2f(g[8 + h]) + p.dt_bias_b[h]); Gb[(size_t)T * GH + gi] = sigmoidf_(bf2f(g[12 + h])); } }
    { float* rq = (float*)(p.ws + OFF_VEC) + T; float* rkv = rq + T; bf16_t* lat = (bf16_t*)(p.ws + OFF_LAT); float* cst = (float*)(p.ws + OFF_CS);
      bf16_t* Kk = (bf16_t*)p.out + (size_t)T * MLA_H * QKD;
      const int jl = (lane & 3) * 8;
      const float inv = expf(-(float)(lane & 31) * (9.210340371976184f / 32.f));
      for (int tq0 = mla_lo + wl; tq0 < mla_hi; tq0 += 4 * nwl) {
        u32x4 vv[4]; int ps[4];
#pragma unroll
        for (int u = 0; u < 4; ++u) { const int tl = tq0 + u * nwl < mla_hi ? tq0 + u * nwl : tq0; vv[u] = u32x4{0u, 0u, 0u, 0u}; if (lane < 56) vv[u] = *(const u32x4*)(proj + (size_t)tl * IN_WP + 8 * lane); ps[u] = p.pos[tl]; }
#pragma unroll
        for (int u = 0; u < 4; ++u) { const int t = tq0 + u * nwl; if (t >= mla_hi) break; const u32x4 v = vv[u];
          float f[8]; unpack8(v, f); float ss = 0.f;
#pragma unroll
          for (int e = 0; e < 8; ++e) ss += f[e] * f[e];
          const float sq = wave_sum(lane < 32 ? ss : 0.f), sk = wave_sum((lane >= 32 && lane < 48) ? ss : 0.f);
          if (lane == 0) { rq[t] = rsqrtf(sq * (1.f / QRANK) + EPS); rkv[t] = rsqrtf(sk * (1.f / KVRANK) + EPS); }
          *(u32x4*)(lat + (size_t)t * 512 + 8 * lane) = lane < 48 ? v : u32x4{0u, 0u, 0u, 0u};
          u32x4 vp; vp.x = __shfl_xor(v.x, 4); vp.y = __shfl_xor(v.y, 4); vp.z = __shfl_xor(v.z, 4); vp.w = __shfl_xor(v.w, 4);
          float sn, cs;
          { const float xa = (float)ps[u] * inv, rh = xa * 0.15915493667125702f, rl = fmaf(xa, 0.15915493667125702f, -rh) + xa * 6.4206383e-9f;
            const float rv = __builtin_amdgcn_fractf(rh) + rl; sn = __builtin_amdgcn_sinf(rv); cs = __builtin_amdgcn_cosf(rv); }
          cst[(size_t)t * 64 + lane] = lane < 32 ? cs : sn;
          float cs8[8], sn8[8];
#pragma unroll
          for (int e = 0; e < 8; ++e) { cs8[e] = __shfl(cs, jl + e); sn8[e] = __shfl(sn, jl + e); }
          if (lane >= 48 && lane < 56) { float g[8]; unpack8(vp, g); const bool first = lane < 52; float o[8];
#pragma unroll
              for (int e = 0; e < 8; ++e) o[e] = first ? f[e] * cs8[e] - g[e] * sn8[e] : f[e] * cs8[e] + g[e] * sn8[e];
              const u32x4 ow = pack8(o); const int b = t / SEQ, s = t % SEQ;
#pragma unroll
              for (int h = 0; h < MLA_H; ++h) *(u32x4*)(Kk + ((size_t)(b * MLA_H + h) * SEQ + s) * QKD + (first ? 128 : 160) + jl) = ow; } } } }
}

__device__ __forceinline__ void ph4a_v2(const Ctx& c, const Params& p, bool split) {
    const int lane = opaque_tid() & 63;
    const bf16_t* Od = (const bf16_t*)(p.ws + OFF_R3); const bf16_t* omla = (const bf16_t*)(p.ws + OFF_R4);
    const bf16_t* zs = (const bf16_t*)(p.ws + OFF_R2) + (size_t)3 * T * 512; bf16_t* cat = (bf16_t*)(p.ws + OFF_R1);
    float gw8[8];
#pragma unroll
    for (int e = 0; e < 8; ++e) gw8[e] = p.gdn_norm_w[(lane & 15) * 8 + e];
    const bool rot = c.ngw == 2048;
    for (int k0 = 0; k0 * c.ngw < T; k0 += 4) {
      const int t0 = k0 * c.ngw + c.gw;
      u32x4 ra[4], rb[4], rz[4], ro[4];
#pragma unroll
      for (int u = 0; u < 4; ++u) { const int tu_ = (k0 + u) * c.ngw + ((rot && k0 + u >= 4) ? (c.gw ^ 1024) : c.gw); const int tl = tu_ < T ? tu_ : t0;
          ra[u] = *(const u32x4*)(Od + (size_t)tl * 512 + lane * 8); rb[u] = *(const u32x4*)(Od + ((size_t)T + tl) * 512 + lane * 8);
          rz[u] = *(const u32x4*)(zs + (size_t)tl * 512 + lane * 8); ro[u] = *(const u32x4*)(omla + (size_t)tl * 512 + lane * 8); }
#pragma unroll
      for (int u = 0; u < 4; ++u) { const int t = (k0 + u) * c.ngw + ((rot && k0 + u >= 4) ? (c.gw ^ 1024) : c.gw); if (t >= T) break;
        float a[8], bb[8], z[8];
        unpack8(ra[u], a); unpack8(rb[u], bb); unpack8(rz[u], z);
        float ss = 0.f;
#pragma unroll
        for (int e = 0; e < 8; ++e) { a[e] += bb[e]; ss += a[e] * a[e]; }
        ss += __shfl_xor(ss, 1); ss += __shfl_xor(ss, 2); ss += __shfl_xor(ss, 4); ss += __shfl_xor(ss, 8);
        const float r = rsqrtf(ss * (1.f / 128.f) + EPS);
#pragma unroll
        for (int e = 0; e < 8; ++e) a[e] = a[e] * r * gw8[e] * z[e];
        *(u32x4*)(cat + (size_t)t * 1024 + 512 + lane * 8) = pack8(a);
        const int s_ = t % SEQ;
        if (split && s_ >= 28 * 256) {
            const int lu = ((s_ >> 8) - 28) * 8 + (t / SEQ) * 4 + (lane >> 4), row = s_ & 255;
            const float* ml = (const float*)(p.ws + OFF_PARTML) + ((size_t)lu * 7 * 256 + row) * 2; const bf16_t* po = (const bf16_t*)(p.ws + OFF_PART) + ((size_t)lu * 7 * 256 + row) * 128 + (lane & 15) * 8;
            float mp[7], lp[7], M = -3e38f;
#pragma unroll
            for (int q = 0; q < 7; ++q) { mp[q] = ml[q * 512]; lp[q] = ml[q * 512 + 1]; M = fmaxf(M, mp[q]); }
            float o8[8], L = 0.f;
#pragma unroll
            for (int e = 0; e < 8; ++e) o8[e] = 0.f;
#pragma unroll
            for (int q = 0; q < 7; ++q) { const float w = exp2f((mp[q] - M) * (attn::SCALE * 1.4426950408889634f)); L += w * lp[q]; float f[8]; unpack8(*(const u32x4*)(po + (size_t)q * 256 * 128), f);
#pragma unroll
                for (int e = 0; e < 8; ++e) o8[e] += w * f[e]; }
            const float il = 1.f / L;
#pragma unroll
            for (int e = 0; e < 8; ++e) o8[e] *= il;
            *(u32x4*)(cat + (size_t)t * 1024 + lane * 8) = pack8(o8);
        } else
        *(u32x4*)(cat + (size_t)t * 1024 + lane * 8) = ro[u];
      }
    }
}


constexpr size_t OFF_HQ = OFF_R1;
constexpr size_t OFF_HSC = OFF_VEC + 3 * (size_t)T * 4;
constexpr size_t OFF_CBUF = OFF_R2;
constexpr size_t OFF_SUMSQ2 = OFF_VEC + (size_t)T * 4;
__device__ __forceinline__ float gelu_as(float v) {
    const float av = fabsf(v), t = __builtin_amdgcn_rcpf(av * 0.2316418882f + 1.0f);
    float q = t * 0.5307027145f + (-0.7265760135f); q = q * t + 0.7107068705f; q = q * t + (-0.142248368f); q = q * t + 0.127414796f; q = q * t;
    const float m = v * (q * __builtin_amdgcn_exp2f((v * v) * (-0.72134752044f)));
    return v < 0.f ? m : v - m;
}
__device__ __forceinline__ void peer_hq(const Ctx& c, const Params& p) {
    const int lane = c.lane; unsigned char* hq = p.ws + OFF_HQ; float* hsc = (float*)(p.ws + OFF_HSC);
    for (int t0 = c.gw; t0 < T; t0 += 4 * c.ngw) {
        u32x4 rw[4][2];
#pragma unroll
        for (int u = 0; u < 4; ++u) { const int tl = t0 + u * c.ngw < T ? t0 + u * c.ngw : t0; const bf16_t* row = (const bf16_t*)(p.ws + OFF_R3) + (size_t)tl * 1024 + 16 * lane;
            rw[u][0] = *(const u32x4*)row; rw[u][1] = *(const u32x4*)(row + 8); }
#pragma unroll
        for (int u = 0; u < 4; ++u) { const int t = t0 + u * c.ngw; if (t >= T) break;
            f32x4 hr[4]; float ssq = 0.f, mx = 0.f;
            { float f0[8], f1[8]; unpack8(rw[u][0], f0); unpack8(rw[u][1], f1);
              hr[0] = f32x4{f0[0], f0[1], f0[2], f0[3]}; hr[1] = f32x4{f0[4], f0[5], f0[6], f0[7]}; hr[2] = f32x4{f1[0], f1[1], f1[2], f1[3]}; hr[3] = f32x4{f1[4], f1[5], f1[6], f1[7]}; }
#pragma unroll
            for (int j = 0; j < 4; ++j) {
#pragma unroll
                for (int k = 0; k < 4; ++k) { ssq += hr[j][k] * hr[j][k]; mx = fmaxf(mx, fabsf(hr[j][k])); } }
            ssq = wave_sum(ssq); mx = fmaxf(wave_max(mx), 1e-30f);
            const float qinv = 127.f / mx;
            u32x4 hv; hv.x = q4(hr[0].x, hr[0].y, hr[0].z, hr[0].w, qinv, 0); hv.y = q4(hr[1].x, hr[1].y, hr[1].z, hr[1].w, qinv, 0);
            hv.z = q4(hr[2].x, hr[2].y, hr[2].z, hr[2].w, qinv, 0); hv.w = q4(hr[3].x, hr[3].y, hr[3].z, hr[3].w, qinv, 0);
            *(u32x4*)(hq + (size_t)t * 1024 + 16 * lane) = hv;
            if (lane == 0) hsc[t] = rsqrtf(ssq * (1.f / 1024.f) + EPS) * mx * (1.f / 127.f);
        }
    }
}
__device__ __forceinline__ void peer_H4(const Ctx& c, const Params& p) {
    const int tid = opaque_tid(), lane = tid & 63, wid = __builtin_amdgcn_readfirstlane(tid >> 6), grp = lane >> 3, sub = lane & 7;
    const unsigned char* hq = p.ws + OFF_HQ; const float* hsc = (const float*)(p.ws + OFF_HSC);
    const unsigned char* u8 = p.ws + OFF_R5; const float* su = (const float*)(p.ws + OFF_SU); const float* sv = (const float*)(p.ws + OFF_SV);
    const int* experts = (const int*)(p.ws + OFF_R4); const float* gates = (const float*)(p.ws + OFF_R4 + 8 * MB);
    __fp16* cbuf = (__fp16*)(p.ws + OFF_CBUF);
    { float* s2 = (float*)(p.ws + OFF_SUMSQ2); for (int i = c.bid * NT + tid; i < T; i += c.nb * NT) s2[i] = 0.f; }
    const int x = c.bid & 7, nslw = ((c.nb - x + 7) >> 3) * (NT / 64), wx = (c.bid >> 3) * (NT / 64) + wid;
    int* cE = (int*)c.lds + wid * 768; float* cG = (float*)(cE + 128); int* cS = cE + 256;
    int e0n[2], e1n[2]; float g0n[2], g1n[2]; u32x4 hqn[2];
    unsigned char* hrows = (unsigned char*)c.lds + 8 * 3072 + wid * 2048;
    constexpr int QCAP = 512;
    int* qE = (int*)((unsigned char*)c.lds + 40960 + wid * (QCAP * 12)); float* qG = (float*)(qE + QCAP); int* qST = qE + 2 * QCAP;
    int qn = 0;
#define PH_FETCH(u_, t_) do { e0n[u_] = experts[(size_t)(t_) * 128 + lane]; e1n[u_] = experts[(size_t)(t_) * 128 + 64 + lane]; g0n[u_] = gates[(size_t)(t_) * 128 + lane]; g1n[u_] = gates[(size_t)(t_) * 128 + 64 + lane]; \
    hqn[u_] = *(const u32x4*)(hq + (size_t)(t_) * 1024 + lane * 16); } while (0)
#define PH_DOT(S_, HV_, UR_) do { int s0_ = 0, s1_ = 0, s2__ = 0, s3_ = 0; \
    _Pragma("unroll") for (int j_ = 0; j_ < 8; ++j_) { s0_ = __builtin_amdgcn_sdot4((int)HV_[j_].x, (int)UR_[j_].x, s0_, false); s1_ = __builtin_amdgcn_sdot4((int)HV_[j_].y, (int)UR_[j_].y, s1_, false); \
        s2__ = __builtin_amdgcn_sdot4((int)HV_[j_].z, (int)UR_[j_].z, s2__, false); s3_ = __builtin_amdgcn_sdot4((int)HV_[j_].w, (int)UR_[j_].w, s3_, false); } \
    S_ = (s0_ + s1_) + (s2__ + s3_); \
    S_ += __builtin_amdgcn_update_dpp(0, S_, 0xB1, 0xf, 0xf, true); S_ += __builtin_amdgcn_update_dpp(0, S_, 0x4E, 0xf, 0xf, true); S_ += __builtin_amdgcn_update_dpp(0, S_, 0x141, 0xf, 0xf, true); } while (0)
    int cm[2]; float hs[2]; int tt[2]; bool val[2]; float mg[2][2], msu[2][2], msv[2][2]; int ms[2][2]; u32x4 ur[2][2][8];
    auto load = [&](const int u, const int tok) __attribute__((always_inline)) {
        val[u] = tok < T; tt[u] = val[u] ? tok : 0;
        const int e0 = e0n[u], e1 = e1n[u]; const float g0 = g0n[u], g1 = g1n[u];
        *(u32x4*)(hrows + u * 1024 + lane * 16) = hqn[u];
        hs[u] = hsc[tt[u]];
        const bool in0 = (e0 >> 11) == x, in1 = (e1 >> 11) == x;
        const unsigned long long m0 = __ballot(in0), m1 = __ballot(in1);
        const int n0 = __popcll(m0), cnt = n0 + __popcll(m1); cm[u] = min(cnt, 16);
        const int r0 = __builtin_amdgcn_mbcnt_hi((unsigned)(m0 >> 32), __builtin_amdgcn_mbcnt_lo((unsigned)m0, 0));
        const int r1 = n0 + __builtin_amdgcn_mbcnt_hi((unsigned)(m1 >> 32), __builtin_amdgcn_mbcnt_lo((unsigned)m1, 0));
        int* E_ = cE + u * 384; float* G_ = cG + u * 384; int* S_ = cS + u * 384;
        if (in0) { if (r0 < 16) { E_[r0] = e0; G_[r0] = g0; S_[r0] = lane; } else if (val[u]) { const int q_ = qn + r0 - 16; qE[q_] = e0; qG[q_] = g0; qST[q_] = (tt[u] << 7) | lane; } }
        if (in1) { if (r1 < 16) { E_[r1] = e1; G_[r1] = g1; S_[r1] = 64 + lane; } else if (val[u]) { const int q_ = qn + r1 - 16; qE[q_] = e1; qG[q_] = g1; qST[q_] = (tt[u] << 7) | (64 + lane); } }
        if (val[u]) qn += max(cnt - 16, 0);
        { const int tn = tok + 2 * nslw; const int t2 = tn < T ? tn : 0; PH_FETCH(u, t2); }
#pragma unroll
        for (int q = 0; q < 2; ++q) { const int ent = min(8 * q + grp, max(cm[u] - 1, 0)); int me = cE[u * 384 + ent]; mg[u][q] = cG[u * 384 + ent]; ms[u][q] = cS[u * 384 + ent];
            if (cm[u] == 0) me = 2048 * x;
            msu[u][q] = su[me]; msv[u][q] = sv[me]; const unsigned char* pr = u8 + (size_t)me * 1024 + sub * 16;
#pragma unroll
            for (int j = 0; j < 8; ++j) ur[u][q][j] = *(const u32x4*)(pr + j * 128); }
    };
    auto compute = [&](const int u) __attribute__((always_inline)) {
        u32x4 hv[8];
#pragma unroll
        for (int j = 0; j < 8; ++j) hv[j] = *(const u32x4*)(hrows + u * 1024 + sub * 16 + j * 128);
#pragma unroll
        for (int q = 0; q < 2; ++q) { int s; PH_DOT(s, hv, ur[u][q]);
            const float cc = mg[u][q] * msv[u][q] * gelu_as(hs[u] * msu[u][q] * (float)s);
            if (sub == 0 && val[u] && 8 * q + grp < cm[u]) cbuf[(size_t)tt[u] * 128 + ms[u][q]] = (__fp16)cc; }
    };
#pragma unroll
    for (int u = 0; u < 2; ++u) { const int tt0 = wx + u * nslw < T ? wx + u * nslw : 0; PH_FETCH(u, tt0); }
    int t = wx;
    while (true) {
        load(0, t);
        for (; t < T && qn <= QCAP - 224; t += 2 * nslw) {
            load(1, t + nslw);
            __builtin_amdgcn_sched_barrier(0);
            compute(0);
            __builtin_amdgcn_sched_barrier(0);
            load(0, t + 2 * nslw);
            __builtin_amdgcn_sched_barrier(0);
            compute(1);
            __builtin_amdgcn_sched_barrier(0);
        }
        if (qn > 0) {
            const int nbq = (qn + 7) >> 3;
            u32x4 urq[2][8], hvq[2][8]; int qst[2]; float qg[2], qsu[2], qsv[2], qhs[2];
#define PH_QLOAD(B_, b_) do { const int ent_ = min(8 * (b_) + grp, qn - 1); const int qe_ = qE[ent_]; qg[B_] = qG[ent_]; qst[B_] = qST[ent_]; const int tq_ = qst[B_] >> 7; \
            qsu[B_] = su[qe_]; qsv[B_] = sv[qe_]; qhs[B_] = hsc[tq_]; const unsigned char* pr_ = u8 + (size_t)qe_ * 1024 + sub * 16; const unsigned char* ph_ = hq + (size_t)tq_ * 1024 + sub * 16; \
            _Pragma("unroll") for (int j_ = 0; j_ < 8; ++j_) { urq[B_][j_] = *(const u32x4*)(pr_ + j_ * 128); hvq[B_][j_] = *(const u32x4*)(ph_ + j_ * 128); } } while (0)
#define PH_QCOMP(B_, b_) do { int s_; PH_DOT(s_, hvq[B_], urq[B_]); const float cc_ = qg[B_] * qsv[B_] * gelu_as(qhs[B_] * qsu[B_] * (float)s_); \
            if (sub == 0 && 8 * (b_) + grp < qn) cbuf[(size_t)(qst[B_] >> 7) * 128 + (qst[B_] & 127)] = (__fp16)cc_; } while (0)
            PH_QLOAD(0, 0);
            for (int b = 0; b < nbq; b += 2) {
                PH_QLOAD(1, b + 1);
                __builtin_amdgcn_sched_barrier(0);
                PH_QCOMP(0, b);
                __builtin_amdgcn_sched_barrier(0);
                PH_QLOAD(0, b + 2);
                __builtin_amdgcn_sched_barrier(0);
                PH_QCOMP(1, b + 1);
                __builtin_amdgcn_sched_barrier(0);
            }
#undef PH_QLOAD
#undef PH_QCOMP
            qn = 0;
        }
        if (t >= T) break;
        PH_FETCH(0, t);
    }
#undef PH_FETCH
#undef PH_DOT
}
template <int DRY>
__device__ __forceinline__ void peer_O2(const Ctx& c, const Params& p) {
    typedef __fp16 h16x2 __attribute__((ext_vector_type(2)));
    const int tid = opaque_tid(), lane = tid & 63, wid = __builtin_amdgcn_readfirstlane(tid >> 6);
    const unsigned char* v8 = p.ws + OFF_R5 + (size_t)NEXP * 1024;
    const int* experts = (const int*)(p.ws + OFF_R4); const unsigned* cbuf = (const unsigned*)(p.ws + OFF_CBUF); float* s2 = (float*)(p.ws + OFF_SUMSQ2);
    const int x = c.bid & 7, nslw = ((c.nb - x + 7) >> 3) * (NT / 64), wx = (c.bid >> 3) * (NT / 64) + wid;
    const int grp = lane >> 3, sub = lane & 7;
    const int col4 = 128 * x + 16 * sub + 8 * ((grp >> 1) & 1) + 4 * (grp >> 2);
    const unsigned char* v8s = v8 + (size_t)x * ((size_t)NEXP * 128);
    u32x2 Eraw[2]; unsigned craw[2]; u32x4 vr[2][16]; u32x2 hpre[2];
    unsigned char* olds = (unsigned char*)c.lds + wid * 2048;
#define PO_FETCH(u_, t_) do { const int tf_ = (t_) < T ? (t_) : 0; Eraw[u_] = *(const u32x2*)(experts + (size_t)tf_ * 128 + 2 * lane); } while (0)
#define PO_LOAD(u_, t_) do { const int tl_ = (t_) < T ? (t_) : 0; \
        *(u32x2*)(olds + (u_) * 1024 + lane * 8) = Eraw[u_]; \
        craw[u_] = cbuf[(size_t)tl_ * 64 + lane]; \
        hpre[u_] = *(const u32x2*)((const bf16_t*)(p.ws + OFF_R3) + (size_t)tl_ * 1024 + col4); \
        _Pragma("unroll") for (int j_ = 0; j_ < 4; ++j_) { const u32x4 en_ = *(const u32x4*)(olds + (u_) * 1024 + grp * 64 + 16 * j_); \
            _Pragma("unroll") for (int k_ = 0; k_ < 4; ++k_) { int e_ = (int)en_[k_]; if (DRY == 2) e_ &= 7; vr[u_][4 * j_ + k_] = *(const u32x4*)(v8s + (((unsigned)e_ << 7) | (unsigned)(16 * sub))); } } } while (0)
    auto compute = [&](const int u, const int tt) __attribute__((always_inline)) {
        h16x2 cp[8]; float csum = 0.f; u32x4 cvv[2];
        *(unsigned*)(olds + u * 1024 + 512 + lane * 4) = craw[u];
#pragma unroll
        for (int j = 0; j < 2; ++j) cvv[j] = *(const u32x4*)(olds + u * 1024 + 512 + grp * 32 + 16 * j);
#pragma unroll
        for (int i2 = 0; i2 < 8; ++i2) { { const unsigned w_ = cvv[i2 >> 2][i2 & 3]; cp[i2] = *(const h16x2*)&w_; }
            const unsigned one2 = 0x00010001u; csum = __builtin_amdgcn_fdot2(*(const h16x2*)&one2, cp[i2], csum, false); }
        float a16[16]; const float ainit = -128.f * csum;
#pragma unroll
        for (int i2 = 0; i2 < 8; ++i2) {
#pragma unroll
            for (int w = 0; w < 4; ++w) { const unsigned ra = vr[u][2 * i2][w], rb = vr[u][2 * i2 + 1][w];
#pragma unroll
                for (int k = 0; k < 4; ++k) { const unsigned pk = __builtin_amdgcn_perm(rb, ra, 0x0C000C00u | ((4u + k) << 16) | (unsigned)k);
                    if (i2 == 0) asm("v_dot2_f32_f16 %0, %1, %2, %3" : "=v"(a16[4 * w + k]) : "v"(pk), "v"(cp[0]), "v"(ainit));
                    else a16[4 * w + k] = __builtin_amdgcn_fdot2(*(const h16x2*)&pk, cp[i2], a16[4 * w + k], false); } } }
        float r8[8], r4[4];
#pragma unroll
        for (int i = 0; i < 8; ++i) { auto r = __builtin_amdgcn_permlane16_swap(__float_as_uint(a16[i]), __float_as_uint(a16[8 + i]), false, false); r8[i] = __uint_as_float(r[0]) + __uint_as_float(r[1]); }
#pragma unroll
        for (int i = 0; i < 4; ++i) { auto r = __builtin_amdgcn_permlane32_swap(__float_as_uint(r8[i]), __float_as_uint(r8[4 + i]), false, false); r4[i] = __uint_as_float(r[0]) + __uint_as_float(r[1]); }
#pragma unroll
        for (int i = 0; i < 4; ++i) r4[i] += __builtin_amdgcn_update_dpp(0.f, r4[i], 0x128, 0xf, 0xf, true);
        float ss = 0.f;
        if ((lane & 8) == 0 && tt < T) { bf16_t* hrow = (bf16_t*)(p.ws + OFF_R3) + (size_t)tt * 1024 + col4;
            const float f0 = bflo(hpre[u].x) + r4[0] * 16777216.f, f1 = bfhi(hpre[u].x) + r4[1] * 16777216.f, f2 = bflo(hpre[u].y) + r4[2] * 16777216.f, f3 = bfhi(hpre[u].y) + r4[3] * 16777216.f;
            ss = (f0 * f0 + f1 * f1) + (f2 * f2 + f3 * f3);
            if (!DRY) { u32x2 o; o.x = gdn::cvtpk(f0, f1); o.y = gdn::cvtpk(f2, f3); *(u32x2*)hrow = o; } }
        ss += __builtin_amdgcn_update_dpp(0.f, ss, 0xB1, 0xf, 0xf, true); ss += __builtin_amdgcn_update_dpp(0.f, ss, 0x4E, 0xf, 0xf, true); ss += __builtin_amdgcn_update_dpp(0.f, ss, 0x141, 0xf, 0xf, true);
        { auto r = __builtin_amdgcn_permlane16_swap(__float_as_uint(ss), __float_as_uint(ss), false, false); ss = __uint_as_float(r[0]) + __uint_as_float(r[1]); }
        { auto r = __builtin_amdgcn_permlane32_swap(__float_as_uint(ss), __float_as_uint(ss), false, false); ss = __uint_as_float(r[0]) + __uint_as_float(r[1]); }
        if (DRY) asm volatile("" :: "v"(ss)); else if (lane == 0 && tt < T) unsafeAtomicAdd(s2 + tt, ss);
    };
    PO_FETCH(0, wx); PO_FETCH(1, wx + nslw);
    PO_LOAD(0, wx); PO_FETCH(0, wx + 2 * nslw);
    for (int t = wx; t < T; t += 2 * nslw) {
        PO_LOAD(1, t + nslw); PO_FETCH(1, t + 3 * nslw);
        __builtin_amdgcn_sched_barrier(0);
        compute(0, t);
        __builtin_amdgcn_sched_barrier(0);
        PO_LOAD(0, t + 2 * nslw); PO_FETCH(0, t + 4 * nslw);
        __builtin_amdgcn_sched_barrier(0);
        compute(1, t + nslw);
        __builtin_amdgcn_sched_barrier(0);
    }
#undef PO_LOAD
#undef PO_FETCH
}
__device__ __forceinline__ void peer_N(const Ctx& c, const Params& p) {
    const int lane = c.lane; const float* s2 = (const float*)(p.ws + OFF_SUMSQ2);
    f32x4 fw[4];
#pragma unroll
    for (int j = 0; j < 4; ++j) fw[j] = *(const f32x4*)(p.final_w + 4 * lane + 256 * j);
    for (int t0 = c.gw; t0 < T; t0 += 4 * c.ngw) {
        u32x2 w[4][4]; float ss[4];
#pragma unroll
        for (int u = 0; u < 4; ++u) { const int t = t0 + u * c.ngw < T ? t0 + u * c.ngw : t0; const bf16_t* hrow = (const bf16_t*)(p.ws + OFF_R3) + (size_t)t * 1024 + 4 * lane; ss[u] = s2[t];
#pragma unroll
            for (int j = 0; j < 4; ++j) w[u][j] = *(const u32x2*)(hrow + 256 * j); }
#pragma unroll
        for (int u = 0; u < 4; ++u) { const int t = t0 + u * c.ngw; if (t < T) { float* row = p.out + (size_t)t * 1024 + 4 * lane; const float r = rsqrtf(ss[u] * (1.f / 1024.f) + EPS);
#pragma unroll
            for (int j = 0; j < 4; ++j) { const f32x4 hv = {bflo(w[u][j].x), bfhi(w[u][j].x), bflo(w[u][j].y), bfhi(w[u][j].y)}; *(f32x4*)(row + 256 * j) = hv * r * fw[j]; } } }
    }
}

constexpr int LDS_BYTES = 144 * 1024;
__global__ void __launch_bounds__(NT, 2) fwd_megakernel(Params p_arg) {
    extern __shared__ __attribute__((aligned(16))) unsigned char lds_raw[];
    typedef const Params __attribute__((address_space(4)))* KargP;
    const KargP pk_ = (KargP)__builtin_amdgcn_kernarg_segment_ptr();
#if defined(__HIP_DEVICE_COMPILE__)
#define RELOAD_P() ({ KargP q_ = pk_; asm volatile("" : "+s"(q_)); Params t_; __builtin_memcpy(&t_, q_, sizeof(Params)); t_; })
#else
#define RELOAD_P() (p_arg)
#endif
    Params p = p_arg;
    cg::grid_group grid = cg::this_grid();
#define MKCTX() ({ Ctx c_; c_.tid = opaque_tid(); c_.lane = c_.tid & 63; c_.wave = __builtin_amdgcn_readfirstlane(c_.tid >> 6); c_.bid = blockIdx.x; { int nb_ = (int)gridDim.x; asm volatile("" : "+s"(nb_)); c_.nb = nb_; } \
    c_.gw = c_.bid * (NT / 64) + c_.wave; c_.ngw = c_.nb * (NT / 64); c_.lds = (float*)lds_raw; c_; })
    Ctx c = MKCTX();
    volatile LAS unsigned* xb_st = (volatile LAS unsigned*)(lds_raw + LDS_BYTES - 16);
    if (threadIdx.x < 4) xb_st[threadIdx.x] = 0u;
    __syncthreads();
    const XcdBarrier xbar = xcd_barrier_post((unsigned*)(p.ws + OFF_BAR), xb_st);
#define GSYNC() do { xcd_barrier(xbar); c = MKCTX(); p = RELOAD_P(); } while (0)
    ph0_v2(c, p);
    if (p.ws == nullptr) grid.sync();
    GSYNC();
    ph1_mfma(c, p); GSYNC();
    if (c.nb != 256 || c.bid < 128) ph1z(c, p, c.nb == 256 ? 128 : c.nb);
    ph2a1_v2(c, p); GSYNC();
    ph2a2_v3(c, p); ph2b_v4<0>(c, p); GSYNC();
    const bool split = c.nb == 256; constexpr int TAB_SPLIT = NEXP;
    if (split) {
        if (c.bid >= 32) ph3a_split(c, p);
        else { ph3b_mfma<0>(c, p); ph4a_tables_q8(c, p, c.gw, 32 * (NT / 64), 0, TAB_SPLIT); }
    } else {
        ph3a_mfma(c, p);
        if (c.bid < 32) ph3b_mfma<0>(c, p); else ph4a_tables_q8(c, p, (c.bid - 32) * (NT / 64) + c.wave, (c.nb - 32) * (NT / 64), 0, TAB_SPLIT);
    }
    GSYNC();
    ph4a_v2(c, p, split); ph4a_tables_q8(c, p, c.gw, c.ngw, TAB_SPLIT, 2 * NEXP); GSYNC();
    ph4b_v2(c, p); GSYNC();
    ph5_v2(c, p); GSYNC();
    ph6_fast(c, p); peer_hq(c, p); GSYNC();
    peer_H4(c, p); GSYNC();
    peer_O2<0>(c, p); GSYNC();
    peer_N(c, p);
}

extern "C" void kernel_launch(void* const* d_in, const int* in_sizes, int n_in, void* d_out, int out_size, void* d_ws, size_t ws_size, hipStream_t stream) {
    static int grid_blocks = 0;
    if (grid_blocks == 0) {
        if (n_in != 21 || out_size != T * D_MODEL || ws_size < WS_END) { fprintf(stderr, "kernel_launch: unexpected shapes n_in %d out %d ws %zu\n", n_in, out_size, ws_size); grid_blocks = -1; return; }
        int dev = 0, cus = 0, per_cu = 0;
        hipGetDevice(&dev); hipDeviceGetAttribute(&cus, hipDeviceAttributeMultiprocessorCount, dev);
        if (hipFuncSetAttribute((const void*)fwd_megakernel, hipFuncAttributeMaxDynamicSharedMemorySize, LDS_BYTES) != hipSuccess) { fprintf(stderr, "kernel_launch: hipFuncSetAttribute failed\n"); grid_blocks = -1; return; }
        if (hipOccupancyMaxActiveBlocksPerMultiprocessor(&per_cu, (const void*)fwd_megakernel, NT, LDS_BYTES) != hipSuccess || per_cu < 1) { fprintf(stderr, "kernel_launch: occupancy query failed (%d)\n", per_cu); grid_blocks = -1; return; }
        grid_blocks = cus * per_cu;
    }
    if (grid_blocks < 0) return;
    Params p{};
    p.x = (const float*)d_in[0]; p.pos = (const int*)d_in[1]; p.ln1_w = (const float*)d_in[2]; p.w_in = (const float*)d_in[3]; p.q_a_norm_w = (const float*)d_in[4];
    p.w_q_up = (const float*)d_in[5]; p.kv_a_norm_w = (const float*)d_in[6]; p.w_kv_up = (const float*)d_in[7]; p.conv_w = (const float*)d_in[8];
    p.a_log_f = (const float*)d_in[9]; p.dt_bias_f = (const float*)d_in[10]; p.a_log_b = (const float*)d_in[11]; p.dt_bias_b = (const float*)d_in[12];
    p.gdn_norm_w = (const float*)d_in[13]; p.w_out = (const float*)d_in[14]; p.ln2_w = (const float*)d_in[15]; p.peer_wq = (const float*)d_in[16];
    p.sub_keys = (const float*)d_in[17]; p.peer_u = (const float*)d_in[18]; p.peer_v = (const float*)d_in[19]; p.final_w = (const float*)d_in[20];
    p.out = (float*)d_out; p.ws = (unsigned char*)d_ws;
    if (hipMemsetAsync((char*)d_ws + OFF_BAR, 0, 16384, stream) != hipSuccess) { fprintf(stderr, "kernel_launch: memset of barrier words failed\n"); return; }
    void* args[] = {&p};
    hipError_t e = hipLaunchCooperativeKernel((const void*)fwd_megakernel, dim3(grid_blocks), dim3(NT), args, LDS_BYTES, stream);
    if (e != hipSuccess) fprintf(stderr, "cooperative launch failed: %s (grid %d)\n", hipGetErrorString(e), grid_blocks);
}
```
